# Optimizing an MI355X kernel written in HIP

```python
import jax, jax.numpy as jnp
from jax import lax
import numpy as np

D_MODEL = 1024
BATCH = 2
SEQ = 8192
DEPTH = 4

HEAD_DIM = 64
ROPE_THETA = 10000.0
RMS_EPS = 1e-6
QBLK = 128
NEG_INF = -1e30

GRID_W = 64
NA_HEADS = 8
NA_ROWS = 8
NA_COLS = 16
NA_WIDTH = NA_HEADS * HEAD_DIM

MLA_HEADS = 8
MLA_Q_RANK = 256
MLA_KV_RANK = 128
MLA_NOPE = 64
MLA_ROPE = 32
MLA_V = 64

DIL_PAIRS = ((128, 1), (512, 4), (2048, 16))
DIL_GROUPS = len(DIL_PAIRS)
DIL_HEADS = D_MODEL // HEAD_DIM

D_FF = 4 * D_MODEL
N_EVEN = (DEPTH + 1) // 2
N_ODD = DEPTH // 2

EVEN_IN = 3 * NA_WIDTH + MLA_Q_RANK + MLA_KV_RANK + MLA_ROPE
EVEN_MIX = NA_WIDTH + MLA_HEADS * MLA_V
ODD_IN = DIL_GROUPS * 3 * DIL_HEADS * HEAD_DIM
ODD_MIX = DIL_HEADS * HEAD_DIM

kernel_name = "hybrid_na_mla_dilated_encoder"


def rms_norm(x, g):
    xf = x.astype(jnp.float32)
    y = xf * lax.rsqrt(jnp.mean(xf * xf, axis=-1, keepdims=True) + RMS_EPS)
    return (y * g.astype(jnp.float32)).astype(x.dtype)


def rope_tables(seq_len, dim):
    inv = 1.0 / (ROPE_THETA ** (jnp.arange(0, dim, 2, dtype=jnp.float32) / dim))
    ang = jnp.arange(seq_len, dtype=jnp.float32)[:, None] * inv[None, :]
    return jnp.cos(ang), jnp.sin(ang)


def apply_rope(x, cos, sin):
    half = x.shape[-1] // 2
    shp = (1, cos.shape[0]) + (1,) * (x.ndim - 3) + (cos.shape[1],)
    c = cos.reshape(shp).astype(x.dtype)
    s = sin.reshape(shp).astype(x.dtype)
    x1, x2 = x[..., :half], x[..., half:]
    return jnp.concatenate([x1 * c - x2 * s, x2 * c + x1 * s], axis=-1)


def neighbourhood_attention(q, k, v, rpb):
    b, s, h, dh = q.shape
    rows = s // GRID_W
    wr = min(NA_ROWS, rows)
    wc = NA_COLS
    qg = q.reshape(b, rows, GRID_W, h, dh)
    kg = k.reshape(b, rows, GRID_W, h, dh)
    vg = v.reshape(b, rows, GRID_W, h, dh)
    cols = jnp.arange(GRID_W)
    col_start = jnp.clip(cols - wc // 2, 0, GRID_W - wc)
    col_idx = col_start[:, None] + jnp.arange(wc)[None, :]
    col_rel = col_idx - cols[:, None] + (NA_COLS - 1)
    scale = dh ** -0.5

    def row_fn(r):
        r_start = jnp.clip(r - wr // 2, 0, rows - wr)
        row_rel = r_start + jnp.arange(wr) - r + (NA_ROWS - 1)
        q_row = lax.dynamic_index_in_dim(qg, r, axis=1, keepdims=False)
        k_rows = lax.dynamic_slice_in_dim(kg, r_start, wr, axis=1)
        v_rows = lax.dynamic_slice_in_dim(vg, r_start, wr, axis=1)
        k_win = k_rows[:, :, col_idx]
        v_win = v_rows[:, :, col_idx]
        sc = jnp.einsum('bchd,bicjhd->bhcij', q_row, k_win,
                        preferred_element_type=jnp.float32) * scale
        bias = rpb[:, row_rel[:, None, None], col_rel[None, :, :]]
        sc = sc + bias.transpose(0, 2, 1, 3).astype(jnp.float32)[None]
        p = jax.nn.softmax(sc.reshape(b, h, GRID_W, wr * wc), axis=-1).reshape(sc.shape)
        return jnp.einsum('bhcij,bicjhd->bchd', p.astype(v.dtype), v_win)

    out = lax.map(row_fn, jnp.arange(rows))
    return out.transpose(1, 0, 2, 3, 4).reshape(b, s, h * dh)


def dense_attention(q, k, v, scale):
    b, s, h, dq = q.shape
    nblk = s // QBLK
    qb = q.reshape(b, nblk, QBLK, h, dq).transpose(1, 0, 2, 3, 4)

    def blk(qi):
        sc = jnp.einsum('bqhd,bkhd->bhqk', qi, k, preferred_element_type=jnp.float32) * scale
        p = jax.nn.softmax(sc, axis=-1)
        return jnp.einsum('bhqk,bkhd->bqhd', p.astype(v.dtype), v)

    out = lax.map(blk, qb)
    return out.transpose(1, 0, 2, 3, 4).reshape(b, s, h * v.shape[-1])


def dilated_attention(q, k, v):
    b, s, g, h, dh = q.shape
    nblk = s // QBLK
    scale = dh ** -0.5
    offsets = [jnp.arange(-(w // 2), w // 2 + 1, d) for (w, d) in DIL_PAIRS]
    ks = [k[:, :, gi] for gi in range(g)]
    vs = [v[:, :, gi] for gi in range(g)]

    def blk(bi):
        start = bi * QBLK
        qpos = start + jnp.arange(QBLK)
        q_blk = lax.dynamic_slice_in_dim(q, start, QBLK, axis=1)
        outs, lses = [], []
        for gi in range(g):
            kpos = qpos[:, None] + offsets[gi][None, :]
            valid = (kpos >= 0) & (kpos < s)
            kidx = jnp.clip(kpos, 0, s - 1)
            k_sel = ks[gi][:, kidx]
            v_sel = vs[gi][:, kidx]
            sc = jnp.einsum('bqhd,bqjhd->bhqj', q_blk[:, :, gi], k_sel,
                            preferred_element_type=jnp.float32) * scale
            sc = jnp.where(valid[None, None], sc, NEG_INF)
            m = jnp.max(sc, axis=-1, keepdims=True)
            e = jnp.exp(sc - m)
            z = jnp.sum(e, axis=-1, keepdims=True)
            o = jnp.einsum('bhqj,bqjhd->bqhd', (e / z).astype(v.dtype), v_sel)
            outs.append(o.astype(jnp.float32))
            lses.append((m + jnp.log(z))[..., 0])
        lse = jnp.stack(lses, axis=0)
        wgt = jax.nn.softmax(lse, axis=0).transpose(0, 1, 3, 2)[..., None]
        out = jnp.sum(wgt * jnp.stack(outs, axis=0), axis=0)
        return out.astype(v.dtype)

    out = lax.map(blk, jnp.arange(nblk))
    return out.transpose(1, 0, 2, 3, 4).reshape(b, s, h * dh)


def even_mixer(xn, w_in, rpb, q_norm, w_uq, kv_norm, w_ukv, w_o, cos_r, sin_r):
    b, s, _ = xn.shape
    hcat = xn @ w_in
    o0 = 3 * NA_WIDTH
    o1 = o0 + MLA_Q_RANK
    o2 = o1 + MLA_KV_RANK
    a_qkv = hcat[..., :o0].reshape(b, s, 3, NA_HEADS, HEAD_DIM)
    out_a = neighbourhood_attention(a_qkv[:, :, 0], a_qkv[:, :, 1], a_qkv[:, :, 2], rpb)
    c_q = rms_norm(hcat[..., o0:o1], q_norm)
    c_kv = rms_norm(hcat[..., o1:o2], kv_norm)
    k_pe = apply_rope(hcat[..., o2:][:, :, None, :], cos_r, sin_r)
    q = (c_q @ w_uq).reshape(b, s, MLA_HEADS, MLA_NOPE + MLA_ROPE)
    q = jnp.concatenate([q[..., :MLA_NOPE], apply_rope(q[..., MLA_NOPE:], cos_r, sin_r)], axis=-1)
    kv = (c_kv @ w_ukv).reshape(b, s, MLA_HEADS, MLA_NOPE + MLA_V)
    k = jnp.concatenate([kv[..., :MLA_NOPE],
                         jnp.broadcast_to(k_pe, (b, s, MLA_HEADS, MLA_ROPE))], axis=-1)
    v = kv[..., MLA_NOPE:]
    out_b = dense_attention(q, k, v, (MLA_NOPE + MLA_ROPE) ** -0.5)
    return jnp.concatenate([out_a, out_b], axis=-1) @ w_o


def odd_mixer(xn, w_in, w_o, cos_f, sin_f):
    b, s, _ = xn.shape
    hcat = (xn @ w_in).reshape(b, s, DIL_GROUPS, 3, DIL_HEADS, HEAD_DIM)
    q = apply_rope(hcat[:, :, :, 0], cos_f, sin_f)
    k = apply_rope(hcat[:, :, :, 1], cos_f, sin_f)
    v = hcat[:, :, :, 2]
    return dilated_attention(q, k, v) @ w_o


def sq_relu_mlp(xn, w1, w2):
    return jnp.square(jax.nn.relu(xn @ w1)) @ w2


def setup_inputs(seed: int = 0) -> dict:
    key = jax.random.key(seed)
    ks = jax.random.split(key, 16)
    f32 = jnp.float32

    def nrm(k, shape, scale):
        return jax.random.normal(k, shape, f32) * scale

    return {
        "x": nrm(ks[0], (BATCH, SEQ, D_MODEL), 1.0),
        "norm_mix": 1.0 + nrm(ks[1], (DEPTH, D_MODEL), 0.1),
        "norm_mlp": 1.0 + nrm(ks[2], (DEPTH, D_MODEL), 0.1),
        "norm_final": 1.0 + nrm(ks[3], (D_MODEL,), 0.1),
        "ev_w_in": nrm(ks[4], (N_EVEN, D_MODEL, EVEN_IN), D_MODEL ** -0.5),
        "ev_rpb": nrm(ks[5], (N_EVEN, NA_HEADS, 2 * NA_ROWS - 1, 2 * NA_COLS - 1), 0.5),
        "ev_q_norm": 1.0 + nrm(ks[6], (N_EVEN, MLA_Q_RANK), 0.1),
        "ev_w_uq": nrm(ks[7], (N_EVEN, MLA_Q_RANK, MLA_HEADS * (MLA_NOPE + MLA_ROPE)), MLA_Q_RANK ** -0.5),
        "ev_kv_norm": 1.0 + nrm(ks[8], (N_EVEN, MLA_KV_RANK), 0.1),
        "ev_w_ukv": nrm(ks[9], (N_EVEN, MLA_KV_RANK, MLA_HEADS * (MLA_NOPE + MLA_V)), MLA_KV_RANK ** -0.5),
        "ev_w_o": nrm(ks[10], (N_EVEN, EVEN_MIX, D_MODEL), EVEN_MIX ** -0.5),
        "od_w_in": nrm(ks[11], (N_ODD, D_MODEL, ODD_IN), D_MODEL ** -0.5),
        "od_w_o": nrm(ks[12], (N_ODD, ODD_MIX, D_MODEL), ODD_MIX ** -0.5),
        "mlp_w1": nrm(ks[13], (DEPTH, D_MODEL, D_FF), D_MODEL ** -0.5),
        "mlp_w2": nrm(ks[14], (DEPTH, D_FF, D_MODEL), D_FF ** -0.5),
    }


def reference(x, norm_mix, norm_mlp, norm_final, ev_w_in, ev_rpb, ev_q_norm, ev_w_uq,
              ev_kv_norm, ev_w_ukv, ev_w_o, od_w_in, od_w_o, mlp_w1, mlp_w2):
    s = x.shape[1]
    cos_r, sin_r = rope_tables(s, MLA_ROPE)
    cos_f, sin_f = rope_tables(s, HEAD_DIM)
    for layer in range(DEPTH):
        xn = rms_norm(x, norm_mix[layer])
        if layer % 2 == 0:
            e = layer // 2
            x = x + even_mixer(xn, ev_w_in[e], ev_rpb[e], ev_q_norm[e], ev_w_uq[e],
                               ev_kv_norm[e], ev_w_ukv[e], ev_w_o[e], cos_r, sin_r)
        else:
            o = layer // 2
            x = x + odd_mixer(xn, od_w_in[o], od_w_o[o], cos_f, sin_f)
        x = x + sq_relu_mlp(rms_norm(x, norm_mlp[layer]), mlp_w1[layer], mlp_w2[layer])
    return rms_norm(x, norm_final)
```

```cpp
#include <hip/hip_runtime.h>
#include <hip/hip_cooperative_groups.h>
#include <cstdio>
#include <cstdint>
namespace cg = cooperative_groups;

#define LAS __attribute__((address_space(3)))
typedef unsigned short bf16_t;
typedef short bf16x8 __attribute__((ext_vector_type(8)));
typedef float f32x4 __attribute__((ext_vector_type(4)));
typedef float f32x2 __attribute__((ext_vector_type(2)));
typedef float f32x16 __attribute__((ext_vector_type(16)));
typedef unsigned u32x4 __attribute__((ext_vector_type(4)));
typedef unsigned u32x2 __attribute__((ext_vector_type(2)));

constexpr int M = 16384, SEQ = 8192, DM = 1024, FF = 4096;
constexpr int EV_N = 2048;
constexpr int OD_NC = 4608;
constexpr float LOG2E = 1.4426950408889634f;
constexpr float C_NA = 0.125f * LOG2E;
constexpr float C_MLA = 0.10206207261596575f * LOG2E;
constexpr float RMS_EPS = 1e-6f;
constexpr float NEG_BIG = -1e30f;

constexpr size_t MiB = 1u << 20;
constexpr size_t WS_COS64 = 1 * MiB, WS_SIN64 = 2 * MiB, WS_COS32 = 3 * MiB, WS_SIN32 = 3 * MiB + 512 * 1024;
constexpr size_t WS_W = 4 * MiB;
constexpr size_t W_IN = 0, W_O = 18 * MiB, W_1 = 20 * MiB, W_2 = 28 * MiB, W_UQ = 36 * MiB, W_UKV = 36 * MiB + 512 * 1024;
constexpr size_t WS_XN = 41 * MiB;
constexpr size_t WS_ATT = 73 * MiB;
constexpr size_t WS_BIG = 105 * MiB;
constexpr size_t B_QKNA = 0, B_VTNA = 32 * MiB, B_CRAW = 48 * MiB, B_CQN = 60 * MiB, B_CKVN = 68 * MiB, B_KPE = 72 * MiB,
                 B_QMLA = 73 * MiB, B_KN = 97 * MiB, B_VTMLA = 113 * MiB;
constexpr size_t B_QK = 0, B_VT = 96 * MiB, B_LSE = 144 * MiB;
constexpr size_t WS_END = WS_BIG + 146 * MiB;

constexpr int LDS_BYTES = 147456;
constexpr int NPH = 37;

__device__ const float INV64[32] = {
  1.000000000e+00f, 7.498942018e-01f, 5.623413324e-01f, 4.216965139e-01f, 3.162277639e-01f, 2.371373922e-01f, 1.778279394e-01f, 1.333521456e-01f,
  1.000000015e-01f, 7.498941571e-02f, 5.623412877e-02f, 4.216964915e-02f, 3.162277862e-02f, 2.371373586e-02f, 1.778279431e-02f, 1.333521493e-02f,
  9.999999776e-03f, 7.498942316e-03f, 5.623413250e-03f, 4.216964822e-03f, 3.162277862e-03f, 2.371373819e-03f, 1.778279431e-03f, 1.333521446e-03f,
  1.000000047e-03f, 7.498941850e-04f, 5.623413017e-04f, 4.216965463e-04f, 3.162277862e-04f, 2.371373848e-04f, 1.778279402e-04f, 1.333521504e-04f};

__device__ __forceinline__ unsigned cvt_pk_bf16(float lo, float hi) { unsigned r; asm volatile("v_cvt_pk_bf16_f32 %0, %1, %2" : "=v"(r) : "v"(lo), "v"(hi)); return r; }
__device__ __forceinline__ bf16_t f2bf(float f) { return (bf16_t)(cvt_pk_bf16(f, 0.f) & 0xffffu); }
__device__ __forceinline__ float bf2f(unsigned short h) { return __uint_as_float(((unsigned)h) << 16); }
__device__ __forceinline__ float bflo(unsigned w) { return __uint_as_float(w << 16); }
__device__ __forceinline__ float bfhi(unsigned w) { return __uint_as_float(w & 0xffff0000u); }
__device__ __forceinline__ int vtidx(int p) { return (p & ~12) | ((p & 4) << 1) | ((p & 8) >> 1); }
__device__ __forceinline__ float wave_sum(float v) {
#pragma unroll
  for (int o = 1; o < 64; o <<= 1) v += __shfl_xor(v, o);
  return v;
}
__device__ __forceinline__ void unpack8(const u32x4 w, float* f) {
  f[0] = bflo(w.x); f[1] = bfhi(w.x); f[2] = bflo(w.y); f[3] = bfhi(w.y); f[4] = bflo(w.z); f[5] = bfhi(w.z); f[6] = bflo(w.w); f[7] = bfhi(w.w);
}

namespace pg8 {
constexpr int BM = 256, BK = 64, HALF = 128, HTB = HALF * BK * 2, STAGE_BYTES = 8 * HTB, NXCD = 8, WGM = 8;
__host__ __device__ __forceinline__ int lds_byte(int r, int c) { const int st = (r >> 4) * 2 + (c >> 5), rr = r & 15, cc = c & 31, ob = rr * 64 + cc * 2; return st * 1024 + (ob ^ (((ob >> 9) & 1) << 5)); }
__host__ __device__ __forceinline__ void stage_rc(int b, int& R, int& C) { const int st = b / 1024, sb = b % 1024, swz = sb ^ (((sb >> 9) & 1) << 5); R = (st >> 1) * 16 + swz / 64; C = (st & 1) * 32 + (swz % 64) / 2; }
__host__ __device__ __forceinline__ int perm32(int rho) { const int n = rho >> 4, i = rho & 15; return 8 * (i >> 2) + 4 * n + (i & 3); }

struct Unit { int pm, pn; };
struct Gemm { const bf16_t* A; const bf16_t* Bt; int M, N, K; };
struct StaticOrder {
  int nM, nN, nwg, G, c;
  __device__ void init(int M_, int N_, int G_, int c_) { nM = M_ / BM; nN = N_ / BM; nwg = nM * nN; G = G_; c = c_; }
  __device__ bool next(int i, Unit& u) const {
    const long L = (long)i * G + c; if (L >= nwg) return false;
    int wgid = (int)L; { const int q = nwg / NXCD, r = nwg % NXCD, xcd = wgid % NXCD, off = wgid / NXCD; wgid = (xcd < r ? xcd * (q + 1) : r * (q + 1) + (xcd - r) * q) + off; }
    const int nig = WGM * nN, gid = wgid / nig, fm = gid * WGM, gsz = (nM - fm) < WGM ? (nM - fm) : WGM;
    u.pm = fm + ((wgid % nig) % gsz); u.pn = (wgid % nig) / gsz; return true;
  }
};

template <class Epi>
__device__ __forceinline__ void gemm_phase(LAS unsigned char* lds, const Gemm g, const StaticOrder& S, const Epi& E) {
  int tid = threadIdx.x; asm volatile("" : "+v"(tid));
  const int wid = __builtin_amdgcn_readfirstlane(tid >> 6), lane = tid & 63, wr = wid >> 2, wc = wid & 3, fr = lane & 15, fq = lane >> 4;
  constexpr bool PERM = true; const int K = g.K, nt = K / BK;
  unsigned voffA[2], voffB[2];
#pragma unroll
  for (int i = 0; i < 2; ++i) { int R, C; stage_rc(tid * 16 + i * 8192, R, C); const int Rb = PERM ? ((R & ~31) + perm32(R & 31)) : R;
    voffA[i] = (unsigned)(R * K + C) * 2u; voffB[i] = (unsigned)(Rb * K + C) * 2u; }
  const size_t kstep = (size_t)(BK * 2);
  const size_t hstep = (size_t)HALF * K * 2;
  const size_t tstep = 2 * hstep;
  const unsigned ldsw = (unsigned)wid * 1024u;
  const int aoff = lds_byte(wr * 64 + fr, fq * 8), boff = lds_byte(wc * 32 + fr, fq * 8);
#define PG8_SA(b, h) (((b) * 2 + (h)) * HTB)
#define PG8_SB(b, h) ((4 + (b) * 2 + (h)) * HTB)
#define PG8_STAGE(bufoff, gbase, voff) do { _Pragma("unroll") for (int _i = 0; _i < 2; ++_i) \
    __builtin_amdgcn_global_load_lds((const unsigned*)((const char*)(gbase) + (voff)[_i]), (LAS unsigned*)(lds + (bufoff) + ldsw + _i * 8192), 16, 0, 0); } while (0)
#define PG8_LDA(dst, b, h) do { _Pragma("unroll") for (int m = 0; m < 4; ++m) _Pragma("unroll") for (int k = 0; k < 2; ++k) dst[m][k] = *(const LAS bf16x8*)(lds + PG8_SA(b, h) + aoff + m * 2048 + k * 1024); } while (0)
#define PG8_LDB(dst, b, h) do { _Pragma("unroll") for (int n = 0; n < 2; ++n) _Pragma("unroll") for (int k = 0; k < 2; ++k) dst[n][k] = *(const LAS bf16x8*)(lds + PG8_SB(b, h) + boff + n * 2048 + k * 1024); } while (0)
#define PG8_MMA(ai, bj, At, Bt) do { __builtin_amdgcn_s_setprio(1); _Pragma("unroll") for (int m = 0; m < 4; ++m) _Pragma("unroll") for (int n = 0; n < 2; ++n) _Pragma("unroll") for (int k = 0; k < 2; ++k) \
    acc[ai][bj][m][n] = __builtin_amdgcn_mfma_f32_16x16x32_bf16(Bt[n][k], At[m][k], acc[ai][bj][m][n], 0, 0, 0); __builtin_amdgcn_s_setprio(0); } while (0)
#define PG8_WAIT_V(n) asm volatile("s_waitcnt vmcnt(" #n ")" ::: "memory")
#define PG8_WAIT_L(n) asm volatile("s_waitcnt lgkmcnt(" #n ")" ::: "memory")
#define PG8_BAR __builtin_amdgcn_s_barrier()
#define PG8_SCHED __builtin_amdgcn_sched_barrier(0)
  Unit cur, nxt; int ui = 0;
  if (!S.next(0, cur)) return;
  f32x4 acc[2][2][4][2];
#pragma unroll
  for (int a = 0; a < 2; ++a)
#pragma unroll
    for (int b = 0; b < 2; ++b)
#pragma unroll
      for (int m = 0; m < 4; ++m)
#pragma unroll
        for (int n = 0; n < 2; ++n) acc[a][b][m][n] = (f32x4){0.f, 0.f, 0.f, 0.f};
  bf16x8 At[4][2], B0[2][2], B1[2][2];
  const char* cA = (const char*)g.A + (size_t)cur.pm * tstep; const char* cB = (const char*)g.Bt + (size_t)cur.pn * tstep;
  PG8_STAGE(PG8_SB(0, 0), cB, voffB); PG8_STAGE(PG8_SB(0, 1), cB + hstep, voffB); PG8_STAGE(PG8_SA(0, 0), cA, voffA); PG8_STAGE(PG8_SA(0, 1), cA + hstep, voffA);
  if (wr == 1) PG8_BAR;
  PG8_WAIT_V(2); PG8_BAR;
  PG8_STAGE(PG8_SB(1, 0), cB + kstep, voffB); PG8_STAGE(PG8_SA(1, 0), cA + kstep, voffA); PG8_STAGE(PG8_SB(1, 1), cB + hstep + kstep, voffB);
  PG8_WAIT_V(6); PG8_BAR;
  for (;;) {
    const bool has_next = S.next(ui + 1, nxt);
    const char* nA = has_next ? (const char*)g.A + (size_t)nxt.pm * tstep : cA; const char* nB = has_next ? (const char*)g.Bt + (size_t)nxt.pn * tstep : cB;
    for (int t = 0; t < nt; t += 2) {
      const bool last = (t == nt - 2);
      const char* a1 = cA + (size_t)(t + 1) * kstep;
      const char* a2 = last ? nA : cA + (size_t)(t + 2) * kstep; const char* b2 = last ? nB : cB + (size_t)(t + 2) * kstep;
      const char* a3 = a2 + kstep; const char* b3 = b2 + kstep;
      PG8_LDB(B0, 0, 0); PG8_LDB(B1, 0, 1); PG8_SCHED; PG8_LDA(At, 0, 0); PG8_STAGE(PG8_SA(1, 1), a1 + hstep, voffA);
      PG8_WAIT_V(8); PG8_WAIT_L(0); PG8_BAR; PG8_MMA(0, 0, At, B0); PG8_MMA(0, 1, At, B1); PG8_BAR; PG8_SCHED;
      PG8_LDA(At, 0, 1); PG8_STAGE(PG8_SB(0, 0), b2, voffB); PG8_STAGE(PG8_SB(0, 1), b2 + hstep, voffB); PG8_STAGE(PG8_SA(0, 0), a2, voffA);
      PG8_WAIT_V(8); PG8_WAIT_L(0); PG8_BAR; PG8_MMA(1, 0, At, B0); PG8_MMA(1, 1, At, B1); PG8_BAR; PG8_SCHED;
      PG8_LDB(B0, 1, 0); PG8_LDB(B1, 1, 1); PG8_SCHED; PG8_LDA(At, 1, 0); PG8_STAGE(PG8_SA(0, 1), a2 + hstep, voffA);
      PG8_WAIT_V(8); PG8_WAIT_L(0); PG8_BAR; PG8_MMA(0, 0, At, B0); PG8_MMA(0, 1, At, B1); PG8_BAR; PG8_SCHED;
      PG8_LDA(At, 1, 1); PG8_STAGE(PG8_SB(1, 0), b3, voffB); PG8_STAGE(PG8_SB(1, 1), b3 + hstep, voffB); PG8_STAGE(PG8_SA(1, 0), a3, voffA);
      PG8_WAIT_V(8); PG8_WAIT_L(0); PG8_BAR; PG8_MMA(1, 0, At, B0); PG8_MMA(1, 1, At, B1); PG8_BAR; PG8_SCHED;
    }
    if (wr == 0) PG8_BAR;
    E(acc, cur, wr, wc, fr, fq);
    if (!has_next) break;
#pragma unroll
    for (int a = 0; a < 2; ++a)
#pragma unroll
      for (int b = 0; b < 2; ++b)
#pragma unroll
        for (int m = 0; m < 4; ++m)
#pragma unroll
          for (int n = 0; n < 2; ++n) acc[a][b][m][n] = (f32x4){0.f, 0.f, 0.f, 0.f};
    cur = nxt; cA = nA; cB = nB; ++ui;
    if (wr == 1) PG8_BAR;
  }
  PG8_WAIT_V(0);
  PG8_BAR;
#undef PG8_SA
#undef PG8_SB
#undef PG8_STAGE
#undef PG8_LDA
#undef PG8_LDB
#undef PG8_MMA
#undef PG8_WAIT_V
#undef PG8_WAIT_L
#undef PG8_BAR
#undef PG8_SCHED
}
}

enum EpiKind { K_EVIN = 0, K_UQ = 1, K_UKV = 2, K_ODIN = 3, K_RELU2 = 4, K_RESID = 5 };
struct EpiB {
  int kind;
  unsigned char* ws;
  const float* base; float* outf;
  __device__ __forceinline__ void store8(unsigned char* b, unsigned off, f32x4 v0, f32x4 v1) const {
    u32x4 w; w.x = cvt_pk_bf16(v0[0], v0[1]); w.y = cvt_pk_bf16(v0[2], v0[3]); w.z = cvt_pk_bf16(v1[0], v1[1]); w.w = cvt_pk_bf16(v1[2], v1[3]);
    *(u32x4*)(b + off) = w;
  }
  __device__ __forceinline__ void rope8(f32x4& v0, f32x4& v1, const float* ct, const float* st, unsigned toff) const {
    const f32x4 c = *(const f32x4*)((const char*)ct + toff), s = *(const f32x4*)((const char*)st + toff);
    f32x4 a0, a1;
    a0[0] = v0[0] * c[0] - v0[1] * s[0]; a0[1] = v0[1] * c[0] + v0[0] * s[0];
    a0[2] = v0[2] * c[1] - v0[3] * s[1]; a0[3] = v0[3] * c[1] + v0[2] * s[1];
    a1[0] = v1[0] * c[2] - v1[1] * s[2]; a1[1] = v1[1] * c[2] + v1[0] * s[2];
    a1[2] = v1[2] * c[3] - v1[3] * s[3]; a1[3] = v1[3] * c[3] + v1[2] * s[3];
    v0 = a0; v1 = a1;
  }
  __device__ __forceinline__ void vt8(unsigned char* vt, unsigned off, f32x4 v0, f32x4 v1) const {
    *(bf16_t*)(vt + off + 0 * SEQ * 2) = f2bf(v0[0]); *(bf16_t*)(vt + off + 1 * SEQ * 2) = f2bf(v0[1]); *(bf16_t*)(vt + off + 2 * SEQ * 2) = f2bf(v0[2]); *(bf16_t*)(vt + off + 3 * SEQ * 2) = f2bf(v0[3]);
    *(bf16_t*)(vt + off + 4 * SEQ * 2) = f2bf(v1[0]); *(bf16_t*)(vt + off + 5 * SEQ * 2) = f2bf(v1[1]); *(bf16_t*)(vt + off + 6 * SEQ * 2) = f2bf(v1[2]); *(bf16_t*)(vt + off + 7 * SEQ * 2) = f2bf(v1[3]);
  }
  __device__ __forceinline__ void operator()(const f32x4 (&acc)[2][2][4][2], const pg8::Unit& u, int wr, int wc, int fr, int fq) const {
    const int pn = u.pn;
    unsigned char* const big = ws + WS_BIG;
    const float* const cos64 = (const float*)(ws + WS_COS64); const float* const sin64 = (const float*)(ws + WS_SIN64);
    const float* const cos32 = (const float*)(ws + WS_COS32); const float* const sin32 = (const float*)(ws + WS_SIN32);
#pragma unroll
    for (int ai = 0; ai < 2; ++ai)
#pragma unroll
      for (int m = 0; m < 4; ++m) {
        asm volatile("" ::: "memory");
        const unsigned row = u.pm * 256 + ai * 128 + wr * 64 + m * 16 + fr;
        const unsigned b = row >> 13, pos = row & (SEQ - 1);
#pragma unroll
        for (int bj = 0; bj < 2; ++bj) {
          const unsigned col = pn * 256 + bj * 128 + wc * 32 + 8 * fq;
          f32x4 v0 = acc[ai][bj][m][0], v1 = acc[ai][bj][m][1];
          if (kind == K_RESID) {
            const unsigned o = (row * DM + col) * 4u;
            *(f32x4*)((char*)outf + o) = *(const f32x4*)((const char*)base + o) + v0; *(f32x4*)((char*)outf + o + 16) = *(const f32x4*)((const char*)base + o + 16) + v1;
          } else if (kind == K_RELU2) {
#pragma unroll
            for (int e = 0; e < 4; ++e) { float a = fmaxf(v0[e], 0.f), c = fmaxf(v1[e], 0.f); v0[e] = a * a; v1[e] = c * c; }
            store8(big, (row * FF + col) * 2u, v0, v1);
          } else if (kind == K_EVIN) {
            if (pn < 4) { const float sc = pn < 2 ? C_NA : 1.f; store8(big + B_QKNA, (row * 1024 + col) * 2u, v0 * sc, v1 * sc); }
            else if (pn < 6) { vt8(big + B_VTNA, ((b * 512 + (col - 1024)) * SEQ + vtidx(pos)) * 2u, v0, v1); }
            else if (pn == 6) { store8(big + B_CRAW, (row * 384 + (col - 1536)) * 2u, v0, v1); }
            else {
              if (bj == 0) store8(big + B_CRAW, (row * 384 + 256 + (col - 1792)) * 2u, v0, v1);
              else if (wc == 0) { rope8(v0, v1, cos32, sin32, (pos * 16 + 4 * fq) * 4u); store8(big + B_KPE, (row * 32 + 8 * fq) * 2u, v0, v1); }
            }
          } else if (kind == K_UQ) {
            if (pn == 2) rope8(v0, v1, cos32, sin32, (pos * 16 + ((col & 31) >> 1)) * 4u);
            store8(big + B_QMLA, (row * 768 + col) * 2u, v0 * C_MLA, v1 * C_MLA);
          } else if (kind == K_UKV) {
            if (pn < 2) store8(big + B_KN, (row * 512 + col) * 2u, v0, v1);
            else vt8(big + B_VTMLA, ((b * 512 + (col - 512)) * SEQ + vtidx(pos)) * 2u, v0, v1);
          } else {
            const int s = pn >> 1;
            if (s < 6) {
              rope8(v0, v1, cos64, sin64, (pos * 32 + ((col & 63) >> 1)) * 4u);
              const float sc = (s & 1) ? 1.f : C_NA;
              store8(big + B_QK, (row * 3072 + col) * 2u, v0 * sc, v1 * sc);
            } else {
              const int gq = s - 6, sh = 2 * gq;
              const unsigned lidx = ((pos & ((1u << sh) - 1)) << (13 - sh)) | (pos >> sh);
              vt8(big + B_VT, (((b * 3 + gq) * 512 + (col - s * 512)) * SEQ + vtidx(lidx)) * 2u, v0, v1);
            }
          }
        }
      }
  }
};

enum ColMap { CM_ID = 0, CM_EVIN = 1, CM_UQ = 2, CM_UKV = 3, CM_ODIN = 4 };
__device__ __forceinline__ int colmap(int kind, int n) {
  switch (kind) {
    case CM_EVIN: { if (n < 1920) return n; if (n >= 1952) return -1; const int j = n - 1920, k = j >> 1; return 1920 + ((j & 1) ? k + 16 : k); }
    case CM_UQ: { if (n < 512) return (n >> 6) * 96 + (n & 63); const int h = (n - 512) >> 5, j = (n - 512) & 31, k = j >> 1; return h * 96 + 64 + ((j & 1) ? k + 16 : k); }
    case CM_UKV: { if (n < 512) return (n >> 6) * 128 + (n & 63); const int n2 = n - 512; return (n2 >> 6) * 128 + 64 + (n2 & 63); }
    case CM_ODIN: { const int ch = n / OD_NC, n1 = n - ch * OD_NC, s = n1 >> 9, hl = (n1 & 511) >> 6, j = n1 & 63;
      int gq, t, js; if (s < 6) { gq = s >> 1; t = s & 1; const int k = j >> 1; js = (j & 1) ? k + 32 : k; } else { gq = s - 6; t = 2; js = j; }
      return ((gq * 3 + t) * 16 + (8 * ch + hl)) * 64 + js; }
    default: return n;
  }
}
__device__ __forceinline__ void transpose_item(const float* W, int K, int Nsrc, int Nout, bf16_t* WT, int cm, LAS float* scr, int item, int lane) {
  const int nblk = Nout / 32, kb = item / nblk, nb = item % nblk, k0 = 64 * kb, n0 = 32 * nb;
  const int sc = colmap(cm, n0 + (lane & 31));
#pragma unroll 8
  for (int i = 0; i < 32; ++i) { const int kk = 2 * i + (lane >> 5); scr[kk * 33 + (lane & 31)] = sc >= 0 ? W[(size_t)(k0 + kk) * Nsrc + sc] : 0.f; }
  asm volatile("s_waitcnt lgkmcnt(0)" ::: "memory");
  const int c = lane & 7;
#pragma unroll
  for (int j = 0; j < 4; ++j) { const int n = (lane >> 3) + 8 * j; const LAS float* s = scr + (8 * c) * 33 + n;
    u32x4 o; o.x = cvt_pk_bf16(s[0 * 33], s[1 * 33]); o.y = cvt_pk_bf16(s[2 * 33], s[3 * 33]); o.z = cvt_pk_bf16(s[4 * 33], s[5 * 33]); o.w = cvt_pk_bf16(s[6 * 33], s[7 * 33]);
    *(u32x4*)(WT + (size_t)(n0 + n) * K + k0 + 8 * c) = o; }
  asm volatile("s_waitcnt lgkmcnt(0)" ::: "memory");
}
__device__ __forceinline__ void rms_row_bf16(const float* xrow, const float* g, bf16_t* orow, int lane) {
  const f32x4* xr = (const f32x4*)xrow + lane; const f32x4* gr = (const f32x4*)g + lane;
  f32x4 v[4]; float s = 0.f;
#pragma unroll
  for (int j = 0; j < 4; ++j) { v[j] = xr[64 * j]; s += (v[j].x * v[j].x + v[j].y * v[j].y) + (v[j].z * v[j].z + v[j].w * v[j].w); }
  const float rstd = 1.f / sqrtf(wave_sum(s) * (1.f / DM) + RMS_EPS);
  u32x2* o8 = (u32x2*)orow + lane;
#pragma unroll
  for (int j = 0; j < 4; ++j) { const f32x4 gg = gr[64 * j]; u32x2 w; w.x = cvt_pk_bf16(v[j].x * rstd * gg.x, v[j].y * rstd * gg.y); w.y = cvt_pk_bf16(v[j].z * rstd * gg.z, v[j].w * rstd * gg.w); o8[64 * j] = w; }
}
__device__ __forceinline__ void rms_row_f32(const float* xrow, const float* g, float* orow, int lane) {
  const f32x4* xr = (const f32x4*)xrow + lane; const f32x4* gr = (const f32x4*)g + lane;
  f32x4 v[4]; float s = 0.f;
#pragma unroll
  for (int j = 0; j < 4; ++j) { v[j] = xr[64 * j]; s += (v[j].x * v[j].x + v[j].y * v[j].y) + (v[j].z * v[j].z + v[j].w * v[j].w); }
  const float rstd = 1.f / sqrtf(wave_sum(s) * (1.f / DM) + RMS_EPS);
  f32x4* o = (f32x4*)orow + lane;
#pragma unroll
  for (int j = 0; j < 4; ++j) { const f32x4 gg = gr[64 * j]; o[64 * j] = v[j] * rstd * gg; }
}
__device__ __forceinline__ void sincos_acc(float angf, float& sn, float& cs) {
  const double x = (double)angf;
  const double n = __builtin_rint(x * 0.63661977236758134308);
  double r = __builtin_fma(-n, 1.57079632679489655800e+00, x); r = __builtin_fma(-n, 6.12323399573676603587e-17, r);
  const double r2 = r * r;
  double sp = 1.0 / 6227020800.0; sp = sp * r2 - 1.0 / 39916800.0; sp = sp * r2 + 1.0 / 362880.0; sp = sp * r2 - 1.0 / 5040.0; sp = sp * r2 + 1.0 / 120.0; sp = sp * r2 - 1.0 / 6.0; sp = sp * r2 + 1.0; sp *= r;
  double cp = -1.0 / 87178291200.0; cp = cp * r2 + 1.0 / 479001600.0; cp = cp * r2 - 1.0 / 3628800.0; cp = cp * r2 + 1.0 / 40320.0; cp = cp * r2 - 1.0 / 720.0; cp = cp * r2 + 1.0 / 24.0; cp = cp * r2 - 0.5; cp = cp * r2 + 1.0;
  const int q = ((int)(long long)n) & 3;
  const double s_ = (q & 1) ? cp : sp, c_ = (q & 1) ? sp : cp;
  sn = (float)((q & 2) ? -s_ : s_);
  cs = (float)(((q + 1) & 2) ? -c_ : c_);
}

__device__ __forceinline__ void na_attn_naive(const unsigned char* big, bf16_t* att, const float* rpb, int gtid, int gsz) {
  const bf16_t* QK = (const bf16_t*)(big + B_QKNA); const bf16_t* VT = (const bf16_t*)(big + B_VTNA);
  for (int idx = gtid; idx < M * 8; idx += gsz) {
    const int m = idx & (M - 1), h = idx >> 14, b = m >> 13, pos = m & (SEQ - 1), r = pos >> 6, c = pos & 63;
    const int rs = min(max(r - 4, 0), 120), cs = min(max(c - 8, 0), 48);
    float q[64], o[64];
#pragma unroll
    for (int j = 0; j < 8; ++j) unpack8(*(const u32x4*)(QK + (size_t)m * 1024 + h * 64 + 8 * j), q + 8 * j);
#pragma unroll
    for (int d = 0; d < 64; ++d) o[d] = 0.f;
    float mx = NEG_BIG, l = 0.f;
    for (int i = 0; i < 8; ++i)
      for (int jj = 0; jj < 16; ++jj) {
        const int kr = rs + i, kc = cs + jj, kp = kr * 64 + kc; const size_t mk = (size_t)b * SEQ + kp;
        float s = 0.f;
#pragma unroll
        for (int j = 0; j < 8; ++j) { float kf[8]; unpack8(*(const u32x4*)(QK + mk * 1024 + 512 + h * 64 + 8 * j), kf);
#pragma unroll
          for (int e = 0; e < 8; ++e) s += q[8 * j + e] * kf[e]; }
        s += rpb[(h * 15 + (kr - r + 7)) * 31 + (kc - c + 15)] * LOG2E;
        const float mn = fmaxf(mx, s), al = exp2f(mx - mn), p = exp2f(s - mn);
        l = l * al + p; mx = mn;
        const bf16_t* vp = VT + ((size_t)(b * 8 + h) * 64) * SEQ + vtidx(kp);
#pragma unroll
        for (int d = 0; d < 64; ++d) o[d] = o[d] * al + p * bf2f(vp[(size_t)d * SEQ]);
      }
    const float il = 1.f / l;
#pragma unroll
    for (int j = 0; j < 8; ++j) { u32x4 w; w.x = cvt_pk_bf16(o[8 * j] * il, o[8 * j + 1] * il); w.y = cvt_pk_bf16(o[8 * j + 2] * il, o[8 * j + 3] * il);
      w.z = cvt_pk_bf16(o[8 * j + 4] * il, o[8 * j + 5] * il); w.w = cvt_pk_bf16(o[8 * j + 6] * il, o[8 * j + 7] * il);
      *(u32x4*)(att + (size_t)m * 1024 + h * 64 + 8 * j) = w; }
  }
}
__device__ __forceinline__ void mla_attn_naive(const unsigned char* big, bf16_t* att, int gtid, int gsz) {
  const bf16_t* Q = (const bf16_t*)(big + B_QMLA); const bf16_t* KN = (const bf16_t*)(big + B_KN); const bf16_t* KPE = (const bf16_t*)(big + B_KPE); const bf16_t* VT = (const bf16_t*)(big + B_VTMLA);
  for (int idx = gtid; idx < M * 8; idx += gsz) {
    const int m = idx & (M - 1), h = __builtin_amdgcn_readfirstlane(idx >> 14), b = __builtin_amdgcn_readfirstlane(m >> 13);
    float q[96], o[64];
#pragma unroll
    for (int j = 0; j < 8; ++j) unpack8(*(const u32x4*)(Q + (size_t)m * 768 + h * 64 + 8 * j), q + 8 * j);
#pragma unroll
    for (int j = 0; j < 4; ++j) unpack8(*(const u32x4*)(Q + (size_t)m * 768 + 512 + h * 32 + 8 * j), q + 64 + 8 * j);
#pragma unroll
    for (int d = 0; d < 64; ++d) o[d] = 0.f;
    float mx = NEG_BIG, l = 0.f;
    for (int kb = 0; kb < SEQ / 16; ++kb) {
      float s[16];
#pragma unroll
      for (int t = 0; t < 16; ++t) {
        const size_t mk = (size_t)b * SEQ + kb * 16 + t; float a = 0.f;
#pragma unroll
        for (int j = 0; j < 8; ++j) { float kf[8]; unpack8(*(const u32x4*)(KN + mk * 512 + h * 64 + 8 * j), kf);
#pragma unroll
          for (int e = 0; e < 8; ++e) a += q[8 * j + e] * kf[e]; }
#pragma unroll
        for (int j = 0; j < 4; ++j) { float kf[8]; unpack8(*(const u32x4*)(KPE + mk * 32 + 8 * j), kf);
#pragma unroll
          for (int e = 0; e < 8; ++e) a += q[64 + 8 * j + e] * kf[e]; }
        s[t] = a;
      }
      float bm = s[0];
#pragma unroll
      for (int t = 1; t < 16; ++t) bm = fmaxf(bm, s[t]);
      const float mn = fmaxf(mx, bm), al = exp2f(mx - mn); mx = mn;
      float ps = 0.f;
#pragma unroll
      for (int t = 0; t < 16; ++t) { s[t] = exp2f(s[t] - mn); ps += s[t]; }
      l = l * al + ps;
      const bf16_t* vp = VT + ((size_t)(b * 8 + h) * 64) * SEQ + kb * 16;
#pragma unroll
      for (int d = 0; d < 64; ++d) {
        float vf[16]; unpack8(*(const u32x4*)(vp + (size_t)d * SEQ), vf); unpack8(*(const u32x4*)(vp + (size_t)d * SEQ + 8), vf + 8);
        float a = o[d] * al;
#pragma unroll
        for (int t = 0; t < 16; ++t) a += s[(t & 3) | ((t & 4) << 1) | ((t & 8) >> 1)] * vf[t];
        o[d] = a;
      }
    }
    const float il = 1.f / l;
#pragma unroll
    for (int j = 0; j < 8; ++j) { u32x4 w; w.x = cvt_pk_bf16(o[8 * j] * il, o[8 * j + 1] * il); w.y = cvt_pk_bf16(o[8 * j + 2] * il, o[8 * j + 3] * il);
      w.z = cvt_pk_bf16(o[8 * j + 4] * il, o[8 * j + 5] * il); w.w = cvt_pk_bf16(o[8 * j + 6] * il, o[8 * j + 7] * il);
      *(u32x4*)(att + (size_t)m * 1024 + 512 + h * 64 + 8 * j) = w; }
  }
}
__device__ __forceinline__ void dil_attn_naive(const unsigned char* big, bf16_t* att, int ch, int gtid, int gsz) {
  const bf16_t* QK = (const bf16_t*)(big + B_QK); const bf16_t* VT = (const bf16_t*)(big + B_VT);
  for (int idx = gtid; idx < M * 8; idx += gsz) {
    const int m = idx & (M - 1), hl = idx >> 14, b = m >> 13, pos = m & (SEQ - 1);
    float o[64];
#pragma unroll
    for (int d = 0; d < 64; ++d) o[d] = 0.f;
    float mx = NEG_BIG, l = 0.f;
    for (int gq = 0; gq < 3; ++gq) {
      const int sh = 2 * gq, dg = 1 << sh;
      float q[64];
#pragma unroll
      for (int j = 0; j < 8; ++j) unpack8(*(const u32x4*)(QK + (size_t)m * 3072 + gq * 1024 + hl * 64 + 8 * j), q + 8 * j);
      for (int jj = -64; jj <= 64; ++jj) {
        const int kp = pos + jj * dg;
        if (kp < 0 || kp >= SEQ) continue;
        const size_t mk = (size_t)b * SEQ + kp;
        float s = 0.f;
#pragma unroll
        for (int j = 0; j < 8; ++j) { float kf[8]; unpack8(*(const u32x4*)(QK + mk * 3072 + gq * 1024 + 512 + hl * 64 + 8 * j), kf);
#pragma unroll
          for (int e = 0; e < 8; ++e) s += q[8 * j + e] * kf[e]; }
        const float mn = fmaxf(mx, s), al = exp2f(mx - mn), p = exp2f(s - mn);
        l = l * al + p; mx = mn;
        const int lidx = ((kp & (dg - 1)) << (13 - sh)) | (kp >> sh);
        const bf16_t* vp = VT + ((size_t)((b * 3 + gq) * 8 + hl) * 64) * SEQ + vtidx(lidx);
#pragma unroll
        for (int d = 0; d < 64; ++d) o[d] = o[d] * al + p * bf2f(vp[(size_t)d * SEQ]);
      }
    }
    const float il = 1.f / l;
#pragma unroll
    for (int j = 0; j < 8; ++j) { u32x4 w; w.x = cvt_pk_bf16(o[8 * j] * il, o[8 * j + 1] * il); w.y = cvt_pk_bf16(o[8 * j + 2] * il, o[8 * j + 3] * il);
      w.z = cvt_pk_bf16(o[8 * j + 4] * il, o[8 * j + 5] * il); w.w = cvt_pk_bf16(o[8 * j + 6] * il, o[8 * j + 7] * il);
      *(u32x4*)(att + (size_t)m * 1024 + (8 * ch + hl) * 64 + 8 * j) = w; }
  }
}

__global__ void __launch_bounds__(256) k_na_naive(unsigned char* big, bf16_t* att, const float* rpb) { na_attn_naive(big, att, rpb, blockIdx.x * 256 + threadIdx.x, gridDim.x * 256); }
__global__ void __launch_bounds__(256) k_mla_naive(unsigned char* big, bf16_t* att) { mla_attn_naive(big, att, blockIdx.x * 256 + threadIdx.x, gridDim.x * 256); }
__global__ void __launch_bounds__(256) k_dil_naive(unsigned char* big, bf16_t* att, int ch) { dil_attn_naive(big, att, ch, blockIdx.x * 256 + threadIdx.x, gridDim.x * 256); }

__device__ __forceinline__ const void* ldptr(LAS unsigned char* lds, int i) {
  const volatile LAS unsigned* p = (const volatile LAS unsigned*)(lds + 131072) + 2 * i;
  const unsigned lo = __builtin_amdgcn_readfirstlane(p[0]), hi = __builtin_amdgcn_readfirstlane(p[1]);
  return (const void*)(((unsigned long long)hi << 32) | lo);
}
struct Args { const float* in[15]; float* out; unsigned char* ws; int ph_lo, ph_hi; };

__global__ void __launch_bounds__(512, 2) fwd(Args a) {
  extern __shared__ __attribute__((aligned(16))) unsigned char lds_raw[];
  LAS unsigned char* lds = (LAS unsigned char*)lds_raw;
  cg::grid_group grid = cg::this_grid();
  const int G = gridDim.x, bx = blockIdx.x;
  const int gsz = G * 512, NGW = G * 8;
  if (threadIdx.x < 15) ((LAS unsigned long long*)(lds + 131072))[threadIdx.x] = (unsigned long long)a.in[threadIdx.x];
  if (threadIdx.x == 15) ((LAS unsigned long long*)(lds + 131072))[15] = (unsigned long long)a.out;
  if (threadIdx.x == 16) ((LAS unsigned long long*)(lds + 131072))[16] = (unsigned long long)a.ws;
  __syncthreads();
#define INP(i) ((const float*)ldptr(lds, (i)))

#ifdef ONE_LAUNCH
  for (int ph = a.ph_lo; ph < a.ph_hi; ++ph) {
#else
  { const int ph = a.ph_lo;
#endif
    int tid = threadIdx.x; asm volatile("" : "+v"(tid));
    const int lane = tid & 63, wave = __builtin_amdgcn_readfirstlane(tid >> 6), gtid = bx * 512 + tid, gw = bx * 8 + wave;
    unsigned char* ws = a.ws;
    float* X = a.out;
    unsigned char* big = ws + WS_BIG;
    bf16_t* XN = (bf16_t*)(ws + WS_XN); bf16_t* ATT = (bf16_t*)(ws + WS_ATT);
    const float* cos64 = (const float*)(ws + WS_COS64); const float* sin64 = (const float*)(ws + WS_SIN64);
    const float* cos32 = (const float*)(ws + WS_COS32); const float* sin32 = (const float*)(ws + WS_SIN32);
    if (ph == NPH - 1) {
      for (int m = gw; m < M; m += NGW) rms_row_f32(X + (size_t)m * DM, INP(3), X + (size_t)m * DM, lane);
    } else {
      const int L = ph / 9, k = ph % 9, e = L >> 1; const bool even = !(L & 1);
      const float* xsrc = (L == 0) ? INP(0) : X;
      if (k == 0) {
        if (L == 0) {
          for (int i = gtid; i < SEQ * 32; i += gsz) { const int pos = i >> 5, kk = i & 31; float sn, cs; sincos_acc((float)pos * INV64[kk], sn, cs); ((float*)cos64)[i] = cs; ((float*)sin64)[i] = sn; }
          for (int i = gtid; i < SEQ * 16; i += gsz) { const int pos = i >> 4, kk = i & 15; float sn, cs; sincos_acc((float)pos * INV64[2 * kk], sn, cs); ((float*)cos32)[i] = cs; ((float*)sin32)[i] = sn; }
        }
        LAS float* scr = (LAS float*)(lds + wave * 16384);
        const float* w1 = INP(13) + (size_t)L * DM * FF; const float* w2 = INP(14) + (size_t)L * FF * DM;
        const float* wo = even ? INP(10) + (size_t)e * DM * DM : INP(12) + (size_t)e * DM * DM;
        const int nin = even ? EV_N : 2 * OD_NC;
        const int I_IN = 16 * (nin / 32), I_O = 16 * 32, I_1 = 16 * 128, I_2 = 64 * 32, I_UQ = even ? 4 * 24 : 0, I_UKV = even ? 2 * 32 : 0;
        const int NIT = I_IN + I_O + I_1 + I_2 + I_UQ + I_UKV;
        for (int it = gw; it < NIT; it += NGW) {
          int r = it;
          if (r < I_IN) { if (even) transpose_item(INP(4) + (size_t)e * DM * 1952, DM, 1952, EV_N, (bf16_t*)(ws + WS_W + W_IN), CM_EVIN, scr, r, lane);
                          else transpose_item(INP(11) + (size_t)e * DM * 9216, DM, 9216, 2 * OD_NC, (bf16_t*)(ws + WS_W + W_IN), CM_ODIN, scr, r, lane); continue; } r -= I_IN;
          if (r < I_O) { transpose_item(wo, DM, DM, DM, (bf16_t*)(ws + WS_W + W_O), CM_ID, scr, r, lane); continue; } r -= I_O;
          if (r < I_1) { transpose_item(w1, DM, FF, FF, (bf16_t*)(ws + WS_W + W_1), CM_ID, scr, r, lane); continue; } r -= I_1;
          if (r < I_2) { transpose_item(w2, FF, DM, DM, (bf16_t*)(ws + WS_W + W_2), CM_ID, scr, r, lane); continue; } r -= I_2;
          if (r < I_UQ) { transpose_item(INP(7) + (size_t)e * 256 * 768, 256, 768, 768, (bf16_t*)(ws + WS_W + W_UQ), CM_UQ, scr, r, lane); continue; } r -= I_UQ;
          transpose_item(INP(9) + (size_t)e * 128 * 1024, 128, 1024, 1024, (bf16_t*)(ws + WS_W + W_UKV), CM_UKV, scr, r, lane);
        }
        for (int m = gw; m < M; m += NGW) rms_row_bf16(xsrc + (size_t)m * DM, INP(1) + L * DM, XN + (size_t)m * DM, lane);
      } else if (k == 6) {
        for (int m = gw; m < M; m += NGW) rms_row_bf16(X + (size_t)m * DM, INP(2) + L * DM, XN + (size_t)m * DM, lane);
      } else if (even && k == 2) {
        const bf16_t* CR = (const bf16_t*)(big + B_CRAW); bf16_t* CQN = (bf16_t*)(big + B_CQN); bf16_t* CKVN = (bf16_t*)(big + B_CKVN);
        const float* gq = INP(6) + e * 256; const float* gkv = INP(8) + e * 128;
        for (int m = gw; m < M; m += NGW) {
          const u32x2 w = *(const u32x2*)(CR + (size_t)m * 384 + 4 * lane);
          const float v0 = bflo(w.x), v1 = bfhi(w.x), v2 = bflo(w.y), v3 = bfhi(w.y);
          const float rq = 1.f / sqrtf(wave_sum(v0 * v0 + v1 * v1 + v2 * v2 + v3 * v3) * (1.f / 256.f) + RMS_EPS);
          const f32x4 g4 = *(const f32x4*)(gq + 4 * lane);
          u32x2 o; o.x = cvt_pk_bf16(v0 * rq * g4.x, v1 * rq * g4.y); o.y = cvt_pk_bf16(v2 * rq * g4.z, v3 * rq * g4.w);
          *(u32x2*)(CQN + (size_t)m * 256 + 4 * lane) = o;
          const unsigned w2 = *(const unsigned*)(CR + (size_t)m * 384 + 256 + 2 * lane);
          const float u0 = bflo(w2), u1 = bfhi(w2);
          const float rk = 1.f / sqrtf(wave_sum(u0 * u0 + u1 * u1) * (1.f / 128.f) + RMS_EPS);
          const f32x2 g2 = *(const f32x2*)(gkv + 2 * lane);
          *(unsigned*)(CKVN + (size_t)m * 128 + 2 * lane) = cvt_pk_bf16(u0 * rk * g2.x, u1 * rk * g2.y);
        }
      } else if (even && k == 4) {
#ifdef NAIVE_ATTN
#endif
      } else if (!even && (k == 2 || k == 4)) {
      } else {
        const int nsub = (even && k == 3) ? 2 : 1;
        for (int sub = 0; sub < nsub; ++sub) {
          pg8::Gemm g; pg8::StaticOrder S; EpiB E; E.ws = ws;
          g.M = M;
          E.base = (k == 5) ? xsrc : X; E.outf = X;
          if (k == 5) { g.A = ATT; g.Bt = (const bf16_t*)(ws + WS_W + W_O); g.N = DM; g.K = DM; E.kind = K_RESID; }
          else if (k == 8) { g.A = (const bf16_t*)big; g.Bt = (const bf16_t*)(ws + WS_W + W_2); g.N = DM; g.K = FF; E.kind = K_RESID; }
          else if (k == 7) { g.A = XN; g.Bt = (const bf16_t*)(ws + WS_W + W_1); g.N = FF; g.K = DM; E.kind = K_RELU2; }
          else if (even && k == 1) { g.A = XN; g.Bt = (const bf16_t*)(ws + WS_W + W_IN); g.N = EV_N; g.K = DM; E.kind = K_EVIN; }
          else if (even) {
            if (sub == 0) { g.A = (const bf16_t*)(big + B_CQN); g.Bt = (const bf16_t*)(ws + WS_W + W_UQ); g.N = 768; g.K = 256; E.kind = K_UQ; }
            else { g.A = (const bf16_t*)(big + B_CKVN); g.Bt = (const bf16_t*)(ws + WS_W + W_UKV); g.N = 1024; g.K = 128; E.kind = K_UKV; }
          } else { const int ch = (k == 1) ? 0 : 1; g.A = XN; g.Bt = (const bf16_t*)(ws + WS_W + W_IN) + (size_t)ch * OD_NC * DM; g.N = OD_NC; g.K = DM; E.kind = K_ODIN; }
          S.init(M, g.N, G, bx);
          pg8::gemm_phase<EpiB>(lds, g, S, E);
        }
      }
    }
#ifdef ONE_LAUNCH
    if (ph + 1 < a.ph_hi) grid.sync();
#endif
  }
}

extern "C" void kernel_launch(void* const* d_in, const int* in_sizes, int n_in, void* d_out, int out_size, void* d_ws, size_t ws_size, hipStream_t stream) {
  static int grid = 0;
  if (!grid) {
    if (n_in != 15 || out_size != M * DM || ws_size < WS_END) { fprintf(stderr, "kernel_launch: unexpected sizes n_in %d out %d ws %zu (need %zu)\n", n_in, out_size, ws_size, (size_t)WS_END); grid = -1; return; }
    int dev = 0, cus = 0, per_cu = 0;
    (void)hipGetDevice(&dev);
    (void)hipDeviceGetAttribute(&cus, hipDeviceAttributeMultiprocessorCount, dev);
    (void)hipFuncSetAttribute((const void*)fwd, hipFuncAttributeMaxDynamicSharedMemorySize, LDS_BYTES);
    (void)hipOccupancyMaxActiveBlocksPerMultiprocessor(&per_cu, (const void*)fwd, 512, LDS_BYTES);
    if (per_cu < 1) per_cu = 1;
    grid = cus * per_cu;
  }
  if (grid < 0) return;
  Args a{};
  for (int i = 0; i < 15; ++i) a.in[i] = (const float*)d_in[i];
  a.out = (float*)d_out; a.ws = (unsigned char*)d_ws;
#ifndef ONE_LAUNCH
  for (int ph = 0; ph < NPH; ++ph) {
    a.ph_lo = ph; a.ph_hi = ph + 1;
    const int L = ph / 9, k = ph % 9, e = L >> 1; const bool even = !(L & 1);
    unsigned char* big = (unsigned char*)d_ws + WS_BIG; bf16_t* ATT = (bf16_t*)((unsigned char*)d_ws + WS_ATT);
    if (ph < NPH - 1 && even && k == 4) {
      hipLaunchKernelGGL(k_na_naive, dim3(512), dim3(256), 0, stream, big, ATT, (const float*)d_in[5] + (size_t)e * 8 * 15 * 31);
      hipLaunchKernelGGL(k_mla_naive, dim3(512), dim3(256), 0, stream, big, ATT);
    } else if (ph < NPH - 1 && !even && (k == 2 || k == 4)) {
      hipLaunchKernelGGL(k_dil_naive, dim3(512), dim3(256), 0, stream, big, ATT, (k == 2) ? 0 : 1);
    } else {
      hipLaunchKernelGGL(fwd, dim3(grid), dim3(512), LDS_BYTES, stream, a);
    }
  }
#else
  a.ph_lo = 0; a.ph_hi = NPH;
  void* args[] = {&a};
  hipError_t er = hipLaunchCooperativeKernel((const void*)fwd, dim3(grid), dim3(512), args, LDS_BYTES, stream);
  if (er != hipSuccess) fprintf(stderr, "cooperative launch failed: %s (grid %d)\n", hipGetErrorString(er), grid);
#endif
}
```

```cpp
#include <hip/hip_runtime.h>
#include <hip/hip_cooperative_groups.h>
#include <cstdio>
#include <cstdint>
namespace cg = cooperative_groups;
#define ONE_LAUNCH 1

#define LAS __attribute__((address_space(3)))
typedef unsigned short bf16_t;
typedef short bf16x8 __attribute__((ext_vector_type(8)));
typedef float f32x4 __attribute__((ext_vector_type(4)));
typedef float f32x2 __attribute__((ext_vector_type(2)));
typedef float f32x16 __attribute__((ext_vector_type(16)));
typedef unsigned u32x4 __attribute__((ext_vector_type(4)));
typedef unsigned u32x2 __attribute__((ext_vector_type(2)));

constexpr int M = 16384, SEQ = 8192, DM = 1024, FF = 4096;
constexpr int EV_N = 2048;
constexpr int OD_NC = 4608;
constexpr float LOG2E = 1.4426950408889634f;
constexpr float C_NA = 0.125f * LOG2E;
constexpr float C_MLA = 0.10206207261596575f * LOG2E;
constexpr float RMS_EPS = 1e-6f;
constexpr float NEG_BIG = -1e30f;

constexpr size_t MiB = 1u << 20;
constexpr size_t WS_COS64 = 1 * MiB, WS_SIN64 = 2 * MiB, WS_COS32 = 3 * MiB, WS_SIN32 = 3 * MiB + 512 * 1024;
constexpr size_t WS_W = 4 * MiB;
constexpr size_t W_IN = 0, W_O = 18 * MiB, W_1 = 20 * MiB, W_2 = 28 * MiB, W_UQ = 36 * MiB, W_UKV = 36 * MiB + 512 * 1024;
constexpr size_t WS_XN = 41 * MiB;
constexpr size_t WS_ATT = 73 * MiB;
constexpr size_t WS_BIG = 105 * MiB;
constexpr size_t B_QKNA = 0, B_VTNA = 32 * MiB, B_CRAW = 48 * MiB, B_CQN = 60 * MiB, B_CKVN = 68 * MiB, B_KPE = 72 * MiB,
                 B_QMLA = 73 * MiB, B_KN = 97 * MiB, B_VTMLA = 113 * MiB;
constexpr size_t B_QK = 0, B_VT = 96 * MiB, B_LSE = 144 * MiB;
constexpr size_t WS_END = WS_BIG + 146 * MiB;

constexpr int LDS_BYTES = 147456;
constexpr int NPH = 37;

__device__ const float INV64[32] = {
  1.000000000e+00f, 7.498942018e-01f, 5.623413324e-01f, 4.216965139e-01f, 3.162277639e-01f, 2.371373922e-01f, 1.778279394e-01f, 1.333521456e-01f,
  1.000000015e-01f, 7.498941571e-02f, 5.623412877e-02f, 4.216964915e-02f, 3.162277862e-02f, 2.371373586e-02f, 1.778279431e-02f, 1.333521493e-02f,
  9.999999776e-03f, 7.498942316e-03f, 5.623413250e-03f, 4.216964822e-03f, 3.162277862e-03f, 2.371373819e-03f, 1.778279431e-03f, 1.333521446e-03f,
  1.000000047e-03f, 7.498941850e-04f, 5.623413017e-04f, 4.216965463e-04f, 3.162277862e-04f, 2.371373848e-04f, 1.778279402e-04f, 1.333521504e-04f};

__device__ __forceinline__ unsigned cvt_pk_bf16(float lo, float hi) { unsigned r; asm volatile("v_cvt_pk_bf16_f32 %0, %1, %2" : "=v"(r) : "v"(lo), "v"(hi)); return r; }
__device__ __forceinline__ bf16_t f2bf(float f) { return (bf16_t)(cvt_pk_bf16(f, 0.f) & 0xffffu); }
__device__ __forceinline__ float bf2f(unsigned short h) { return __uint_as_float(((unsigned)h) << 16); }
__device__ __forceinline__ float bflo(unsigned w) { return __uint_as_float(w << 16); }
__device__ __forceinline__ float bfhi(unsigned w) { return __uint_as_float(w & 0xffff0000u); }
__device__ __forceinline__ int vtidx(int p) { return (p & ~12) | ((p & 4) << 1) | ((p & 8) >> 1); }
__device__ __forceinline__ float wave_sum(float v) {
#pragma unroll
  for (int o = 1; o < 64; o <<= 1) v += __shfl_xor(v, o);
  return v;
}
__device__ __forceinline__ void unpack8(const u32x4 w, float* f) {
  f[0] = bflo(w.x); f[1] = bfhi(w.x); f[2] = bflo(w.y); f[3] = bfhi(w.y); f[4] = bflo(w.z); f[5] = bfhi(w.z); f[6] = bflo(w.w); f[7] = bfhi(w.w);
}

namespace pg8 {
constexpr int BM = 256, BK = 64, HALF = 128, HTB = HALF * BK * 2, STAGE_BYTES = 8 * HTB, NXCD = 8, WGM = 8;
__host__ __device__ __forceinline__ int lds_byte(int r, int c) { const int st = (r >> 4) * 2 + (c >> 5), rr = r & 15, cc = c & 31, ob = rr * 64 + cc * 2; return st * 1024 + (ob ^ (((ob >> 9) & 1) << 5)); }
__host__ __device__ __forceinline__ void stage_rc(int b, int& R, int& C) { const int st = b / 1024, sb = b % 1024, swz = sb ^ (((sb >> 9) & 1) << 5); R = (st >> 1) * 16 + swz / 64; C = (st & 1) * 32 + (swz % 64) / 2; }
__host__ __device__ __forceinline__ int perm32(int rho) { const int n = rho >> 4, i = rho & 15; return 8 * (i >> 2) + 4 * n + (i & 3); }

struct Unit { int pm, pn; };
struct Gemm { const bf16_t* A; const bf16_t* Bt; int M, N, K; };
struct StaticOrder {
  int nM, nN, nwg, G, c;
  __device__ void init(int M_, int N_, int G_, int c_) { nM = M_ / BM; nN = N_ / BM; nwg = nM * nN; G = G_; c = c_; }
  __device__ bool next(int i, Unit& u) const {
    const long L = (long)i * G + c; if (L >= nwg) return false;
    int wgid = (int)L; { const int q = nwg / NXCD, r = nwg % NXCD, xcd = wgid % NXCD, off = wgid / NXCD; wgid = (xcd < r ? xcd * (q + 1) : r * (q + 1) + (xcd - r) * q) + off; }
    const int nig = WGM * nN, gid = wgid / nig, fm = gid * WGM, gsz = (nM - fm) < WGM ? (nM - fm) : WGM;
    u.pm = fm + ((wgid % nig) % gsz); u.pn = (wgid % nig) / gsz; return true;
  }
};

template <class Epi>
__device__ __forceinline__ void gemm_phase(LAS unsigned char* lds, const Gemm g, const StaticOrder& S, const Epi& E) {
  int tid = threadIdx.x; asm volatile("" : "+v"(tid));
  const int wid = __builtin_amdgcn_readfirstlane(tid >> 6), lane = tid & 63, wr = wid >> 2, wc = wid & 3, fr = lane & 15, fq = lane >> 4;
  constexpr bool PERM = true; const int K = g.K, nt = K / BK;
  unsigned voffA[2], voffB[2];
#pragma unroll
  for (int i = 0; i < 2; ++i) { int R, C; stage_rc(tid * 16 + i * 8192, R, C); const int Rb = PERM ? ((R & ~31) + perm32(R & 31)) : R;
    voffA[i] = (unsigned)(R * K + C) * 2u; voffB[i] = (unsigned)(Rb * K + C) * 2u; }
  const size_t kstep = (size_t)(BK * 2);
  const size_t hstep = (size_t)HALF * K * 2;
  const size_t tstep = 2 * hstep;
  const unsigned ldsw = (unsigned)wid * 1024u;
  const int aoff = lds_byte(wr * 64 + fr, fq * 8), boff = lds_byte(wc * 32 + fr, fq * 8);
#define PG8_SA(b, h) (((b) * 2 + (h)) * HTB)
#define PG8_SB(b, h) ((4 + (b) * 2 + (h)) * HTB)
#define PG8_STAGE(bufoff, gbase, voff) do { _Pragma("unroll") for (int _i = 0; _i < 2; ++_i) \
    __builtin_amdgcn_global_load_lds((const unsigned*)((const char*)(gbase) + (voff)[_i]), (LAS unsigned*)(lds + (bufoff) + ldsw + _i * 8192), 16, 0, 0); } while (0)
#define PG8_LDA(dst, b, h) do { _Pragma("unroll") for (int m = 0; m < 4; ++m) _Pragma("unroll") for (int k = 0; k < 2; ++k) dst[m][k] = *(const LAS bf16x8*)(lds + PG8_SA(b, h) + aoff + m * 2048 + k * 1024); } while (0)
#define PG8_LDB(dst, b, h) do { _Pragma("unroll") for (int n = 0; n < 2; ++n) _Pragma("unroll") for (int k = 0; k < 2; ++k) dst[n][k] = *(const LAS bf16x8*)(lds + PG8_SB(b, h) + boff + n * 2048 + k * 1024); } while (0)
#define PG8_MMA(ai, bj, At, Bt) do { __builtin_amdgcn_s_setprio(1); _Pragma("unroll") for (int m = 0; m < 4; ++m) _Pragma("unroll") for (int n = 0; n < 2; ++n) _Pragma("unroll") for (int k = 0; k < 2; ++k) \
    acc[ai][bj][m][n] = __builtin_amdgcn_mfma_f32_16x16x32_bf16(Bt[n][k], At[m][k], acc[ai][bj][m][n], 0, 0, 0); __builtin_amdgcn_s_setprio(0); } while (0)
#define PG8_WAIT_V(n) asm volatile("s_waitcnt vmcnt(" #n ")" ::: "memory")
#define PG8_WAIT_L(n) asm volatile("s_waitcnt lgkmcnt(" #n ")" ::: "memory")
#define PG8_BAR __builtin_amdgcn_s_barrier()
#define PG8_SCHED __builtin_amdgcn_sched_barrier(0)
  Unit cur, nxt; int ui = 0;
  if (!S.next(0, cur)) return;
  f32x4 acc[2][2][4][2];
#pragma unroll
  for (int a = 0; a < 2; ++a)
#pragma unroll
    for (int b = 0; b < 2; ++b)
#pragma unroll
      for (int m = 0; m < 4; ++m)
#pragma unroll
        for (int n = 0; n < 2; ++n) acc[a][b][m][n] = (f32x4){0.f, 0.f, 0.f, 0.f};
  bf16x8 At[4][2], B0[2][2], B1[2][2];
  const char* cA = (const char*)g.A + (size_t)cur.pm * tstep; const char* cB = (const char*)g.Bt + (size_t)cur.pn * tstep;
  PG8_STAGE(PG8_SB(0, 0), cB, voffB); PG8_STAGE(PG8_SB(0, 1), cB + hstep, voffB); PG8_STAGE(PG8_SA(0, 0), cA, voffA); PG8_STAGE(PG8_SA(0, 1), cA + hstep, voffA);
  if (wr == 1) PG8_BAR;
  PG8_WAIT_V(2); PG8_BAR;
  PG8_STAGE(PG8_SB(1, 0), cB + kstep, voffB); PG8_STAGE(PG8_SA(1, 0), cA + kstep, voffA); PG8_STAGE(PG8_SB(1, 1), cB + hstep + kstep, voffB);
  PG8_WAIT_V(6); PG8_BAR;
  for (;;) {
    const bool has_next = S.next(ui + 1, nxt);
    const char* nA = has_next ? (const char*)g.A + (size_t)nxt.pm * tstep : cA; const char* nB = has_next ? (const char*)g.Bt + (size_t)nxt.pn * tstep : cB;
    for (int t = 0; t < nt; t += 2) {
      const bool last = (t == nt - 2);
      const char* a1 = cA + (size_t)(t + 1) * kstep;
      const char* a2 = last ? nA : cA + (size_t)(t + 2) * kstep; const char* b2 = last ? nB : cB + (size_t)(t + 2) * kstep;
      const char* a3 = a2 + kstep; const char* b3 = b2 + kstep;
      PG8_LDB(B0, 0, 0); PG8_LDB(B1, 0, 1); PG8_SCHED; PG8_LDA(At, 0, 0); PG8_STAGE(PG8_SA(1, 1), a1 + hstep, voffA);
      PG8_WAIT_V(8); PG8_WAIT_L(0); PG8_BAR; PG8_MMA(0, 0, At, B0); PG8_MMA(0, 1, At, B1); PG8_BAR; PG8_SCHED;
      PG8_LDA(At, 0, 1); PG8_STAGE(PG8_SB(0, 0), b2, voffB); PG8_STAGE(PG8_SB(0, 1), b2 + hstep, voffB); PG8_STAGE(PG8_SA(0, 0), a2, voffA);
      PG8_WAIT_V(8); PG8_WAIT_L(0); PG8_BAR; PG8_MMA(1, 0, At, B0); PG8_MMA(1, 1, At, B1); PG8_BAR; PG8_SCHED;
      PG8_LDB(B0, 1, 0); PG8_LDB(B1, 1, 1); PG8_SCHED; PG8_LDA(At, 1, 0); PG8_STAGE(PG8_SA(0, 1), a2 + hstep, voffA);
      PG8_WAIT_V(8); PG8_WAIT_L(0); PG8_BAR; PG8_MMA(0, 0, At, B0); PG8_MMA(0, 1, At, B1); PG8_BAR; PG8_SCHED;
      PG8_LDA(At, 1, 1); PG8_STAGE(PG8_SB(1, 0), b3, voffB); PG8_STAGE(PG8_SB(1, 1), b3 + hstep, voffB); PG8_STAGE(PG8_SA(1, 0), a3, voffA);
      PG8_WAIT_V(8); PG8_WAIT_L(0); PG8_BAR; PG8_MMA(1, 0, At, B0); PG8_MMA(1, 1, At, B1); PG8_BAR; PG8_SCHED;
    }
    if (wr == 0) PG8_BAR;
    E(acc, cur, wr, wc, fr, fq);
    if (!has_next) break;
#pragma unroll
    for (int a = 0; a < 2; ++a)
#pragma unroll
      for (int b = 0; b < 2; ++b)
#pragma unroll
        for (int m = 0; m < 4; ++m)
#pragma unroll
          for (int n = 0; n < 2; ++n) acc[a][b][m][n] = (f32x4){0.f, 0.f, 0.f, 0.f};
    cur = nxt; cA = nA; cB = nB; ++ui;
    if (wr == 1) PG8_BAR;
  }
  PG8_WAIT_V(0);
  PG8_BAR;
#undef PG8_SA
#undef PG8_SB
#undef PG8_STAGE
#undef PG8_LDA
#undef PG8_LDB
#undef PG8_MMA
#undef PG8_WAIT_V
#undef PG8_WAIT_L
#undef PG8_BAR
#undef PG8_SCHED
}
}

enum EpiKind { K_EVIN = 0, K_UQ = 1, K_UKV = 2, K_ODIN = 3, K_RELU2 = 4, K_RESID = 5 };
struct EpiB {
  int kind;
  unsigned char* ws;
  const float* base; float* outf;
  __device__ __forceinline__ void store8(unsigned char* b, unsigned off, f32x4 v0, f32x4 v1) const {
    u32x4 w; w.x = cvt_pk_bf16(v0[0], v0[1]); w.y = cvt_pk_bf16(v0[2], v0[3]); w.z = cvt_pk_bf16(v1[0], v1[1]); w.w = cvt_pk_bf16(v1[2], v1[3]);
    *(u32x4*)(b + off) = w;
  }
  __device__ __forceinline__ void rope8(f32x4& v0, f32x4& v1, const float* ct, const float* st, unsigned toff) const {
    const f32x4 c = *(const f32x4*)((const char*)ct + toff), s = *(const f32x4*)((const char*)st + toff);
    f32x4 a0, a1;
    a0[0] = v0[0] * c[0] - v0[1] * s[0]; a0[1] = v0[1] * c[0] + v0[0] * s[0];
    a0[2] = v0[2] * c[1] - v0[3] * s[1]; a0[3] = v0[3] * c[1] + v0[2] * s[1];
    a1[0] = v1[0] * c[2] - v1[1] * s[2]; a1[1] = v1[1] * c[2] + v1[0] * s[2];
    a1[2] = v1[2] * c[3] - v1[3] * s[3]; a1[3] = v1[3] * c[3] + v1[2] * s[3];
    v0 = a0; v1 = a1;
  }
  __device__ __forceinline__ void vt8(unsigned char* vt, unsigned off, f32x4 v0, f32x4 v1) const {
    *(bf16_t*)(vt + off + 0 * SEQ * 2) = f2bf(v0[0]); *(bf16_t*)(vt + off + 1 * SEQ * 2) = f2bf(v0[1]); *(bf16_t*)(vt + off + 2 * SEQ * 2) = f2bf(v0[2]); *(bf16_t*)(vt + off + 3 * SEQ * 2) = f2bf(v0[3]);
    *(bf16_t*)(vt + off + 4 * SEQ * 2) = f2bf(v1[0]); *(bf16_t*)(vt + off + 5 * SEQ * 2) = f2bf(v1[1]); *(bf16_t*)(vt + off + 6 * SEQ * 2) = f2bf(v1[2]); *(bf16_t*)(vt + off + 7 * SEQ * 2) = f2bf(v1[3]);
  }
  __device__ __forceinline__ void operator()(const f32x4 (&acc)[2][2][4][2], const pg8::Unit& u, int wr, int wc, int fr, int fq) const {
    const int pn = u.pn;
    unsigned char* const big = ws + WS_BIG;
    const float* const cos64 = (const float*)(ws + WS_COS64); const float* const sin64 = (const float*)(ws + WS_SIN64);
    const float* const cos32 = (const float*)(ws + WS_COS32); const float* const sin32 = (const float*)(ws + WS_SIN32);
#pragma unroll
    for (int ai = 0; ai < 2; ++ai)
#pragma unroll
      for (int m = 0; m < 4; ++m) {
        asm volatile("" ::: "memory");
        const unsigned row = u.pm * 256 + ai * 128 + wr * 64 + m * 16 + fr;
        const unsigned b = row >> 13, pos = row & (SEQ - 1);
#pragma unroll
        for (int bj = 0; bj < 2; ++bj) {
          const unsigned col = pn * 256 + bj * 128 + wc * 32 + 8 * fq;
          f32x4 v0 = acc[ai][bj][m][0], v1 = acc[ai][bj][m][1];
          if (kind == K_RESID) {
            const unsigned o = (row * DM + col) * 4u;
            *(f32x4*)((char*)outf + o) = *(const f32x4*)((const char*)base + o) + v0; *(f32x4*)((char*)outf + o + 16) = *(const f32x4*)((const char*)base + o + 16) + v1;
          } else if (kind == K_RELU2) {
#pragma unroll
            for (int e = 0; e < 4; ++e) { float a = fmaxf(v0[e], 0.f), c = fmaxf(v1[e], 0.f); v0[e] = a * a; v1[e] = c * c; }
            store8(big, (row * FF + col) * 2u, v0, v1);
          } else if (kind == K_EVIN) {
            if (pn < 4) { const float sc = pn < 2 ? C_NA : 1.f; store8(big + B_QKNA, (row * 1024 + col) * 2u, v0 * sc, v1 * sc); }
            else if (pn < 6) { vt8(big + B_VTNA, ((b * 512 + (col - 1024)) * SEQ + vtidx(pos)) * 2u, v0, v1); }
            else if (pn == 6) { store8(big + B_CRAW, (row * 384 + (col - 1536)) * 2u, v0, v1); }
            else {
              if (bj == 0) store8(big + B_CRAW, (row * 384 + 256 + (col - 1792)) * 2u, v0, v1);
              else if (wc == 0) { rope8(v0, v1, cos32, sin32, (pos * 16 + 4 * fq) * 4u); store8(big + B_KPE, (row * 32 + 8 * fq) * 2u, v0, v1); }
            }
          } else if (kind == K_UQ) {
            if (pn == 2) rope8(v0, v1, cos32, sin32, (pos * 16 + ((col & 31) >> 1)) * 4u);
            store8(big + B_QMLA, (row * 768 + col) * 2u, v0 * C_MLA, v1 * C_MLA);
          } else if (kind == K_UKV) {
            if (pn < 2) store8(big + B_KN, (row * 512 + col) * 2u, v0, v1);
            else vt8(big + B_VTMLA, ((b * 512 + (col - 512)) * SEQ + vtidx(pos)) * 2u, v0, v1);
          } else {
            const int s = pn >> 1;
            if (s < 6) {
              rope8(v0, v1, cos64, sin64, (pos * 32 + ((col & 63) >> 1)) * 4u);
              const float sc = (s & 1) ? 1.f : C_NA;
              store8(big + B_QK, (row * 3072 + col) * 2u, v0 * sc, v1 * sc);
            } else {
              const int gq = s - 6, sh = 2 * gq;
              const unsigned lidx = ((pos & ((1u << sh) - 1)) << (13 - sh)) | (pos >> sh);
              vt8(big + B_VT, (((b * 3 + gq) * 512 + (col - s * 512)) * SEQ + vtidx(lidx)) * 2u, v0, v1);
            }
          }
        }
      }
  }
};

enum ColMap { CM_ID = 0, CM_EVIN = 1, CM_UQ = 2, CM_UKV = 3, CM_ODIN = 4 };
__device__ __forceinline__ int colmap(int kind, int n) {
  switch (kind) {
    case CM_EVIN: { if (n < 1920) return n; if (n >= 1952) return -1; const int j = n - 1920, k = j >> 1; return 1920 + ((j & 1) ? k + 16 : k); }
    case CM_UQ: { if (n < 512) return (n >> 6) * 96 + (n & 63); const int h = (n - 512) >> 5, j = (n - 512) & 31, k = j >> 1; return h * 96 + 64 + ((j & 1) ? k + 16 : k); }
    case CM_UKV: { if (n < 512) return (n >> 6) * 128 + (n & 63); const int n2 = n - 512; return (n2 >> 6) * 128 + 64 + (n2 & 63); }
    case CM_ODIN: { const int ch = n / OD_NC, n1 = n - ch * OD_NC, s = n1 >> 9, hl = (n1 & 511) >> 6, j = n1 & 63;
      int gq, t, js; if (s < 6) { gq = s >> 1; t = s & 1; const int k = j >> 1; js = (j & 1) ? k + 32 : k; } else { gq = s - 6; t = 2; js = j; }
      return ((gq * 3 + t) * 16 + (8 * ch + hl)) * 64 + js; }
    default: return n;
  }
}
__device__ __forceinline__ void transpose_item(const float* W, int K, int Nsrc, int Nout, bf16_t* WT, int cm, LAS float* scr, int item, int lane) {
  const int nblk = Nout / 32, kb = item / nblk, nb = item % nblk, k0 = 64 * kb, n0 = 32 * nb;
  const int sc = colmap(cm, n0 + (lane & 31));
#pragma unroll 8
  for (int i = 0; i < 32; ++i) { const int kk = 2 * i + (lane >> 5); scr[kk * 33 + (lane & 31)] = sc >= 0 ? W[(size_t)(k0 + kk) * Nsrc + sc] : 0.f; }
  asm volatile("s_waitcnt lgkmcnt(0)" ::: "memory");
  const int c = lane & 7;
#pragma unroll
  for (int j = 0; j < 4; ++j) { const int n = (lane >> 3) + 8 * j; const LAS float* s = scr + (8 * c) * 33 + n;
    u32x4 o; o.x = cvt_pk_bf16(s[0 * 33], s[1 * 33]); o.y = cvt_pk_bf16(s[2 * 33], s[3 * 33]); o.z = cvt_pk_bf16(s[4 * 33], s[5 * 33]); o.w = cvt_pk_bf16(s[6 * 33], s[7 * 33]);
    *(u32x4*)(WT + (size_t)(n0 + n) * K + k0 + 8 * c) = o; }
  asm volatile("s_waitcnt lgkmcnt(0)" ::: "memory");
}
__device__ __forceinline__ void rms_row_bf16(const float* xrow, const float* g, bf16_t* orow, int lane) {
  const f32x4* xr = (const f32x4*)xrow + lane; const f32x4* gr = (const f32x4*)g + lane;
  f32x4 v[4]; float s = 0.f;
#pragma unroll
  for (int j = 0; j < 4; ++j) { v[j] = xr[64 * j]; s += (v[j].x * v[j].x + v[j].y * v[j].y) + (v[j].z * v[j].z + v[j].w * v[j].w); }
  const float rstd = 1.f / sqrtf(wave_sum(s) * (1.f / DM) + RMS_EPS);
  u32x2* o8 = (u32x2*)orow + lane;
#pragma unroll
  for (int j = 0; j < 4; ++j) { const f32x4 gg = gr[64 * j]; u32x2 w; w.x = cvt_pk_bf16(v[j].x * rstd * gg.x, v[j].y * rstd * gg.y); w.y = cvt_pk_bf16(v[j].z * rstd * gg.z, v[j].w * rstd * gg.w); o8[64 * j] = w; }
}
__device__ __forceinline__ void rms_row_f32(const float* xrow, const float* g, float* orow, int lane) {
  const f32x4* xr = (const f32x4*)xrow + lane; const f32x4* gr = (const f32x4*)g + lane;
  f32x4 v[4]; float s = 0.f;
#pragma unroll
  for (int j = 0; j < 4; ++j) { v[j] = xr[64 * j]; s += (v[j].x * v[j].x + v[j].y * v[j].y) + (v[j].z * v[j].z + v[j].w * v[j].w); }
  const float rstd = 1.f / sqrtf(wave_sum(s) * (1.f / DM) + RMS_EPS);
  f32x4* o = (f32x4*)orow + lane;
#pragma unroll
  for (int j = 0; j < 4; ++j) { const f32x4 gg = gr[64 * j]; o[64 * j] = v[j] * rstd * gg; }
}
__device__ __forceinline__ void sincos_acc(float angf, float& sn, float& cs) {
  const double x = (double)angf;
  const double n = __builtin_rint(x * 0.63661977236758134308);
  double r = __builtin_fma(-n, 1.57079632679489655800e+00, x); r = __builtin_fma(-n, 6.12323399573676603587e-17, r);
  const double r2 = r * r;
  double sp = 1.0 / 6227020800.0; sp = sp * r2 - 1.0 / 39916800.0; sp = sp * r2 + 1.0 / 362880.0; sp = sp * r2 - 1.0 / 5040.0; sp = sp * r2 + 1.0 / 120.0; sp = sp * r2 - 1.0 / 6.0; sp = sp * r2 + 1.0; sp *= r;
  double cp = -1.0 / 87178291200.0; cp = cp * r2 + 1.0 / 479001600.0; cp = cp * r2 - 1.0 / 3628800.0; cp = cp * r2 + 1.0 / 40320.0; cp = cp * r2 - 1.0 / 720.0; cp = cp * r2 + 1.0 / 24.0; cp = cp * r2 - 0.5; cp = cp * r2 + 1.0;
  const int q = ((int)(long long)n) & 3;
  const double s_ = (q & 1) ? cp : sp, c_ = (q & 1) ? sp : cp;
  sn = (float)((q & 2) ? -s_ : s_);
  cs = (float)(((q + 1) & 2) ? -c_ : c_);
}

__device__ __forceinline__ int crow(int r, int hi) { return (r & 3) + 8 * (r >> 2) + 4 * hi; }
__device__ __forceinline__ float half_max(float m) { auto rr = __builtin_amdgcn_permlane32_swap(__float_as_uint(m), __float_as_uint(m), false, false); return fmaxf(__uint_as_float(rr[0]), __uint_as_float(rr[1])); }
__device__ __forceinline__ float half_sum(float m) { auto rr = __builtin_amdgcn_permlane32_swap(__float_as_uint(m), __float_as_uint(m), false, false); return __uint_as_float(rr[0]) + __uint_as_float(rr[1]); }
__device__ __forceinline__ bf16x8 ldg8(const unsigned char* base, unsigned off) { return *(const bf16x8*)(base + off); }
__device__ __forceinline__ void softmax_pv(f32x16& s, const bf16x8 (&vf)[4], f32x16& o0, f32x16& o1, float& mrun, float& lrun) {
  float mx = fmaxf(s[0], s[1]);
#pragma unroll
  for (int r = 2; r < 16; ++r) mx = fmaxf(mx, s[r]);
  mx = half_max(mx);
  const float mnew = fmaxf(mrun, mx), alpha = __builtin_amdgcn_exp2f(mrun - mnew); mrun = mnew;
  float ls = 0.f;
#pragma unroll
  for (int r = 0; r < 16; ++r) { s[r] = __builtin_amdgcn_exp2f(s[r] - mnew); ls += s[r]; }
  lrun = lrun * alpha + ls;
#pragma unroll
  for (int r = 0; r < 16; ++r) { o0[r] *= alpha; o1[r] *= alpha; }
  u32x4 w0, w1;
  w0.x = cvt_pk_bf16(s[0], s[1]); w0.y = cvt_pk_bf16(s[2], s[3]); w0.z = cvt_pk_bf16(s[4], s[5]); w0.w = cvt_pk_bf16(s[6], s[7]);
  w1.x = cvt_pk_bf16(s[8], s[9]); w1.y = cvt_pk_bf16(s[10], s[11]); w1.z = cvt_pk_bf16(s[12], s[13]); w1.w = cvt_pk_bf16(s[14], s[15]);
  const bf16x8 p0 = __builtin_bit_cast(bf16x8, w0), p1 = __builtin_bit_cast(bf16x8, w1);
  o0 = __builtin_amdgcn_mfma_f32_32x32x16_bf16(vf[0], p0, o0, 0, 0, 0); o0 = __builtin_amdgcn_mfma_f32_32x32x16_bf16(vf[1], p1, o0, 0, 0, 0);
  o1 = __builtin_amdgcn_mfma_f32_32x32x16_bf16(vf[2], p0, o1, 0, 0, 0); o1 = __builtin_amdgcn_mfma_f32_32x32x16_bf16(vf[3], p1, o1, 0, 0, 0);
}
__device__ __forceinline__ void store_ot(unsigned char* base, unsigned rowoff, const f32x16& o0, const f32x16& o1, float il, int hi) {
#pragma unroll
  for (int a = 0; a < 4; ++a) {
    u32x2 w; w.x = cvt_pk_bf16(o0[4 * a] * il, o0[4 * a + 1] * il); w.y = cvt_pk_bf16(o0[4 * a + 2] * il, o0[4 * a + 3] * il);
    *(u32x2*)(base + rowoff + (8 * a + 4 * hi) * 2) = w;
    u32x2 v; v.x = cvt_pk_bf16(o1[4 * a] * il, o1[4 * a + 1] * il); v.y = cvt_pk_bf16(o1[4 * a + 2] * il, o1[4 * a + 3] * il);
    *(u32x2*)(base + rowoff + (32 + 8 * a + 4 * hi) * 2) = v;
  }
}

__device__ __forceinline__ void mla_attn_phase(unsigned char* big, unsigned char* att, int bx, int G, int wave, int lane) {
  const int r32 = lane & 31, hi = lane >> 5;
  for (int u = bx; u < 512; u += G) {
    const int bh = u >> 5, qb = u & 31, b = bh >> 3, h = bh & 7;
    const unsigned m0 = b * SEQ + qb * 256 + wave * 32 + r32;
    bf16x8 qf[6];
#pragma unroll
    for (int c = 0; c < 4; ++c) qf[c] = ldg8(big + B_QMLA, (m0 * 768 + h * 64 + 16 * c + 8 * hi) * 2u);
#pragma unroll
    for (int c = 0; c < 2; ++c) qf[4 + c] = ldg8(big + B_QMLA, (m0 * 768 + 512 + h * 32 + 16 * c + 8 * hi) * 2u);
    const unsigned char* kn = big + B_KN + ((size_t)b * SEQ * 512 + h * 64) * 2;
    const unsigned char* kp = big + B_KPE + ((size_t)b * SEQ * 32) * 2;
    const unsigned char* vt = big + B_VTMLA + ((size_t)(b * 8 + h) * 64 * SEQ) * 2;
    const unsigned kno = (r32 * 512 + 8 * hi) * 2u, kpo = (r32 * 32 + 8 * hi) * 2u, vto = (r32 * SEQ + 8 * hi) * 2u;
    f32x16 o0 = {0.f, 0.f, 0.f, 0.f, 0.f, 0.f, 0.f, 0.f, 0.f, 0.f, 0.f, 0.f, 0.f, 0.f, 0.f, 0.f}, o1 = o0;
    float mrun = NEG_BIG, lrun = 0.f;
    bf16x8 kfa[6], vfa[4], kfb[6], vfb[4];
#define MLA_LOAD(KF, VF, t) do { \
      _Pragma("unroll") for (int c = 0; c < 4; ++c) KF[c] = ldg8(kn + (size_t)(t) * (32 * 512 * 2), kno + 32 * c); \
      _Pragma("unroll") for (int c = 0; c < 2; ++c) KF[4 + c] = ldg8(kp + (size_t)(t) * (32 * 32 * 2), kpo + 32 * c); \
      _Pragma("unroll") for (int d0 = 0; d0 < 2; ++d0) _Pragma("unroll") for (int j = 0; j < 2; ++j) VF[2 * d0 + j] = ldg8(vt + (size_t)(t) * 64, vto + d0 * (32 * SEQ * 2) + j * 32); } while (0)
#define MLA_TILE(KF, VF) do { f32x16 s = {0.f, 0.f, 0.f, 0.f, 0.f, 0.f, 0.f, 0.f, 0.f, 0.f, 0.f, 0.f, 0.f, 0.f, 0.f, 0.f}; \
      _Pragma("unroll") for (int c = 0; c < 6; ++c) s = __builtin_amdgcn_mfma_f32_32x32x16_bf16(KF[c], qf[c], s, 0, 0, 0); \
      softmax_pv(s, VF, o0, o1, mrun, lrun); } while (0)
    MLA_LOAD(kfa, vfa, 0);
    for (int t = 0; t < SEQ / 32; t += 2) {
      MLA_LOAD(kfb, vfb, t + 1);
      MLA_TILE(kfa, vfa);
      if (t + 2 < SEQ / 32) MLA_LOAD(kfa, vfa, t + 2);
      MLA_TILE(kfb, vfb);
    }
#undef MLA_LOAD
#undef MLA_TILE
    const float il = 1.f / half_sum(lrun);
    store_ot(att, (m0 * 1024 + 512 + h * 64) * 2u, o0, o1, il, hi);
  }
}

__device__ __forceinline__ void na_attn_phase(unsigned char* big, unsigned char* att, const float* rpb, int gw, int NGW, int lane) {
  const int r32 = lane & 31, hi = lane >> 5;
  for (int wt = gw; wt < 4096; wt += NGW) {
    const int w = wt & 1, h = (wt >> 1) & 7, r = (wt >> 4) & 127, b = wt >> 11;
    const int rs = min(max(r - 4, 0), 120), c = 32 * w + r32, cs = min(max(c - 8, 0), 48);
    const unsigned m0 = b * SEQ + r * 64 + c;
    bf16x8 qf[4];
#pragma unroll
    for (int cc = 0; cc < 4; ++cc) qf[cc] = ldg8(big + B_QKNA, (m0 * 1024 + h * 64 + 16 * cc + 8 * hi) * 2u);
    const unsigned char* kb = big + B_QKNA + ((size_t)(b * SEQ + rs * 64) * 1024 + 512 + h * 64) * 2;
    const unsigned char* vt = big + B_VTNA + ((size_t)(b * 8 + h) * 64 * SEQ + rs * 64) * 2;
    const unsigned ko = (r32 * 1024 + 8 * hi) * 2u, vto = (r32 * SEQ + 8 * hi) * 2u;
    const float* bias_h = rpb + h * 15 * 31;
    f32x16 o0 = {0.f, 0.f, 0.f, 0.f, 0.f, 0.f, 0.f, 0.f, 0.f, 0.f, 0.f, 0.f, 0.f, 0.f, 0.f, 0.f}, o1 = o0;
    float mrun = NEG_BIG, lrun = 0.f;
    for (int t = 0; t < 16; ++t) {
      bf16x8 kf[4], vf[4];
#pragma unroll
      for (int cc = 0; cc < 4; ++cc) kf[cc] = ldg8(kb + (size_t)t * (32 * 1024 * 2), ko + 32 * cc);
#pragma unroll
      for (int d0 = 0; d0 < 2; ++d0)
#pragma unroll
        for (int j = 0; j < 2; ++j) vf[2 * d0 + j] = ldg8(vt + (size_t)t * 64, vto + d0 * (32 * SEQ * 2) + j * 32);
      f32x16 s = {0.f, 0.f, 0.f, 0.f, 0.f, 0.f, 0.f, 0.f, 0.f, 0.f, 0.f, 0.f, 0.f, 0.f, 0.f, 0.f};
#pragma unroll
      for (int cc = 0; cc < 4; ++cc) s = __builtin_amdgcn_mfma_f32_32x32x16_bf16(kf[cc], qf[cc], s, 0, 0, 0);
      const int kr = rs + (t >> 1);
      const float* brow = bias_h + (kr - r + 7) * 31;
#pragma unroll
      for (int rr = 0; rr < 16; ++rr) {
        const int kc = 32 * (t & 1) + crow(rr, hi), rel = kc - c + 15;
        const bool ok = (kc >= cs) && (kc < cs + 16);
        const float bv = brow[min(max(rel, 0), 30)];
        s[rr] = ok ? s[rr] + bv * LOG2E : NEG_BIG;
      }
      softmax_pv(s, vf, o0, o1, mrun, lrun);
    }
    const float il = 1.f / half_sum(lrun);
    store_ot(att, (m0 * 1024 + h * 64) * 2u, o0, o1, il, hi);
  }
}

__device__ __forceinline__ void dil_attn_phase(unsigned char* big, unsigned char* att, int ch, int bx, int G, int wave, int lane, int tid) {
  const int r32 = lane & 31, hi = lane >> 5;
  float* lse = (float*)(big + B_LSE);
  for (int u = bx; u < 256; u += G) {
    const int b = u >> 7, hl = (u >> 4) & 7, P0 = (u & 15) * 512;
    for (int wt = wave; wt < 48; wt += 8) {
      const int gq = wt >> 4, j = wt & 15, sh = 2 * gq;
      const int rho = (gq == 0) ? 0 : (gq == 1) ? (j >> 2) : j, it = (gq == 0) ? j : (gq == 1) ? (j & 3) : 0;
      const int i0 = (P0 >> sh) + 32 * it, nseq = SEQ >> sh;
      const unsigned mq = b * SEQ + ((i0 + r32) << sh) + rho;
      bf16x8 qf[4];
#pragma unroll
      for (int cc = 0; cc < 4; ++cc) qf[cc] = ldg8(big + B_QK, (mq * 3072 + gq * 1024 + hl * 64 + 16 * cc + 8 * hi) * 2u);
      const unsigned char* vt = big + B_VT + ((size_t)((b * 3 + gq) * 8 + hl) * 64 * SEQ + rho * nseq) * 2;
      const unsigned vto = (r32 * SEQ + 8 * hi) * 2u;
      f32x16 o0 = {0.f, 0.f, 0.f, 0.f, 0.f, 0.f, 0.f, 0.f, 0.f, 0.f, 0.f, 0.f, 0.f, 0.f, 0.f, 0.f}, o1 = o0;
      float mrun = NEG_BIG, lrun = 0.f;
      for (int t = 0; t < 5; ++t) {
        const int k0 = i0 - 64 + 32 * t;
        if (k0 < 0 || k0 >= nseq) continue;
        const unsigned mk = b * SEQ + ((k0 + r32) << sh) + rho;
        bf16x8 kf[4], vf[4];
#pragma unroll
        for (int cc = 0; cc < 4; ++cc) kf[cc] = ldg8(big + B_QK, (mk * 3072 + gq * 1024 + 512 + hl * 64 + 16 * cc + 8 * hi) * 2u);
#pragma unroll
        for (int d0 = 0; d0 < 2; ++d0)
#pragma unroll
          for (int jj = 0; jj < 2; ++jj) vf[2 * d0 + jj] = ldg8(vt + (size_t)k0 * 2, vto + d0 * (32 * SEQ * 2) + jj * 32);
        f32x16 s = {0.f, 0.f, 0.f, 0.f, 0.f, 0.f, 0.f, 0.f, 0.f, 0.f, 0.f, 0.f, 0.f, 0.f, 0.f, 0.f};
#pragma unroll
        for (int cc = 0; cc < 4; ++cc) s = __builtin_amdgcn_mfma_f32_32x32x16_bf16(kf[cc], qf[cc], s, 0, 0, 0);
        if (t == 0) {
#pragma unroll
          for (int rr = 0; rr < 16; ++rr) s[rr] = (crow(rr, hi) >= r32) ? s[rr] : NEG_BIG;
        } else if (t == 4) {
#pragma unroll
          for (int rr = 0; rr < 16; ++rr) s[rr] = (crow(rr, hi) <= r32) ? s[rr] : NEG_BIG;
        }
        softmax_pv(s, vf, o0, o1, mrun, lrun);
      }
      const float lt = half_sum(lrun), il = 1.f / lt;
      store_ot(big + B_QK, (mq * 3072 + gq * 1024 + hl * 64) * 2u, o0, o1, il, hi);
      if (hi == 0) lse[(mq * 8 + hl) * 3 + gq] = mrun + __builtin_amdgcn_logf(lt);
    }
    __threadfence(); __syncthreads();
    {
      const unsigned m = b * SEQ + P0 + tid;
      const float l0 = lse[(m * 8 + hl) * 3 + 0], l1 = lse[(m * 8 + hl) * 3 + 1], l2 = lse[(m * 8 + hl) * 3 + 2];
      const float lm = fmaxf(l0, fmaxf(l1, l2));
      float w0 = __builtin_amdgcn_exp2f(l0 - lm), w1 = __builtin_amdgcn_exp2f(l1 - lm), w2 = __builtin_amdgcn_exp2f(l2 - lm);
      const float iw = 1.f / (w0 + w1 + w2); w0 *= iw; w1 *= iw; w2 *= iw;
#pragma unroll
      for (int jj = 0; jj < 8; ++jj) {
        float a0[8], a1[8], a2[8];
        unpack8(*(const u32x4*)(big + B_QK + ((size_t)m * 3072 + 0 * 1024 + hl * 64 + 8 * jj) * 2), a0);
        unpack8(*(const u32x4*)(big + B_QK + ((size_t)m * 3072 + 1 * 1024 + hl * 64 + 8 * jj) * 2), a1);
        unpack8(*(const u32x4*)(big + B_QK + ((size_t)m * 3072 + 2 * 1024 + hl * 64 + 8 * jj) * 2), a2);
        float f[8];
#pragma unroll
        for (int e = 0; e < 8; ++e) f[e] = w0 * a0[e] + w1 * a1[e] + w2 * a2[e];
        u32x4 wv; wv.x = cvt_pk_bf16(f[0], f[1]); wv.y = cvt_pk_bf16(f[2], f[3]); wv.z = cvt_pk_bf16(f[4], f[5]); wv.w = cvt_pk_bf16(f[6], f[7]);
        *(u32x4*)(att + ((size_t)m * 1024 + (8 * ch + hl) * 64 + 8 * jj) * 2) = wv;
      }
    }
    __syncthreads();
  }
}

__device__ __forceinline__ const void* ldptr(LAS unsigned char* lds, int i) {
  const volatile LAS unsigned* p = (const volatile LAS unsigned*)(lds + 131072) + 2 * i;
  const unsigned lo = __builtin_amdgcn_readfirstlane(p[0]), hi = __builtin_amdgcn_readfirstlane(p[1]);
  return (const void*)(((unsigned long long)hi << 32) | lo);
}
struct Args { const float* in[15]; float* out; unsigned char* ws; int ph_lo, ph_hi; };

__global__ void __launch_bounds__(512, 2) fwd(Args a) {
  extern __shared__ __attribute__((aligned(16))) unsigned char lds_raw[];
  LAS unsigned char* lds = (LAS unsigned char*)lds_raw;
  cg::grid_group grid = cg::this_grid();
  const int G = gridDim.x, bx = blockIdx.x;
  const int gsz = G * 512, NGW = G * 8;
  if (threadIdx.x < 15) ((LAS unsigned long long*)(lds + 131072))[threadIdx.x] = (unsigned long long)a.in[threadIdx.x];
  if (threadIdx.x == 15) ((LAS unsigned long long*)(lds + 131072))[15] = (unsigned long long)a.out;
  if (threadIdx.x == 16) ((LAS unsigned long long*)(lds + 131072))[16] = (unsigned long long)a.ws;
  __syncthreads();
#define INP(i) ((const float*)ldptr(lds, (i)))

  if (a.ph_lo == 0) {
    const int gtid0 = bx * 512 + threadIdx.x;
    float* cos64 = (float*)(a.ws + WS_COS64); float* sin64 = (float*)(a.ws + WS_SIN64); float* cos32 = (float*)(a.ws + WS_COS32); float* sin32 = (float*)(a.ws + WS_SIN32);
    for (int i = gtid0; i < SEQ * 32; i += gsz) { const int pos = i >> 5, kk = i & 31; float sn, cs; sincos_acc((float)pos * INV64[kk], sn, cs); cos64[i] = cs; sin64[i] = sn; }
    for (int i = gtid0; i < SEQ * 16; i += gsz) { const int pos = i >> 4, kk = i & 15; float sn, cs; sincos_acc((float)pos * INV64[2 * kk], sn, cs); cos32[i] = cs; sin32[i] = sn; }
  }
#ifdef ONE_LAUNCH
  for (int ph = a.ph_lo; ph < a.ph_hi; ++ph) {
#else
  { const int ph = a.ph_lo;
#endif
    int tid = threadIdx.x; asm volatile("" : "+v"(tid));
    const int lane = tid & 63, wave = __builtin_amdgcn_readfirstlane(tid >> 6), gtid = bx * 512 + tid, gw = bx * 8 + wave;
    unsigned char* ws = a.ws;
    float* X = a.out;
    unsigned char* big = ws + WS_BIG;
    bf16_t* XN = (bf16_t*)(ws + WS_XN); bf16_t* ATT = (bf16_t*)(ws + WS_ATT);
    const float* cos64 = (const float*)(ws + WS_COS64); const float* sin64 = (const float*)(ws + WS_SIN64);
    const float* cos32 = (const float*)(ws + WS_COS32); const float* sin32 = (const float*)(ws + WS_SIN32);
    if (ph == NPH - 1) {
      for (int m = gw; m < M; m += NGW) rms_row_f32(X + (size_t)m * DM, INP(3), X + (size_t)m * DM, lane);
    } else {
      const int L = ph / 9, k = ph % 9, e = L >> 1; const bool even = !(L & 1);
      const float* xsrc = (L == 0) ? INP(0) : X;
      if (k == 0) {
        LAS float* scr = (LAS float*)(lds + wave * 16384);
        const float* w1 = INP(13) + (size_t)L * DM * FF; const float* w2 = INP(14) + (size_t)L * FF * DM;
        const float* wo = even ? INP(10) + (size_t)e * DM * DM : INP(12) + (size_t)e * DM * DM;
        const int nin = even ? EV_N : 2 * OD_NC;
        const int I_IN = 16 * (nin / 32), I_O = 16 * 32, I_1 = 16 * 128, I_2 = 64 * 32, I_UQ = even ? 4 * 24 : 0, I_UKV = even ? 2 * 32 : 0;
        const int NIT = I_IN + I_O + I_1 + I_2 + I_UQ + I_UKV;
        for (int it = gw; it < NIT; it += NGW) {
          int r = it;
          if (r < I_IN) { if (even) transpose_item(INP(4) + (size_t)e * DM * 1952, DM, 1952, EV_N, (bf16_t*)(ws + WS_W + W_IN), CM_EVIN, scr, r, lane);
                          else transpose_item(INP(11) + (size_t)e * DM * 9216, DM, 9216, 2 * OD_NC, (bf16_t*)(ws + WS_W + W_IN), CM_ODIN, scr, r, lane); continue; } r -= I_IN;
          if (r < I_O) { transpose_item(wo, DM, DM, DM, (bf16_t*)(ws + WS_W + W_O), CM_ID, scr, r, lane); continue; } r -= I_O;
          if (r < I_1) { transpose_item(w1, DM, FF, FF, (bf16_t*)(ws + WS_W + W_1), CM_ID, scr, r, lane); continue; } r -= I_1;
          if (r < I_2) { transpose_item(w2, FF, DM, DM, (bf16_t*)(ws + WS_W + W_2), CM_ID, scr, r, lane); continue; } r -= I_2;
          if (r < I_UQ) { transpose_item(INP(7) + (size_t)e * 256 * 768, 256, 768, 768, (bf16_t*)(ws + WS_W + W_UQ), CM_UQ, scr, r, lane); continue; } r -= I_UQ;
          transpose_item(INP(9) + (size_t)e * 128 * 1024, 128, 1024, 1024, (bf16_t*)(ws + WS_W + W_UKV), CM_UKV, scr, r, lane);
        }
        for (int m = gw; m < M; m += NGW) rms_row_bf16(xsrc + (size_t)m * DM, INP(1) + L * DM, XN + (size_t)m * DM, lane);
      } else if (k == 6) {
        for (int m = gw; m < M; m += NGW) rms_row_bf16(X + (size_t)m * DM, INP(2) + L * DM, XN + (size_t)m * DM, lane);
      } else if (even && k == 2) {
        const bf16_t* CR = (const bf16_t*)(big + B_CRAW); bf16_t* CQN = (bf16_t*)(big + B_CQN); bf16_t* CKVN = (bf16_t*)(big + B_CKVN);
        const float* gq = INP(6) + e * 256; const float* gkv = INP(8) + e * 128;
        for (int m = gw; m < M; m += NGW) {
          const u32x2 w = *(const u32x2*)(CR + (size_t)m * 384 + 4 * lane);
          const float v0 = bflo(w.x), v1 = bfhi(w.x), v2 = bflo(w.y), v3 = bfhi(w.y);
          const float rq = 1.f / sqrtf(wave_sum(v0 * v0 + v1 * v1 + v2 * v2 + v3 * v3) * (1.f / 256.f) + RMS_EPS);
          const f32x4 g4 = *(const f32x4*)(gq + 4 * lane);
          u32x2 o; o.x = cvt_pk_bf16(v0 * rq * g4.x, v1 * rq * g4.y); o.y = cvt_pk_bf16(v2 * rq * g4.z, v3 * rq * g4.w);
          *(u32x2*)(CQN + (size_t)m * 256 + 4 * lane) = o;
          const unsigned w2 = *(const unsigned*)(CR + (size_t)m * 384 + 256 + 2 * lane);
          const float u0 = bflo(w2), u1 = bfhi(w2);
          const float rk = 1.f / sqrtf(wave_sum(u0 * u0 + u1 * u1) * (1.f / 128.f) + RMS_EPS);
          const f32x2 g2 = *(const f32x2*)(gkv + 2 * lane);
          *(unsigned*)(CKVN + (size_t)m * 128 + 2 * lane) = cvt_pk_bf16(u0 * rk * g2.x, u1 * rk * g2.y);
        }
      } else if (even && k == 4) {
        na_attn_phase(big, (unsigned char*)ATT, INP(5) + (size_t)e * 8 * 15 * 31, gw, NGW, lane);
        mla_attn_phase(big, (unsigned char*)ATT, bx, G, wave, lane);
      } else if (!even && (k == 2 || k == 4)) {
        dil_attn_phase(big, (unsigned char*)ATT, (k == 2) ? 0 : 1, bx, G, wave, lane, tid);
      } else {
        const int nsub = (even && k == 3) ? 2 : 1;
        for (int sub = 0; sub < nsub; ++sub) {
          pg8::Gemm g; pg8::StaticOrder S; EpiB E; E.ws = ws;
          g.M = M;
          E.base = (k == 5) ? xsrc : X; E.outf = X;
          if (k == 5) { g.A = ATT; g.Bt = (const bf16_t*)(ws + WS_W + W_O); g.N = DM; g.K = DM; E.kind = K_RESID; }
          else if (k == 8) { g.A = (const bf16_t*)big; g.Bt = (const bf16_t*)(ws + WS_W + W_2); g.N = DM; g.K = FF; E.kind = K_RESID; }
          else if (k == 7) { g.A = XN; g.Bt = (const bf16_t*)(ws + WS_W + W_1); g.N = FF; g.K = DM; E.kind = K_RELU2; }
          else if (even && k == 1) { g.A = XN; g.Bt = (const bf16_t*)(ws + WS_W + W_IN); g.N = EV_N; g.K = DM; E.kind = K_EVIN; }
          else if (even) {
            if (sub == 0) { g.A = (const bf16_t*)(big + B_CQN); g.Bt = (const bf16_t*)(ws + WS_W + W_UQ); g.N = 768; g.K = 256; E.kind = K_UQ; }
            else { g.A = (const bf16_t*)(big + B_CKVN); g.Bt = (const bf16_t*)(ws + WS_W + W_UKV); g.N = 1024; g.K = 128; E.kind = K_UKV; }
          } else { const int ch = (k == 1) ? 0 : 1; g.A = XN; g.Bt = (const bf16_t*)(ws + WS_W + W_IN) + (size_t)ch * OD_NC * DM; g.N = OD_NC; g.K = DM; E.kind = K_ODIN; }
          S.init(M, g.N, G, bx);
          pg8::gemm_phase<EpiB>(lds, g, S, E);
        }
      }
    }
#ifdef ONE_LAUNCH
    if (ph + 1 < a.ph_hi) grid.sync();
#endif
  }
}

extern "C" void kernel_launch(void* const* d_in, const int* in_sizes, int n_in, void* d_out, int out_size, void* d_ws, size_t ws_size, hipStream_t stream) {
  static int grid = 0;
  if (!grid) {
    if (n_in != 15 || out_size != M * DM || ws_size < WS_END) { fprintf(stderr, "kernel_launch: unexpected sizes n_in %d out %d ws %zu (need %zu)\n", n_in, out_size, ws_size, (size_t)WS_END); grid = -1; return; }
    int dev = 0, cus = 0, per_cu = 0;
    (void)hipGetDevice(&dev);
    (void)hipDeviceGetAttribute(&cus, hipDeviceAttributeMultiprocessorCount, dev);
    (void)hipFuncSetAttribute((const void*)fwd, hipFuncAttributeMaxDynamicSharedMemorySize, LDS_BYTES);
    (void)hipOccupancyMaxActiveBlocksPerMultiprocessor(&per_cu, (const void*)fwd, 512, LDS_BYTES);
    if (per_cu < 1) per_cu = 1;
    grid = cus * per_cu;
  }
  if (grid < 0) return;
  Args a{};
  for (int i = 0; i < 15; ++i) a.in[i] = (const float*)d_in[i];
  a.out = (float*)d_out; a.ws = (unsigned char*)d_ws;
#ifndef ONE_LAUNCH
  for (int ph = 0; ph < NPH; ++ph) {
    a.ph_lo = ph; a.ph_hi = ph + 1;
    hipLaunchKernelGGL(fwd, dim3(grid), dim3(512), LDS_BYTES, stream, a);
  }
#else
  a.ph_lo = 0; a.ph_hi = NPH;
  void* args[] = {&a};
  hipError_t er = hipLaunchCooperativeKernel((const void*)fwd, dim3(grid), dim3(512), args, LDS_BYTES, stream);
  if (er != hipSuccess) fprintf(stderr, "cooperative launch failed: %s (grid %d)\n", hipGetErrorString(er), grid);
#endif
}
```

```cpp
#include <hip/hip_runtime.h>
#include <hip/hip_cooperative_groups.h>
#include <cstdio>
#include <cstdint>
namespace cg = cooperative_groups;
#define ONE_LAUNCH 1

#define LAS __attribute__((address_space(3)))
typedef unsigned short bf16_t;
typedef short bf16x8 __attribute__((ext_vector_type(8)));
typedef float f32x4 __attribute__((ext_vector_type(4)));
typedef float f32x2 __attribute__((ext_vector_type(2)));
typedef float f32x16 __attribute__((ext_vector_type(16)));
typedef unsigned u32x4 __attribute__((ext_vector_type(4)));
typedef unsigned u32x2 __attribute__((ext_vector_type(2)));

constexpr int M = 16384, SEQ = 8192, DM = 1024, FF = 4096;
constexpr int EV_N = 2048;
constexpr int OD_NC = 4608;
constexpr float LOG2E = 1.4426950408889634f;
constexpr float C_NA = 0.125f * LOG2E;
constexpr float C_MLA = 0.10206207261596575f * LOG2E;
constexpr float RMS_EPS = 1e-6f;
constexpr float NEG_BIG = -1e30f;

constexpr size_t MiB = 1u << 20;
constexpr size_t WS_COS64 = 1 * MiB, WS_SIN64 = 2 * MiB, WS_COS32 = 3 * MiB, WS_SIN32 = 3 * MiB + 512 * 1024;
constexpr size_t WS_W = 4 * MiB;
constexpr size_t W_IN = 0, W_O = 18 * MiB, W_1 = 20 * MiB, W_2 = 28 * MiB, W_UQ = 36 * MiB, W_UKV = 36 * MiB + 512 * 1024;
constexpr size_t WS_XN = 41 * MiB;
constexpr size_t WS_ATT = 73 * MiB;
constexpr size_t WS_BIG = 105 * MiB;
constexpr size_t B_QKNA = 0, B_VTNA = 32 * MiB, B_CRAW = 48 * MiB, B_CQN = 60 * MiB, B_CKVN = 68 * MiB, B_KPE = 72 * MiB,
                 B_QMLA = 73 * MiB, B_KN = 97 * MiB, B_VTMLA = 113 * MiB;
constexpr size_t B_QK = 0, B_VT = 96 * MiB, B_LSE = 144 * MiB;
constexpr size_t WS_END = WS_BIG + 146 * MiB;

constexpr int LDS_BYTES = 147456;
constexpr int NPH = 37;

__device__ const float INV64[32] = {
  1.000000000e+00f, 7.498942018e-01f, 5.623413324e-01f, 4.216965139e-01f, 3.162277639e-01f, 2.371373922e-01f, 1.778279394e-01f, 1.333521456e-01f,
  1.000000015e-01f, 7.498941571e-02f, 5.623412877e-02f, 4.216964915e-02f, 3.162277862e-02f, 2.371373586e-02f, 1.778279431e-02f, 1.333521493e-02f,
  9.999999776e-03f, 7.498942316e-03f, 5.623413250e-03f, 4.216964822e-03f, 3.162277862e-03f, 2.371373819e-03f, 1.778279431e-03f, 1.333521446e-03f,
  1.000000047e-03f, 7.498941850e-04f, 5.623413017e-04f, 4.216965463e-04f, 3.162277862e-04f, 2.371373848e-04f, 1.778279402e-04f, 1.333521504e-04f};

__device__ __forceinline__ unsigned cvt_pk_bf16(float lo, float hi) { unsigned r; asm volatile("v_cvt_pk_bf16_f32 %0, %1, %2" : "=v"(r) : "v"(lo), "v"(hi)); return r; }
__device__ __forceinline__ bf16_t f2bf(float f) { return (bf16_t)(cvt_pk_bf16(f, 0.f) & 0xffffu); }
__device__ __forceinline__ float bf2f(unsigned short h) { return __uint_as_float(((unsigned)h) << 16); }
__device__ __forceinline__ float bflo(unsigned w) { return __uint_as_float(w << 16); }
__device__ __forceinline__ float bfhi(unsigned w) { return __uint_as_float(w & 0xffff0000u); }
__device__ __forceinline__ int vtidx(int p) { return (p & ~12) | ((p & 4) << 1) | ((p & 8) >> 1); }
__device__ __forceinline__ float wave_sum(float v) {
#pragma unroll
  for (int o = 1; o < 64; o <<= 1) v += __shfl_xor(v, o);
  return v;
}
__device__ __forceinline__ void unpack8(const u32x4 w, float* f) {
  f[0] = bflo(w.x); f[1] = bfhi(w.x); f[2] = bflo(w.y); f[3] = bfhi(w.y); f[4] = bflo(w.z); f[5] = bfhi(w.z); f[6] = bflo(w.w); f[7] = bfhi(w.w);
}

namespace pg8 {
constexpr int BM = 256, BK = 64, HALF = 128, HTB = HALF * BK * 2, STAGE_BYTES = 8 * HTB, NXCD = 8, WGM = 8;
__host__ __device__ __forceinline__ int lds_byte(int r, int c) { const int st = (r >> 4) * 2 + (c >> 5), rr = r & 15, cc = c & 31, ob = rr * 64 + cc * 2; return st * 1024 + (ob ^ (((ob >> 9) & 1) << 5)); }
__host__ __device__ __forceinline__ void stage_rc(int b, int& R, int& C) { const int st = b / 1024, sb = b % 1024, swz = sb ^ (((sb >> 9) & 1) << 5); R = (st >> 1) * 16 + swz / 64; C = (st & 1) * 32 + (swz % 64) / 2; }
__host__ __device__ __forceinline__ int perm32(int rho) { const int n = rho >> 4, i = rho & 15; return 8 * (i >> 2) + 4 * n + (i & 3); }

struct Unit { int pm, pn; };
struct Gemm { const bf16_t* A; const bf16_t* Bt; int M, N, K; };
struct StaticOrder {
  int nM, nN, nwg, G, c;
  __device__ void init(int M_, int N_, int G_, int c_) { nM = M_ / BM; nN = N_ / BM; nwg = nM * nN; G = G_; c = c_; }
  __device__ bool next(int i, Unit& u) const {
    const long L = (long)i * G + c; if (L >= nwg) return false;
    int wgid = (int)L; { const int q = nwg / NXCD, r = nwg % NXCD, xcd = wgid % NXCD, off = wgid / NXCD; wgid = (xcd < r ? xcd * (q + 1) : r * (q + 1) + (xcd - r) * q) + off; }
    const int nig = WGM * nN, gid = wgid / nig, fm = gid * WGM, gsz = (nM - fm) < WGM ? (nM - fm) : WGM;
    u.pm = fm + ((wgid % nig) % gsz); u.pn = (wgid % nig) / gsz; return true;
  }
};

template <class Epi>
__device__ __forceinline__ void gemm_phase(LAS unsigned char* lds, const Gemm g, const StaticOrder& S, const Epi& E) {
  int tid = threadIdx.x; asm volatile("" : "+v"(tid));
  const int wid = __builtin_amdgcn_readfirstlane(tid >> 6), lane = tid & 63, wr = wid >> 2, wc = wid & 3, fr = lane & 15, fq = lane >> 4;
  constexpr bool PERM = true; const int K = g.K, nt = K / BK;
  unsigned voffA[2], voffB[2];
#pragma unroll
  for (int i = 0; i < 2; ++i) { int R, C; stage_rc(tid * 16 + i * 8192, R, C); const int Rb = PERM ? ((R & ~31) + perm32(R & 31)) : R;
    voffA[i] = (unsigned)(R * K + C) * 2u; voffB[i] = (unsigned)(Rb * K + C) * 2u; }
  const size_t kstep = (size_t)(BK * 2);
  const size_t hstep = (size_t)HALF * K * 2;
  const size_t tstep = 2 * hstep;
  const unsigned ldsw = (unsigned)wid * 1024u;
  const int aoff = lds_byte(wr * 64 + fr, fq * 8), boff = lds_byte(wc * 32 + fr, fq * 8);
#define PG8_SA(b, h) (((b) * 2 + (h)) * HTB)
#define PG8_SB(b, h) ((4 + (b) * 2 + (h)) * HTB)
#define PG8_STAGE(bufoff, gbase, voff) do { _Pragma("unroll") for (int _i = 0; _i < 2; ++_i) \
    __builtin_amdgcn_global_load_lds((const unsigned*)((const char*)(gbase) + (voff)[_i]), (LAS unsigned*)(lds + (bufoff) + ldsw + _i * 8192), 16, 0, 0); } while (0)
#define PG8_LDA(dst, b, h) do { _Pragma("unroll") for (int m = 0; m < 4; ++m) _Pragma("unroll") for (int k = 0; k < 2; ++k) dst[m][k] = *(const LAS bf16x8*)(lds + PG8_SA(b, h) + aoff + m * 2048 + k * 1024); } while (0)
#define PG8_LDB(dst, b, h) do { _Pragma("unroll") for (int n = 0; n < 2; ++n) _Pragma("unroll") for (int k = 0; k < 2; ++k) dst[n][k] = *(const LAS bf16x8*)(lds + PG8_SB(b, h) + boff + n * 2048 + k * 1024); } while (0)
#define PG8_MMA(ai, bj, At, Bt) do { __builtin_amdgcn_s_setprio(1); _Pragma("unroll") for (int m = 0; m < 4; ++m) _Pragma("unroll") for (int n = 0; n < 2; ++n) _Pragma("unroll") for (int k = 0; k < 2; ++k) \
    acc[ai][bj][m][n] = __builtin_amdgcn_mfma_f32_16x16x32_bf16(Bt[n][k], At[m][k], acc[ai][bj][m][n], 0, 0, 0); __builtin_amdgcn_s_setprio(0); } while (0)
#define PG8_WAIT_V(n) asm volatile("s_waitcnt vmcnt(" #n ")" ::: "memory")
#define PG8_WAIT_L(n) asm volatile("s_waitcnt lgkmcnt(" #n ")" ::: "memory")
#define PG8_BAR __builtin_amdgcn_s_barrier()
#define PG8_SCHED __builtin_amdgcn_sched_barrier(0)
  Unit cur, nxt; int ui = 0;
  if (!S.next(0, cur)) return;
  f32x4 acc[2][2][4][2];
#pragma unroll
  for (int a = 0; a < 2; ++a)
#pragma unroll
    for (int b = 0; b < 2; ++b)
#pragma unroll
      for (int m = 0; m < 4; ++m)
#pragma unroll
        for (int n = 0; n < 2; ++n) acc[a][b][m][n] = (f32x4){0.f, 0.f, 0.f, 0.f};
  bf16x8 At[4][2], B0[2][2], B1[2][2];
  const char* cA = (const char*)g.A + (size_t)cur.pm * tstep; const char* cB = (const char*)g.Bt + (size_t)cur.pn * tstep;
  PG8_STAGE(PG8_SB(0, 0), cB, voffB); PG8_STAGE(PG8_SB(0, 1), cB + hstep, voffB); PG8_STAGE(PG8_SA(0, 0), cA, voffA); PG8_STAGE(PG8_SA(0, 1), cA + hstep, voffA);
  if (wr == 1) PG8_BAR;
  PG8_WAIT_V(2); PG8_BAR;
  PG8_STAGE(PG8_SB(1, 0), cB + kstep, voffB); PG8_STAGE(PG8_SA(1, 0), cA + kstep, voffA); PG8_STAGE(PG8_SB(1, 1), cB + hstep + kstep, voffB);
  PG8_WAIT_V(6); PG8_BAR;
  for (;;) {
    const bool has_next = S.next(ui + 1, nxt);
    const char* nA = has_next ? (const char*)g.A + (size_t)nxt.pm * tstep : cA; const char* nB = has_next ? (const char*)g.Bt + (size_t)nxt.pn * tstep : cB;
    for (int t = 0; t < nt; t += 2) {
      const bool last = (t == nt - 2);
      const char* a1 = cA + (size_t)(t + 1) * kstep;
      const char* a2 = last ? nA : cA + (size_t)(t + 2) * kstep; const char* b2 = last ? nB : cB + (size_t)(t + 2) * kstep;
      const char* a3 = a2 + kstep; const char* b3 = b2 + kstep;
      PG8_LDB(B0, 0, 0); PG8_LDB(B1, 0, 1); PG8_SCHED; PG8_LDA(At, 0, 0); PG8_STAGE(PG8_SA(1, 1), a1 + hstep, voffA);
      PG8_WAIT_V(8); PG8_WAIT_L(0); PG8_BAR; PG8_MMA(0, 0, At, B0); PG8_MMA(0, 1, At, B1); PG8_BAR; PG8_SCHED;
      PG8_LDA(At, 0, 1); PG8_STAGE(PG8_SB(0, 0), b2, voffB); PG8_STAGE(PG8_SB(0, 1), b2 + hstep, voffB); PG8_STAGE(PG8_SA(0, 0), a2, voffA);
      PG8_WAIT_V(8); PG8_WAIT_L(0); PG8_BAR; PG8_MMA(1, 0, At, B0); PG8_MMA(1, 1, At, B1); PG8_BAR; PG8_SCHED;
      PG8_LDB(B0, 1, 0); PG8_LDB(B1, 1, 1); PG8_SCHED; PG8_LDA(At, 1, 0); PG8_STAGE(PG8_SA(0, 1), a2 + hstep, voffA);
      PG8_WAIT_V(8); PG8_WAIT_L(0); PG8_BAR; PG8_MMA(0, 0, At, B0); PG8_MMA(0, 1, At, B1); PG8_BAR; PG8_SCHED;
      PG8_LDA(At, 1, 1); PG8_STAGE(PG8_SB(1, 0), b3, voffB); PG8_STAGE(PG8_SB(1, 1), b3 + hstep, voffB); PG8_STAGE(PG8_SA(1, 0), a3, voffA);
      PG8_WAIT_V(8); PG8_WAIT_L(0); PG8_BAR; PG8_MMA(1, 0, At, B0); PG8_MMA(1, 1, At, B1); PG8_BAR; PG8_SCHED;
    }
    if (wr == 0) PG8_BAR;
    E(acc, cur, wr, wc, fr, fq);
    if (!has_next) break;
#pragma unroll
    for (int a = 0; a < 2; ++a)
#pragma unroll
      for (int b = 0; b < 2; ++b)
#pragma unroll
        for (int m = 0; m < 4; ++m)
#pragma unroll
          for (int n = 0; n < 2; ++n) acc[a][b][m][n] = (f32x4){0.f, 0.f, 0.f, 0.f};
    cur = nxt; cA = nA; cB = nB; ++ui;
    if (wr == 1) PG8_BAR;
  }
  PG8_WAIT_V(0);
  PG8_BAR;
#undef PG8_SA
#undef PG8_SB
#undef PG8_STAGE
#undef PG8_LDA
#undef PG8_LDB
#undef PG8_MMA
#undef PG8_WAIT_V
#undef PG8_WAIT_L
#undef PG8_BAR
#undef PG8_SCHED
}
}

enum EpiKind { K_EVIN = 0, K_UQ = 1, K_UKV = 2, K_ODIN = 3, K_RELU2 = 4, K_RESID = 5 };
struct EpiB {
  int kind;
  unsigned char* ws;
  const float* base; float* outf;
  __device__ __forceinline__ void store8(unsigned char* b, unsigned off, f32x4 v0, f32x4 v1) const {
    u32x4 w; w.x = cvt_pk_bf16(v0[0], v0[1]); w.y = cvt_pk_bf16(v0[2], v0[3]); w.z = cvt_pk_bf16(v1[0], v1[1]); w.w = cvt_pk_bf16(v1[2], v1[3]);
    *(u32x4*)(b + off) = w;
  }
  __device__ __forceinline__ void rope8(f32x4& v0, f32x4& v1, const float* ct, const float* st, unsigned toff) const {
    const f32x4 c = *(const f32x4*)((const char*)ct + toff), s = *(const f32x4*)((const char*)st + toff);
    f32x4 a0, a1;
    a0[0] = v0[0] * c[0] - v0[1] * s[0]; a0[1] = v0[1] * c[0] + v0[0] * s[0];
    a0[2] = v0[2] * c[1] - v0[3] * s[1]; a0[3] = v0[3] * c[1] + v0[2] * s[1];
    a1[0] = v1[0] * c[2] - v1[1] * s[2]; a1[1] = v1[1] * c[2] + v1[0] * s[2];
    a1[2] = v1[2] * c[3] - v1[3] * s[3]; a1[3] = v1[3] * c[3] + v1[2] * s[3];
    v0 = a0; v1 = a1;
  }
  __device__ __forceinline__ void vt8(unsigned char* vt, unsigned off, f32x4 v0, f32x4 v1) const {
    *(bf16_t*)(vt + off + 0 * SEQ * 2) = f2bf(v0[0]); *(bf16_t*)(vt + off + 1 * SEQ * 2) = f2bf(v0[1]); *(bf16_t*)(vt + off + 2 * SEQ * 2) = f2bf(v0[2]); *(bf16_t*)(vt + off + 3 * SEQ * 2) = f2bf(v0[3]);
    *(bf16_t*)(vt + off + 4 * SEQ * 2) = f2bf(v1[0]); *(bf16_t*)(vt + off + 5 * SEQ * 2) = f2bf(v1[1]); *(bf16_t*)(vt + off + 6 * SEQ * 2) = f2bf(v1[2]); *(bf16_t*)(vt + off + 7 * SEQ * 2) = f2bf(v1[3]);
  }
  __device__ __forceinline__ void operator()(const f32x4 (&acc)[2][2][4][2], const pg8::Unit& u, int wr, int wc, int fr, int fq) const {
    const int pn = u.pn;
    unsigned char* const big = ws + WS_BIG;
    const float* const cos64 = (const float*)(ws + WS_COS64); const float* const sin64 = (const float*)(ws + WS_SIN64);
    const float* const cos32 = (const float*)(ws + WS_COS32); const float* const sin32 = (const float*)(ws + WS_SIN32);
#pragma unroll
    for (int ai = 0; ai < 2; ++ai)
#pragma unroll
      for (int m = 0; m < 4; ++m) {
        asm volatile("" ::: "memory");
        const unsigned row = u.pm * 256 + ai * 128 + wr * 64 + m * 16 + fr;
        const unsigned b = row >> 13, pos = row & (SEQ - 1);
#pragma unroll
        for (int bj = 0; bj < 2; ++bj) {
          const unsigned col = pn * 256 + bj * 128 + wc * 32 + 8 * fq;
          f32x4 v0 = acc[ai][bj][m][0], v1 = acc[ai][bj][m][1];
          if (kind == K_RESID) {
            const unsigned o = (row * DM + col) * 4u;
            *(f32x4*)((char*)outf + o) = *(const f32x4*)((const char*)base + o) + v0; *(f32x4*)((char*)outf + o + 16) = *(const f32x4*)((const char*)base + o + 16) + v1;
          } else if (kind == K_RELU2) {
#pragma unroll
            for (int e = 0; e < 4; ++e) { float a = fmaxf(v0[e], 0.f), c = fmaxf(v1[e], 0.f); v0[e] = a * a; v1[e] = c * c; }
            store8(big, (row * FF + col) * 2u, v0, v1);
          } else if (kind == K_EVIN) {
            if (pn < 4) { const float sc = pn < 2 ? C_NA : 1.f; store8(big + B_QKNA, (row * 1024 + col) * 2u, v0 * sc, v1 * sc); }
            else if (pn < 6) { vt8(big + B_VTNA, ((b * 512 + (col - 1024)) * SEQ + vtidx(pos)) * 2u, v0, v1); }
            else if (pn == 6) { store8(big + B_CRAW, (row * 384 + (col - 1536)) * 2u, v0, v1); }
            else {
              if (bj == 0) store8(big + B_CRAW, (row * 384 + 256 + (col - 1792)) * 2u, v0, v1);
              else if (wc == 0) { rope8(v0, v1, cos32, sin32, (pos * 16 + 4 * fq) * 4u); store8(big + B_KPE, (row * 32 + 8 * fq) * 2u, v0, v1); }
            }
          } else if (kind == K_UQ) {
            if (pn == 2) rope8(v0, v1, cos32, sin32, (pos * 16 + ((col & 31) >> 1)) * 4u);
            store8(big + B_QMLA, (row * 768 + col) * 2u, v0 * C_MLA, v1 * C_MLA);
          } else if (kind == K_UKV) {
            if (pn < 2) store8(big + B_KN, (row * 512 + col) * 2u, v0, v1);
            else vt8(big + B_VTMLA, ((b * 512 + (col - 512)) * SEQ + vtidx(pos)) * 2u, v0, v1);
          } else {
            const int s = pn >> 1;
            if (s < 6) {
              rope8(v0, v1, cos64, sin64, (pos * 32 + ((col & 63) >> 1)) * 4u);
              const float sc = (s & 1) ? 1.f : C_NA;
              store8(big + B_QK, (row * 3072 + col) * 2u, v0 * sc, v1 * sc);
            } else {
              const int gq = s - 6, sh = 2 * gq;
              const unsigned lidx = ((pos & ((1u << sh) - 1)) << (13 - sh)) | (pos >> sh);
              vt8(big + B_VT, (((b * 3 + gq) * 512 + (col - s * 512)) * SEQ + vtidx(lidx)) * 2u, v0, v1);
            }
          }
        }
      }
  }
};

enum ColMap { CM_ID = 0, CM_EVIN = 1, CM_UQ = 2, CM_UKV = 3, CM_ODIN = 4 };
__device__ __forceinline__ int colmap(int kind, int n) {
  switch (kind) {
    case CM_EVIN: { if (n < 1920) return n; if (n >= 1952) return -1; const int j = n - 1920, k = j >> 1; return 1920 + ((j & 1) ? k + 16 : k); }
    case CM_UQ: { if (n < 512) return (n >> 6) * 96 + (n & 63); const int h = (n - 512) >> 5, j = (n - 512) & 31, k = j >> 1; return h * 96 + 64 + ((j & 1) ? k + 16 : k); }
    case CM_UKV: { if (n < 512) return (n >> 6) * 128 + (n & 63); const int n2 = n - 512; return (n2 >> 6) * 128 + 64 + (n2 & 63); }
    case CM_ODIN: { const int ch = n / OD_NC, n1 = n - ch * OD_NC, s = n1 >> 9, hl = (n1 & 511) >> 6, j = n1 & 63;
      int gq, t, js; if (s < 6) { gq = s >> 1; t = s & 1; const int k = j >> 1; js = (j & 1) ? k + 32 : k; } else { gq = s - 6; t = 2; js = j; }
      return ((gq * 3 + t) * 16 + (8 * ch + hl)) * 64 + js; }
    default: return n;
  }
}
__device__ __forceinline__ void transpose_item(const float* W, int K, int Nsrc, int Nout, bf16_t* WT, int cm, LAS float* scr, int item, int lane) {
  const int nblk = Nout / 32, kb = item / nblk, nb = item % nblk, k0 = 64 * kb, n0 = 32 * nb;
  const int sc = colmap(cm, n0 + (lane & 31));
#pragma unroll 8
  for (int i = 0; i < 32; ++i) { const int kk = 2 * i + (lane >> 5); scr[kk * 33 + (lane & 31)] = sc >= 0 ? W[(size_t)(k0 + kk) * Nsrc + sc] : 0.f; }
  asm volatile("s_waitcnt lgkmcnt(0)" ::: "memory");
  const int c = lane & 7;
#pragma unroll
  for (int j = 0; j < 4; ++j) { const int n = (lane >> 3) + 8 * j; const LAS float* s = scr + (8 * c) * 33 + n;
    u32x4 o; o.x = cvt_pk_bf16(s[0 * 33], s[1 * 33]); o.y = cvt_pk_bf16(s[2 * 33], s[3 * 33]); o.z = cvt_pk_bf16(s[4 * 33], s[5 * 33]); o.w = cvt_pk_bf16(s[6 * 33], s[7 * 33]);
    *(u32x4*)(WT + (size_t)(n0 + n) * K + k0 + 8 * c) = o; }
  asm volatile("s_waitcnt lgkmcnt(0)" ::: "memory");
}
__device__ __forceinline__ void rms_row_bf16(const float* xrow, const float* g, bf16_t* orow, int lane) {
  const f32x4* xr = (const f32x4*)xrow + lane; const f32x4* gr = (const f32x4*)g + lane;
  f32x4 v[4]; float s = 0.f;
#pragma unroll
  for (int j = 0; j < 4; ++j) { v[j] = xr[64 * j]; s += (v[j].x * v[j].x + v[j].y * v[j].y) + (v[j].z * v[j].z + v[j].w * v[j].w); }
  const float rstd = 1.f / sqrtf(wave_sum(s) * (1.f / DM) + RMS_EPS);
  u32x2* o8 = (u32x2*)orow + lane;
#pragma unroll
  for (int j = 0; j < 4; ++j) { const f32x4 gg = gr[64 * j]; u32x2 w; w.x = cvt_pk_bf16(v[j].x * rstd * gg.x, v[j].y * rstd * gg.y); w.y = cvt_pk_bf16(v[j].z * rstd * gg.z, v[j].w * rstd * gg.w); o8[64 * j] = w; }
}
__device__ __forceinline__ void rms_row_f32(const float* xrow, const float* g, float* orow, int lane) {
  const f32x4* xr = (const f32x4*)xrow + lane; const f32x4* gr = (const f32x4*)g + lane;
  f32x4 v[4]; float s = 0.f;
#pragma unroll
  for (int j = 0; j < 4; ++j) { v[j] = xr[64 * j]; s += (v[j].x * v[j].x + v[j].y * v[j].y) + (v[j].z * v[j].z + v[j].w * v[j].w); }
  const float rstd = 1.f / sqrtf(wave_sum(s) * (1.f / DM) + RMS_EPS);
  f32x4* o = (f32x4*)orow + lane;
#pragma unroll
  for (int j = 0; j < 4; ++j) { const f32x4 gg = gr[64 * j]; o[64 * j] = v[j] * rstd * gg; }
}
__device__ __forceinline__ void sincos_acc(float angf, float& sn, float& cs) {
  const double x = (double)angf;
  const double n = __builtin_rint(x * 0.63661977236758134308);
  double r = __builtin_fma(-n, 1.57079632679489655800e+00, x); r = __builtin_fma(-n, 6.12323399573676603587e-17, r);
  const double r2 = r * r;
  double sp = 1.0 / 6227020800.0; sp = sp * r2 - 1.0 / 39916800.0; sp = sp * r2 + 1.0 / 362880.0; sp = sp * r2 - 1.0 / 5040.0; sp = sp * r2 + 1.0 / 120.0; sp = sp * r2 - 1.0 / 6.0; sp = sp * r2 + 1.0; sp *= r;
  double cp = -1.0 / 87178291200.0; cp = cp * r2 + 1.0 / 479001600.0; cp = cp * r2 - 1.0 / 3628800.0; cp = cp * r2 + 1.0 / 40320.0; cp = cp * r2 - 1.0 / 720.0; cp = cp * r2 + 1.0 / 24.0; cp = cp * r2 - 0.5; cp = cp * r2 + 1.0;
  const int q = ((int)(long long)n) & 3;
  const double s_ = (q & 1) ? cp : sp, c_ = (q & 1) ? sp : cp;
  sn = (float)((q & 2) ? -s_ : s_);
  cs = (float)(((q + 1) & 2) ? -c_ : c_);
}

__device__ __forceinline__ int crow(int r, int hi) { return (r & 3) + 8 * (r >> 2) + 4 * hi; }
__device__ __forceinline__ float half_max(float m) { auto rr = __builtin_amdgcn_permlane32_swap(__float_as_uint(m), __float_as_uint(m), false, false); return fmaxf(__uint_as_float(rr[0]), __uint_as_float(rr[1])); }
__device__ __forceinline__ float half_sum(float m) { auto rr = __builtin_amdgcn_permlane32_swap(__float_as_uint(m), __float_as_uint(m), false, false); return __uint_as_float(rr[0]) + __uint_as_float(rr[1]); }
__device__ __forceinline__ bf16x8 ldg8(const unsigned char* base, unsigned off) { return *(const bf16x8*)(base + off); }
__device__ __forceinline__ void softmax_pv(f32x16& s, const bf16x8 (&vf)[4], f32x16& o0, f32x16& o1, float& mrun, float& lrun) {
  float mx = fmaxf(s[0], s[1]);
#pragma unroll
  for (int r = 2; r < 16; ++r) mx = fmaxf(mx, s[r]);
  mx = half_max(mx);
  const float mnew = fmaxf(mrun, mx), alpha = __builtin_amdgcn_exp2f(mrun - mnew); mrun = mnew;
  float ls = 0.f;
#pragma unroll
  for (int r = 0; r < 16; ++r) { s[r] = __builtin_amdgcn_exp2f(s[r] - mnew); ls += s[r]; }
  lrun = lrun * alpha + ls;
#pragma unroll
  for (int r = 0; r < 16; ++r) { o0[r] *= alpha; o1[r] *= alpha; }
  u32x4 w0, w1;
  w0.x = cvt_pk_bf16(s[0], s[1]); w0.y = cvt_pk_bf16(s[2], s[3]); w0.z = cvt_pk_bf16(s[4], s[5]); w0.w = cvt_pk_bf16(s[6], s[7]);
  w1.x = cvt_pk_bf16(s[8], s[9]); w1.y = cvt_pk_bf16(s[10], s[11]); w1.z = cvt_pk_bf16(s[12], s[13]); w1.w = cvt_pk_bf16(s[14], s[15]);
  const bf16x8 p0 = __builtin_bit_cast(bf16x8, w0), p1 = __builtin_bit_cast(bf16x8, w1);
  o0 = __builtin_amdgcn_mfma_f32_32x32x16_bf16(vf[0], p0, o0, 0, 0, 0); o0 = __builtin_amdgcn_mfma_f32_32x32x16_bf16(vf[1], p1, o0, 0, 0, 0);
  o1 = __builtin_amdgcn_mfma_f32_32x32x16_bf16(vf[2], p0, o1, 0, 0, 0); o1 = __builtin_amdgcn_mfma_f32_32x32x16_bf16(vf[3], p1, o1, 0, 0, 0);
}
__device__ __forceinline__ void store_ot(unsigned char* base, unsigned rowoff, const f32x16& o0, const f32x16& o1, float il, int hi) {
#pragma unroll
  for (int a = 0; a < 4; ++a) {
    u32x2 w; w.x = cvt_pk_bf16(o0[4 * a] * il, o0[4 * a + 1] * il); w.y = cvt_pk_bf16(o0[4 * a + 2] * il, o0[4 * a + 3] * il);
    *(u32x2*)(base + rowoff + (8 * a + 4 * hi) * 2) = w;
    u32x2 v; v.x = cvt_pk_bf16(o1[4 * a] * il, o1[4 * a + 1] * il); v.y = cvt_pk_bf16(o1[4 * a + 2] * il, o1[4 * a + 3] * il);
    *(u32x2*)(base + rowoff + (32 + 8 * a + 4 * hi) * 2) = v;
  }
}

__device__ __forceinline__ void mla_attn_phase(unsigned char* big, unsigned char* att, int bx, int G, int wave, int lane) {
  const int r32 = lane & 31, hi = lane >> 5;
  for (int u = bx; u < 512; u += G) {
    const int bh = u >> 5, qb = u & 31, b = bh >> 3, h = bh & 7;
    const unsigned m0 = b * SEQ + qb * 256 + wave * 32 + r32;
    bf16x8 qf[6];
#pragma unroll
    for (int c = 0; c < 4; ++c) qf[c] = ldg8(big + B_QMLA, (m0 * 768 + h * 64 + 16 * c + 8 * hi) * 2u);
#pragma unroll
    for (int c = 0; c < 2; ++c) qf[4 + c] = ldg8(big + B_QMLA, (m0 * 768 + 512 + h * 32 + 16 * c + 8 * hi) * 2u);
    const unsigned char* kn = big + B_KN + ((size_t)b * SEQ * 512 + h * 64) * 2;
    const unsigned char* kp = big + B_KPE + ((size_t)b * SEQ * 32) * 2;
    const unsigned char* vt = big + B_VTMLA + ((size_t)(b * 8 + h) * 64 * SEQ) * 2;
    const unsigned kno = (r32 * 512 + 8 * hi) * 2u, kpo = (r32 * 32 + 8 * hi) * 2u, vto = (r32 * SEQ + 8 * hi) * 2u;
    f32x16 o0 = {0.f, 0.f, 0.f, 0.f, 0.f, 0.f, 0.f, 0.f, 0.f, 0.f, 0.f, 0.f, 0.f, 0.f, 0.f, 0.f}, o1 = o0;
    float mrun = NEG_BIG, lrun = 0.f;
    bf16x8 kfa[6], vfa[4], kfb[6], vfb[4];
#define MLA_LOAD(KF, VF, t) do { \
      _Pragma("unroll") for (int c = 0; c < 4; ++c) KF[c] = ldg8(kn + (size_t)(t) * (32 * 512 * 2), kno + 32 * c); \
      _Pragma("unroll") for (int c = 0; c < 2; ++c) KF[4 + c] = ldg8(kp + (size_t)(t) * (32 * 32 * 2), kpo + 32 * c); \
      _Pragma("unroll") for (int d0 = 0; d0 < 2; ++d0) _Pragma("unroll") for (int j = 0; j < 2; ++j) VF[2 * d0 + j] = ldg8(vt + (size_t)(t) * 64, vto + d0 * (32 * SEQ * 2) + j * 32); } while (0)
#define MLA_TILE(KF, VF) do { f32x16 s = {0.f, 0.f, 0.f, 0.f, 0.f, 0.f, 0.f, 0.f, 0.f, 0.f, 0.f, 0.f, 0.f, 0.f, 0.f, 0.f}; \
      _Pragma("unroll") for (int c = 0; c < 6; ++c) s = __builtin_amdgcn_mfma_f32_32x32x16_bf16(KF[c], qf[c], s, 0, 0, 0); \
      softmax_pv(s, VF, o0, o1, mrun, lrun); } while (0)
    MLA_LOAD(kfa, vfa, 0);
    for (int t = 0; t < SEQ / 32; t += 2) {
      MLA_LOAD(kfb, vfb, t + 1);
      MLA_TILE(kfa, vfa);
      if (t + 2 < SEQ / 32) MLA_LOAD(kfa, vfa, t + 2);
      MLA_TILE(kfb, vfb);
    }
#undef MLA_LOAD
#undef MLA_TILE
    const float il = 1.f / half_sum(lrun);
    store_ot(att, (m0 * 1024 + 512 + h * 64) * 2u, o0, o1, il, hi);
  }
}

__device__ __forceinline__ void na_attn_phase(unsigned char* big, unsigned char* att, const float* rpb, int gw, int NGW, int lane) {
  const int r32 = lane & 31, hi = lane >> 5;
  for (int wt = gw; wt < 4096; wt += NGW) {
    const int w = wt & 1, h = (wt >> 1) & 7, r = (wt >> 4) & 127, b = wt >> 11;
    const int rs = min(max(r - 4, 0), 120), c = 32 * w + r32, cs = min(max(c - 8, 0), 48);
    const unsigned m0 = b * SEQ + r * 64 + c;
    bf16x8 qf[4];
#pragma unroll
    for (int cc = 0; cc < 4; ++cc) qf[cc] = ldg8(big + B_QKNA, (m0 * 1024 + h * 64 + 16 * cc + 8 * hi) * 2u);
    const unsigned char* kb = big + B_QKNA + ((size_t)(b * SEQ + rs * 64) * 1024 + 512 + h * 64) * 2;
    const unsigned char* vt = big + B_VTNA + ((size_t)(b * 8 + h) * 64 * SEQ + rs * 64) * 2;
    const unsigned ko = (r32 * 1024 + 8 * hi) * 2u, vto = (r32 * SEQ + 8 * hi) * 2u;
    const float* bias_h = rpb + h * 15 * 31;
    f32x16 o0 = {0.f, 0.f, 0.f, 0.f, 0.f, 0.f, 0.f, 0.f, 0.f, 0.f, 0.f, 0.f, 0.f, 0.f, 0.f, 0.f}, o1 = o0;
    float mrun = NEG_BIG, lrun = 0.f;
    for (int t = 0; t < 16; ++t) {
      bf16x8 kf[4], vf[4];
#pragma unroll
      for (int cc = 0; cc < 4; ++cc) kf[cc] = ldg8(kb + (size_t)t * (32 * 1024 * 2), ko + 32 * cc);
#pragma unroll
      for (int d0 = 0; d0 < 2; ++d0)
#pragma unroll
        for (int j = 0; j < 2; ++j) vf[2 * d0 + j] = ldg8(vt + (size_t)t * 64, vto + d0 * (32 * SEQ * 2) + j * 32);
      f32x16 s = {0.f, 0.f, 0.f, 0.f, 0.f, 0.f, 0.f, 0.f, 0.f, 0.f, 0.f, 0.f, 0.f, 0.f, 0.f, 0.f};
#pragma unroll
      for (int cc = 0; cc < 4; ++cc) s = __builtin_amdgcn_mfma_f32_32x32x16_bf16(kf[cc], qf[cc], s, 0, 0, 0);
      const int kr = rs + (t >> 1);
      const float* brow = bias_h + (kr - r + 7) * 31;
#pragma unroll
      for (int rr = 0; rr < 16; ++rr) {
        const int kc = 32 * (t & 1) + crow(rr, hi), rel = kc - c + 15;
        const bool ok = (kc >= cs) && (kc < cs + 16);
        const float bv = brow[min(max(rel, 0), 30)];
        s[rr] = ok ? s[rr] + bv * LOG2E : NEG_BIG;
      }
      softmax_pv(s, vf, o0, o1, mrun, lrun);
    }
    const float il = 1.f / half_sum(lrun);
    store_ot(att, (m0 * 1024 + h * 64) * 2u, o0, o1, il, hi);
  }
}

__device__ __forceinline__ void dil_attn_phase(unsigned char* big, unsigned char* att, int ch, int bx, int G, int wave, int lane, int tid) {
  const int r32 = lane & 31, hi = lane >> 5;
  float* lse = (float*)(big + B_LSE);
  for (int u = bx; u < 256; u += G) {
    const int b = u >> 7, hl = (u >> 4) & 7, P0 = (u & 15) * 512;
    for (int wt = wave; wt < 48; wt += 8) {
      const int gq = wt >> 4, j = wt & 15, sh = 2 * gq;
      const int rho = (gq == 0) ? 0 : (gq == 1) ? (j >> 2) : j, it = (gq == 0) ? j : (gq == 1) ? (j & 3) : 0;
      const int i0 = (P0 >> sh) + 32 * it, nseq = SEQ >> sh;
      const unsigned mq = b * SEQ + ((i0 + r32) << sh) + rho;
      bf16x8 qf[4];
#pragma unroll
      for (int cc = 0; cc < 4; ++cc) qf[cc] = ldg8(big + B_QK, (mq * 3072 + gq * 1024 + hl * 64 + 16 * cc + 8 * hi) * 2u);
      const unsigned char* vt = big + B_VT + ((size_t)((b * 3 + gq) * 8 + hl) * 64 * SEQ + rho * nseq) * 2;
      const unsigned vto = (r32 * SEQ + 8 * hi) * 2u;
      f32x16 o0 = {0.f, 0.f, 0.f, 0.f, 0.f, 0.f, 0.f, 0.f, 0.f, 0.f, 0.f, 0.f, 0.f, 0.f, 0.f, 0.f}, o1 = o0;
      float mrun = NEG_BIG, lrun = 0.f;
      for (int t = 0; t < 5; ++t) {
        const int k0 = i0 - 64 + 32 * t;
        if (k0 < 0 || k0 >= nseq) continue;
        const unsigned mk = b * SEQ + ((k0 + r32) << sh) + rho;
        bf16x8 kf[4], vf[4];
#pragma unroll
        for (int cc = 0; cc < 4; ++cc) kf[cc] = ldg8(big + B_QK, (mk * 3072 + gq * 1024 + 512 + hl * 64 + 16 * cc + 8 * hi) * 2u);
#pragma unroll
        for (int d0 = 0; d0 < 2; ++d0)
#pragma unroll
          for (int jj = 0; jj < 2; ++jj) vf[2 * d0 + jj] = ldg8(vt + (size_t)k0 * 2, vto + d0 * (32 * SEQ * 2) + jj * 32);
        f32x16 s = {0.f, 0.f, 0.f, 0.f, 0.f, 0.f, 0.f, 0.f, 0.f, 0.f, 0.f, 0.f, 0.f, 0.f, 0.f, 0.f};
#pragma unroll
        for (int cc = 0; cc < 4; ++cc) s = __builtin_amdgcn_mfma_f32_32x32x16_bf16(kf[cc], qf[cc], s, 0, 0, 0);
        if (t == 0) {
#pragma unroll
          for (int rr = 0; rr < 16; ++rr) s[rr] = (crow(rr, hi) >= r32) ? s[rr] : NEG_BIG;
        } else if (t == 4) {
#pragma unroll
          for (int rr = 0; rr < 16; ++rr) s[rr] = (crow(rr, hi) <= r32) ? s[rr] : NEG_BIG;
        }
        softmax_pv(s, vf, o0, o1, mrun, lrun);
      }
      const float lt = half_sum(lrun), il = 1.f / lt;
      store_ot(big + B_QK, (mq * 3072 + gq * 1024 + hl * 64) * 2u, o0, o1, il, hi);
      if (hi == 0) lse[(mq * 8 + hl) * 3 + gq] = mrun + __builtin_amdgcn_logf(lt);
    }
    __threadfence(); __syncthreads();
    {
      const unsigned m = b * SEQ + P0 + tid;
      const float l0 = lse[(m * 8 + hl) * 3 + 0], l1 = lse[(m * 8 + hl) * 3 + 1], l2 = lse[(m * 8 + hl) * 3 + 2];
      const float lm = fmaxf(l0, fmaxf(l1, l2));
      float w0 = __builtin_amdgcn_exp2f(l0 - lm), w1 = __builtin_amdgcn_exp2f(l1 - lm), w2 = __builtin_amdgcn_exp2f(l2 - lm);
      const float iw = 1.f / (w0 + w1 + w2); w0 *= iw; w1 *= iw; w2 *= iw;
#pragma unroll
      for (int jj = 0; jj < 8; ++jj) {
        float a0[8], a1[8], a2[8];
        unpack8(*(const u32x4*)(big + B_QK + ((size_t)m * 3072 + 0 * 1024 + hl * 64 + 8 * jj) * 2), a0);
        unpack8(*(const u32x4*)(big + B_QK + ((size_t)m * 3072 + 1 * 1024 + hl * 64 + 8 * jj) * 2), a1);
        unpack8(*(const u32x4*)(big + B_QK + ((size_t)m * 3072 + 2 * 1024 + hl * 64 + 8 * jj) * 2), a2);
        float f[8];
#pragma unroll
        for (int e = 0; e < 8; ++e) f[e] = w0 * a0[e] + w1 * a1[e] + w2 * a2[e];
        u32x4 wv; wv.x = cvt_pk_bf16(f[0], f[1]); wv.y = cvt_pk_bf16(f[2], f[3]); wv.z = cvt_pk_bf16(f[4], f[5]); wv.w = cvt_pk_bf16(f[6], f[7]);
        *(u32x4*)(att + ((size_t)m * 1024 + (8 * ch + hl) * 64 + 8 * jj) * 2) = wv;
      }
    }
    __syncthreads();
  }
}

#define XB_TMO      128
#define XB_XCNT(j)  (256  + 64 * (j))
#define XB_XSUB(j)  (1280 + 64 * (j))
#define XB_XGEN(j)  (2304 + 64 * (j))
#define XB_TOP      3328
#define XB_TOPGEN   3392
#define XCD_BAR_WORDS 3456
#define XB_SPIN_CAP (1u << 18)
__device__ __forceinline__ unsigned xb_ld(unsigned* p)              { return __hip_atomic_load(p, __ATOMIC_RELAXED, __HIP_MEMORY_SCOPE_AGENT); }
__device__ __forceinline__ unsigned xb_add(unsigned* p, unsigned v) { return __hip_atomic_fetch_add(p, v, __ATOMIC_RELAXED, __HIP_MEMORY_SCOPE_AGENT); }
__device__ __forceinline__ unsigned xb_xcc_id() { return (unsigned)__builtin_amdgcn_s_getreg((3 << 11) | 20) & 0xFu; }
#define XB_SPIN(cond, bar) do { unsigned _sp = 0; while (cond) { __builtin_amdgcn_s_sleep(1); \
    if ((++_sp & 255u) == 0u) { if (xb_ld(&(bar)[XB_TMO])) break; if (_sp > XB_SPIN_CAP) { atomicAdd(&(bar)[XB_TMO], 1u); break; } } } } while (0)
struct XcdBarrier { unsigned* bar; unsigned x; volatile LAS unsigned* st; };
__device__ __forceinline__ XcdBarrier xcd_barrier_post(unsigned* bar, volatile LAS unsigned* st) {
  XcdBarrier b; b.bar = bar; b.x = xb_xcc_id(); b.st = st;
  if (threadIdx.x == 0) (void)xb_add(&bar[XB_XCNT(b.x)], 1u);
  return b;
}
__device__ __forceinline__ void xcd_barrier_complete(unsigned* bar, unsigned x, unsigned& nloc, unsigned& nx) {
  const unsigned G = gridDim.x * gridDim.y * gridDim.z;
  unsigned sum, cnt, mine, sp = 0u;
  for (;;) {
    sum = 0u; cnt = 0u; mine = 0u;
#pragma unroll
    for (unsigned j = 0; j < 16; ++j) { const unsigned c = xb_ld(&bar[XB_XCNT(j)]); sum += c; cnt += (c > 0u) ? 1u : 0u; mine = (j == x) ? c : mine; }
    if (sum == G) break;
    __builtin_amdgcn_s_sleep(1);
    if ((++sp & 255u) == 0u) { if (xb_ld(&bar[XB_TMO])) break; if (sp > XB_SPIN_CAP) { atomicAdd(&bar[XB_TMO], 1u); break; } }
  }
  nloc = mine > 0u ? mine : 1u; nx = cnt > 0u ? cnt : 1u;
}
__device__ __forceinline__ void xcd_barrier(const XcdBarrier& b) {
  asm volatile("s_waitcnt vmcnt(0)" ::: "memory");
  __syncthreads();
  if (threadIdx.x == 0) {
    unsigned* bar = b.bar;
    __builtin_amdgcn_s_waitcnt(0);
    unsigned nloc = b.st[0], nx = b.st[1];
    if (nloc == 0u) { xcd_barrier_complete(bar, b.x, nloc, nx); b.st[0] = nloc; b.st[1] = nx; }
    const unsigned old = xb_add(&bar[XB_XSUB(b.x)], 1u);
    const unsigned gen = old / nloc;
    if (old + 1u == (gen + 1u) * nloc) {
      __builtin_amdgcn_fence(__ATOMIC_RELEASE, "agent");
      asm volatile("s_waitcnt vmcnt(0)" ::: "memory");
      const unsigned og = xb_add(&bar[XB_TOP], 1u);
      const unsigned tg = og / nx;
      if (og + 1u == (tg + 1u) * nx) xb_add(&bar[XB_TOPGEN], 1u);
      else XB_SPIN(xb_ld(&bar[XB_TOPGEN]) == tg, bar);
      __builtin_amdgcn_fence(__ATOMIC_ACQUIRE, "agent");
      xb_add(&bar[XB_XGEN(b.x)], 1u);
      asm volatile("s_waitcnt vmcnt(0)" ::: "memory");
    } else {
      XB_SPIN(xb_ld(&bar[XB_XGEN(b.x)]) == gen, bar);
      __builtin_amdgcn_fence(__ATOMIC_ACQUIRE, "agent");
      asm volatile("s_waitcnt vmcnt(0)" ::: "memory");
    }
  }
  __syncthreads();
}

__device__ __forceinline__ const void* ldptr(LAS unsigned char* lds, int i) {
  const volatile LAS unsigned* p = (const volatile LAS unsigned*)(lds + 131072) + 2 * i;
  const unsigned lo = __builtin_amdgcn_readfirstlane(p[0]), hi = __builtin_amdgcn_readfirstlane(p[1]);
  return (const void*)(((unsigned long long)hi << 32) | lo);
}
struct Args { const float* in[15]; float* out; unsigned char* ws; int ph_lo, ph_hi; };

__global__ void __launch_bounds__(512, 2) fwd(Args a) {
  extern __shared__ __attribute__((aligned(16))) unsigned char lds_raw[];
  LAS unsigned char* lds = (LAS unsigned char*)lds_raw;
  cg::grid_group grid = cg::this_grid();
  const int G = gridDim.x, bx = blockIdx.x;
  const int gsz = G * 512, NGW = G * 8;
  if (threadIdx.x < 15) ((LAS unsigned long long*)(lds + 131072))[threadIdx.x] = (unsigned long long)a.in[threadIdx.x];
  if (threadIdx.x == 15) ((LAS unsigned long long*)(lds + 131072))[15] = (unsigned long long)a.out;
  if (threadIdx.x == 16) ((LAS unsigned long long*)(lds + 131072))[16] = (unsigned long long)a.ws;
  if (threadIdx.x == 17) { ((LAS unsigned*)(lds + 131072 + 256))[0] = 0u; ((LAS unsigned*)(lds + 131072 + 256))[1] = 0u; }
  if (bx == 0) for (int i = threadIdx.x; i < XCD_BAR_WORDS; i += 512) ((unsigned*)a.ws)[i] = 0u;
  __syncthreads();
  XcdBarrier xbar; xbar.bar = (unsigned*)a.ws; xbar.x = 0; xbar.st = (volatile LAS unsigned*)(lds + 131072 + 256);
#define INP(i) ((const float*)ldptr(lds, (i)))

  if (a.ph_lo == 0) {
    const int gtid0 = bx * 512 + threadIdx.x;
    float* cos64 = (float*)(a.ws + WS_COS64); float* sin64 = (float*)(a.ws + WS_SIN64); float* cos32 = (float*)(a.ws + WS_COS32); float* sin32 = (float*)(a.ws + WS_SIN32);
    for (int i = gtid0; i < SEQ * 32; i += gsz) { const int pos = i >> 5, kk = i & 31; float sn, cs; sincos_acc((float)pos * INV64[kk], sn, cs); cos64[i] = cs; sin64[i] = sn; }
    for (int i = gtid0; i < SEQ * 16; i += gsz) { const int pos = i >> 4, kk = i & 15; float sn, cs; sincos_acc((float)pos * INV64[2 * kk], sn, cs); cos32[i] = cs; sin32[i] = sn; }
  }
#ifdef ONE_LAUNCH
  for (int ph = a.ph_lo; ph < a.ph_hi; ++ph) {
#else
  { const int ph = a.ph_lo;
#endif
    int tid = threadIdx.x; asm volatile("" : "+v"(tid));
    const int lane = tid & 63, wave = __builtin_amdgcn_readfirstlane(tid >> 6), gtid = bx * 512 + tid, gw = bx * 8 + wave;
    unsigned char* ws = a.ws;
    float* X = a.out;
    unsigned char* big = ws + WS_BIG;
    bf16_t* XN = (bf16_t*)(ws + WS_XN); bf16_t* ATT = (bf16_t*)(ws + WS_ATT);
    const float* cos64 = (const float*)(ws + WS_COS64); const float* sin64 = (const float*)(ws + WS_SIN64);
    const float* cos32 = (const float*)(ws + WS_COS32); const float* sin32 = (const float*)(ws + WS_SIN32);
    if (ph == NPH - 1) {
      for (int m = gw; m < M; m += NGW) rms_row_f32(X + (size_t)m * DM, INP(3), X + (size_t)m * DM, lane);
    } else {
      const int L = ph / 9, k = ph % 9, e = L >> 1; const bool even = !(L & 1);
      const float* xsrc = (L == 0) ? INP(0) : X;
      if (k == 0) {
        LAS float* scr = (LAS float*)(lds + wave * 16384);
        const float* w1 = INP(13) + (size_t)L * DM * FF; const float* w2 = INP(14) + (size_t)L * FF * DM;
        const float* wo = even ? INP(10) + (size_t)e * DM * DM : INP(12) + (size_t)e * DM * DM;
        const int nin = even ? EV_N : 2 * OD_NC;
        const int I_IN = 16 * (nin / 32), I_O = 16 * 32, I_1 = 16 * 128, I_2 = 64 * 32, I_UQ = even ? 4 * 24 : 0, I_UKV = even ? 2 * 32 : 0;
        const int NIT = I_IN + I_O + I_1 + I_2 + I_UQ + I_UKV;
        for (int it = gw; it < NIT; it += NGW) {
          int r = it;
          if (r < I_IN) { if (even) transpose_item(INP(4) + (size_t)e * DM * 1952, DM, 1952, EV_N, (bf16_t*)(ws + WS_W + W_IN), CM_EVIN, scr, r, lane);
                          else transpose_item(INP(11) + (size_t)e * DM * 9216, DM, 9216, 2 * OD_NC, (bf16_t*)(ws + WS_W + W_IN), CM_ODIN, scr, r, lane); continue; } r -= I_IN;
          if (r < I_O) { transpose_item(wo, DM, DM, DM, (bf16_t*)(ws + WS_W + W_O), CM_ID, scr, r, lane); continue; } r -= I_O;
          if (r < I_1) { transpose_item(w1, DM, FF, FF, (bf16_t*)(ws + WS_W + W_1), CM_ID, scr, r, lane); continue; } r -= I_1;
          if (r < I_2) { transpose_item(w2, FF, DM, DM, (bf16_t*)(ws + WS_W + W_2), CM_ID, scr, r, lane); continue; } r -= I_2;
          if (r < I_UQ) { transpose_item(INP(7) + (size_t)e * 256 * 768, 256, 768, 768, (bf16_t*)(ws + WS_W + W_UQ), CM_UQ, scr, r, lane); continue; } r -= I_UQ;
          transpose_item(INP(9) + (size_t)e * 128 * 1024, 128, 1024, 1024, (bf16_t*)(ws + WS_W + W_UKV), CM_UKV, scr, r, lane);
        }
        for (int m = gw; m < M; m += NGW) rms_row_bf16(xsrc + (size_t)m * DM, INP(1) + L * DM, XN + (size_t)m * DM, lane);
      } else if (k == 6) {
        for (int m = gw; m < M; m += NGW) rms_row_bf16(X + (size_t)m * DM, INP(2) + L * DM, XN + (size_t)m * DM, lane);
      } else if (even && k == 2) {
        const bf16_t* CR = (const bf16_t*)(big + B_CRAW); bf16_t* CQN = (bf16_t*)(big + B_CQN); bf16_t* CKVN = (bf16_t*)(big + B_CKVN);
        const float* gq = INP(6) + e * 256; const float* gkv = INP(8) + e * 128;
        for (int m = gw; m < M; m += NGW) {
          const u32x2 w = *(const u32x2*)(CR + (size_t)m * 384 + 4 * lane);
          const float v0 = bflo(w.x), v1 = bfhi(w.x), v2 = bflo(w.y), v3 = bfhi(w.y);
          const float rq = 1.f / sqrtf(wave_sum(v0 * v0 + v1 * v1 + v2 * v2 + v3 * v3) * (1.f / 256.f) + RMS_EPS);
          const f32x4 g4 = *(const f32x4*)(gq + 4 * lane);
          u32x2 o; o.x = cvt_pk_bf16(v0 * rq * g4.x, v1 * rq * g4.y); o.y = cvt_pk_bf16(v2 * rq * g4.z, v3 * rq * g4.w);
          *(u32x2*)(CQN + (size_t)m * 256 + 4 * lane) = o;
          const unsigned w2 = *(const unsigned*)(CR + (size_t)m * 384 + 256 + 2 * lane);
          const float u0 = bflo(w2), u1 = bfhi(w2);
          const float rk = 1.f / sqrtf(wave_sum(u0 * u0 + u1 * u1) * (1.f / 128.f) + RMS_EPS);
          const f32x2 g2 = *(const f32x2*)(gkv + 2 * lane);
          *(unsigned*)(CKVN + (size_t)m * 128 + 2 * lane) = cvt_pk_bf16(u0 * rk * g2.x, u1 * rk * g2.y);
        }
      } else if (even && k == 4) {
        na_attn_phase(big, (unsigned char*)ATT, INP(5) + (size_t)e * 8 * 15 * 31, gw, NGW, lane);
        mla_attn_phase(big, (unsigned char*)ATT, bx, G, wave, lane);
      } else if (!even && (k == 2 || k == 4)) {
        dil_attn_phase(big, (unsigned char*)ATT, (k == 2) ? 0 : 1, bx, G, wave, lane, tid);
      } else {
        const int nsub = (even && k == 3) ? 2 : 1;
        for (int sub = 0; sub < nsub; ++sub) {
          pg8::Gemm g; pg8::StaticOrder S; EpiB E; E.ws = ws;
          g.M = M;
          E.base = (k == 5) ? xsrc : X; E.outf = X;
          if (k == 5) { g.A = ATT; g.Bt = (const bf16_t*)(ws + WS_W + W_O); g.N = DM; g.K = DM; E.kind = K_RESID; }
          else if (k == 8) { g.A = (const bf16_t*)big; g.Bt = (const bf16_t*)(ws + WS_W + W_2); g.N = DM; g.K = FF; E.kind = K_RESID; }
          else if (k == 7) { g.A = XN; g.Bt = (const bf16_t*)(ws + WS_W + W_1); g.N = FF; g.K = DM; E.kind = K_RELU2; }
          else if (even && k == 1) { g.A = XN; g.Bt = (const bf16_t*)(ws + WS_W + W_IN); g.N = EV_N; g.K = DM; E.kind = K_EVIN; }
          else if (even) {
            if (sub == 0) { g.A = (const bf16_t*)(big + B_CQN); g.Bt = (const bf16_t*)(ws + WS_W + W_UQ); g.N = 768; g.K = 256; E.kind = K_UQ; }
            else { g.A = (const bf16_t*)(big + B_CKVN); g.Bt = (const bf16_t*)(ws + WS_W + W_UKV); g.N = 1024; g.K = 128; E.kind = K_UKV; }
          } else { const int ch = (k == 1) ? 0 : 1; g.A = XN; g.Bt = (const bf16_t*)(ws + WS_W + W_IN) + (size_t)ch * OD_NC * DM; g.N = OD_NC; g.K = DM; E.kind = K_ODIN; }
          S.init(M, g.N, G, bx);
          pg8::gemm_phase<EpiB>(lds, g, S, E);
        }
      }
    }
#ifdef ONE_LAUNCH
    if (ph + 1 < a.ph_hi) {
      if (ph == a.ph_lo) { grid.sync(); xbar = xcd_barrier_post((unsigned*)a.ws, (volatile LAS unsigned*)(lds + 131072 + 256)); }
      else xcd_barrier(xbar);
    }
#endif
  }
}

extern "C" void kernel_launch(void* const* d_in, const int* in_sizes, int n_in, void* d_out, int out_size, void* d_ws, size_t ws_size, hipStream_t stream) {
  static int grid = 0;
  if (!grid) {
    if (n_in != 15 || out_size != M * DM || ws_size < WS_END) { fprintf(stderr, "kernel_launch: unexpected sizes n_in %d out %d ws %zu (need %zu)\n", n_in, out_size, ws_size, (size_t)WS_END); grid = -1; return; }
    int dev = 0, cus = 0, per_cu = 0;
    (void)hipGetDevice(&dev);
    (void)hipDeviceGetAttribute(&cus, hipDeviceAttributeMultiprocessorCount, dev);
    (void)hipFuncSetAttribute((const void*)fwd, hipFuncAttributeMaxDynamicSharedMemorySize, LDS_BYTES);
    (void)hipOccupancyMaxActiveBlocksPerMultiprocessor(&per_cu, (const void*)fwd, 512, LDS_BYTES);
    if (per_cu < 1) per_cu = 1;
    grid = cus * per_cu;
  }
  if (grid < 0) return;
  Args a{};
  for (int i = 0; i < 15; ++i) a.in[i] = (const float*)d_in[i];
  a.out = (float*)d_out; a.ws = (unsigned char*)d_ws;
#ifndef ONE_LAUNCH
  for (int ph = 0; ph < NPH; ++ph) {
    a.ph_lo = ph; a.ph_hi = ph + 1;
    hipLaunchKernelGGL(fwd, dim3(grid), dim3(512), LDS_BYTES, stream, a);
  }
#else
  a.ph_lo = 0; a.ph_hi = NPH;
  void* args[] = {&a};
  hipError_t er = hipLaunchCooperativeKernel((const void*)fwd, dim3(grid), dim3(512), args, LDS_BYTES, stream);
  if (er != hipSuccess) fprintf(stderr, "cooperative launch failed: %s (grid %d)\n", hipGetErrorString(er), grid);
#endif
}
```

```cpp
#include <hip/hip_runtime.h>
#include <hip/hip_cooperative_groups.h>
#include <cstdio>
#include <cstdint>
namespace cg = cooperative_groups;
#define ONE_LAUNCH 1

#define LAS __attribute__((address_space(3)))
typedef unsigned short bf16_t;
typedef short bf16x8 __attribute__((ext_vector_type(8)));
typedef float f32x4 __attribute__((ext_vector_type(4)));
typedef float f32x2 __attribute__((ext_vector_type(2)));
typedef float f32x16 __attribute__((ext_vector_type(16)));
typedef unsigned u32x4 __attribute__((ext_vector_type(4)));
typedef unsigned u32x2 __attribute__((ext_vector_type(2)));

constexpr int M = 16384, SEQ = 8192, DM = 1024, FF = 4096;
constexpr int EV_N = 2048;
constexpr int OD_NC = 4608;
constexpr float LOG2E = 1.4426950408889634f;
constexpr float C_NA = 0.125f * LOG2E;
constexpr float C_MLA = 0.10206207261596575f * LOG2E;
constexpr float RMS_EPS = 1e-6f;
constexpr float NEG_BIG = -1e30f;

constexpr size_t MiB = 1u << 20;
constexpr size_t WS_COS64 = 1 * MiB, WS_SIN64 = 2 * MiB, WS_COS32 = 3 * MiB, WS_SIN32 = 3 * MiB + 512 * 1024;
constexpr size_t WS_W = 4 * MiB;
constexpr size_t W_IN = 0, W_O = 18 * MiB, W_1 = 20 * MiB, W_2 = 28 * MiB, W_UQ = 36 * MiB, W_UKV = 36 * MiB + 512 * 1024;
constexpr size_t WS_XN = 41 * MiB;
constexpr size_t WS_ATT = 73 * MiB;
constexpr size_t WS_BIG = 105 * MiB;
constexpr size_t B_QKNA = 0, B_VTNA = 32 * MiB, B_CRAW = 48 * MiB, B_CQN = 60 * MiB, B_CKVN = 68 * MiB, B_KPE = 72 * MiB,
                 B_QMLA = 73 * MiB, B_KN = 97 * MiB, B_VTMLA = 113 * MiB;
constexpr size_t B_QK = 0, B_VT = 96 * MiB, B_LSE = 144 * MiB;
constexpr size_t WS_END = WS_BIG + 146 * MiB;

constexpr int LDS_BYTES = 147456;
constexpr int NPH = 37;

__device__ const float INV64[32] = {
  1.000000000e+00f, 7.498942018e-01f, 5.623413324e-01f, 4.216965139e-01f, 3.162277639e-01f, 2.371373922e-01f, 1.778279394e-01f, 1.333521456e-01f,
  1.000000015e-01f, 7.498941571e-02f, 5.623412877e-02f, 4.216964915e-02f, 3.162277862e-02f, 2.371373586e-02f, 1.778279431e-02f, 1.333521493e-02f,
  9.999999776e-03f, 7.498942316e-03f, 5.623413250e-03f, 4.216964822e-03f, 3.162277862e-03f, 2.371373819e-03f, 1.778279431e-03f, 1.333521446e-03f,
  1.000000047e-03f, 7.498941850e-04f, 5.623413017e-04f, 4.216965463e-04f, 3.162277862e-04f, 2.371373848e-04f, 1.778279402e-04f, 1.333521504e-04f};

__device__ __forceinline__ unsigned cvt_pk_bf16(float lo, float hi) { unsigned r; asm volatile("v_cvt_pk_bf16_f32 %0, %1, %2" : "=v"(r) : "v"(lo), "v"(hi)); return r; }
__device__ __forceinline__ bf16_t f2bf(float f) { return (bf16_t)(cvt_pk_bf16(f, 0.f) & 0xffffu); }
__device__ __forceinline__ float bf2f(unsigned short h) { return __uint_as_float(((unsigned)h) << 16); }
__device__ __forceinline__ float bflo(unsigned w) { return __uint_as_float(w << 16); }
__device__ __forceinline__ float bfhi(unsigned w) { return __uint_as_float(w & 0xffff0000u); }
__device__ __forceinline__ int vtidx(int p) { return (p & ~12) | ((p & 4) << 1) | ((p & 8) >> 1); }
__device__ __forceinline__ float wave_sum(float v) {
#pragma unroll
  for (int o = 1; o < 64; o <<= 1) v += __shfl_xor(v, o);
  return v;
}
__device__ __forceinline__ void unpack8(const u32x4 w, float* f) {
  f[0] = bflo(w.x); f[1] = bfhi(w.x); f[2] = bflo(w.y); f[3] = bfhi(w.y); f[4] = bflo(w.z); f[5] = bfhi(w.z); f[6] = bflo(w.w); f[7] = bfhi(w.w);
}

namespace pg8 {
constexpr int BM = 256, BK = 64, HALF = 128, HTB = HALF * BK * 2, STAGE_BYTES = 8 * HTB, NXCD = 8, WGM = 8;
__host__ __device__ __forceinline__ int lds_byte(int r, int c) { const int st = (r >> 4) * 2 + (c >> 5), rr = r & 15, cc = c & 31, ob = rr * 64 + cc * 2; return st * 1024 + (ob ^ (((ob >> 9) & 1) << 5)); }
__host__ __device__ __forceinline__ void stage_rc(int b, int& R, int& C) { const int st = b / 1024, sb = b % 1024, swz = sb ^ (((sb >> 9) & 1) << 5); R = (st >> 1) * 16 + swz / 64; C = (st & 1) * 32 + (swz % 64) / 2; }
__host__ __device__ __forceinline__ int perm32(int rho) { const int n = rho >> 4, i = rho & 15; return 8 * (i >> 2) + 4 * n + (i & 3); }

struct Unit { int pm, pn; };
struct Gemm { const bf16_t* A; const bf16_t* Bt; int M, N, K; };
struct StaticOrder {
  int nM, nN, nwg, G, c;
  __device__ void init(int M_, int N_, int G_, int c_) { nM = M_ / BM; nN = N_ / BM; nwg = nM * nN; G = G_; c = c_; }
  __device__ bool next(int i, Unit& u) const {
    const long L = (long)i * G + c; if (L >= nwg) return false;
    int wgid = (int)L; { const int q = nwg / NXCD, r = nwg % NXCD, xcd = wgid % NXCD, off = wgid / NXCD; wgid = (xcd < r ? xcd * (q + 1) : r * (q + 1) + (xcd - r) * q) + off; }
    const int nig = WGM * nN, gid = wgid / nig, fm = gid * WGM, gsz = (nM - fm) < WGM ? (nM - fm) : WGM;
    u.pm = fm + ((wgid % nig) % gsz); u.pn = (wgid % nig) / gsz; return true;
  }
};

template <class Epi>
__device__ __forceinline__ void gemm_phase(LAS unsigned char* lds, const Gemm g, const StaticOrder& S, const Epi& E) {
  int tid = threadIdx.x; asm volatile("" : "+v"(tid));
  const int wid = __builtin_amdgcn_readfirstlane(tid >> 6), lane = tid & 63, wr = wid >> 2, wc = wid & 3, fr = lane & 15, fq = lane >> 4;
  constexpr bool PERM = true; const int K = g.K, nt = K / BK;
  unsigned voffA[2], voffB[2];
#pragma unroll
  for (int i = 0; i < 2; ++i) { int R, C; stage_rc(tid * 16 + i * 8192, R, C); const int Rb = PERM ? ((R & ~31) + perm32(R & 31)) : R;
    voffA[i] = (unsigned)(R * K + C) * 2u; voffB[i] = (unsigned)(Rb * K + C) * 2u; }
  const size_t kstep = (size_t)(BK * 2);
  const size_t hstep = (size_t)HALF * K * 2;
  const size_t tstep = 2 * hstep;
  const unsigned ldsw = (unsigned)wid * 1024u;
  const int aoff = lds_byte(wr * 64 + fr, fq * 8), boff = lds_byte(wc * 32 + fr, fq * 8);
#define PG8_SA(b, h) (((b) * 2 + (h)) * HTB)
#define PG8_SB(b, h) ((4 + (b) * 2 + (h)) * HTB)
#define PG8_STAGE(bufoff, gbase, voff) do { _Pragma("unroll") for (int _i = 0; _i < 2; ++_i) \
    __builtin_amdgcn_global_load_lds((const unsigned*)((const char*)(gbase) + (voff)[_i]), (LAS unsigned*)(lds + (bufoff) + ldsw + _i * 8192), 16, 0, 0); } while (0)
#define PG8_LDA(dst, b, h) do { _Pragma("unroll") for (int m = 0; m < 4; ++m) _Pragma("unroll") for (int k = 0; k < 2; ++k) dst[m][k] = *(const LAS bf16x8*)(lds + PG8_SA(b, h) + aoff + m * 2048 + k * 1024); } while (0)
#define PG8_LDB(dst, b, h) do { _Pragma("unroll") for (int n = 0; n < 2; ++n) _Pragma("unroll") for (int k = 0; k < 2; ++k) dst[n][k] = *(const LAS bf16x8*)(lds + PG8_SB(b, h) + boff + n * 2048 + k * 1024); } while (0)
#define PG8_MMA(ai, bj, At, Bt) do { __builtin_amdgcn_s_setprio(1); _Pragma("unroll") for (int m = 0; m < 4; ++m) _Pragma("unroll") for (int n = 0; n < 2; ++n) _Pragma("unroll") for (int k = 0; k < 2; ++k) \
    acc[ai][bj][m][n] = __builtin_amdgcn_mfma_f32_16x16x32_bf16(Bt[n][k], At[m][k], acc[ai][bj][m][n], 0, 0, 0); __builtin_amdgcn_s_setprio(0); } while (0)
#define PG8_WAIT_V(n) asm volatile("s_waitcnt vmcnt(" #n ")" ::: "memory")
#define PG8_WAIT_L(n) asm volatile("s_waitcnt lgkmcnt(" #n ")" ::: "memory")
#define PG8_BAR __builtin_amdgcn_s_barrier()
#define PG8_SCHED __builtin_amdgcn_sched_barrier(0)
  Unit cur, nxt; int ui = 0;
  if (!S.next(0, cur)) return;
  f32x4 acc[2][2][4][2];
#pragma unroll
  for (int a = 0; a < 2; ++a)
#pragma unroll
    for (int b = 0; b < 2; ++b)
#pragma unroll
      for (int m = 0; m < 4; ++m)
#pragma unroll
        for (int n = 0; n < 2; ++n) acc[a][b][m][n] = (f32x4){0.f, 0.f, 0.f, 0.f};
  bf16x8 At[4][2], B0[2][2], B1[2][2];
  const char* cA = (const char*)g.A + (size_t)cur.pm * tstep; const char* cB = (const char*)g.Bt + (size_t)cur.pn * tstep;
  PG8_STAGE(PG8_SB(0, 0), cB, voffB); PG8_STAGE(PG8_SB(0, 1), cB + hstep, voffB); PG8_STAGE(PG8_SA(0, 0), cA, voffA); PG8_STAGE(PG8_SA(0, 1), cA + hstep, voffA);
  if (wr == 1) PG8_BAR;
  PG8_WAIT_V(2); PG8_BAR;
  PG8_STAGE(PG8_SB(1, 0), cB + kstep, voffB); PG8_STAGE(PG8_SA(1, 0), cA + kstep, voffA); PG8_STAGE(PG8_SB(1, 1), cB + hstep + kstep, voffB);
  PG8_WAIT_V(6); PG8_BAR;
  for (;;) {
    const bool has_next = S.next(ui + 1, nxt);
    const char* nA = has_next ? (const char*)g.A + (size_t)nxt.pm * tstep : cA; const char* nB = has_next ? (const char*)g.Bt + (size_t)nxt.pn * tstep : cB;
    for (int t = 0; t < nt; t += 2) {
      const bool last = (t == nt - 2);
      const char* a1 = cA + (size_t)(t + 1) * kstep;
      const char* a2 = last ? nA : cA + (size_t)(t + 2) * kstep; const char* b2 = last ? nB : cB + (size_t)(t + 2) * kstep;
      const char* a3 = a2 + kstep; const char* b3 = b2 + kstep;
      PG8_LDB(B0, 0, 0); PG8_LDB(B1, 0, 1); PG8_SCHED; PG8_LDA(At, 0, 0); PG8_STAGE(PG8_SA(1, 1), a1 + hstep, voffA);
      PG8_WAIT_V(8); PG8_WAIT_L(0); PG8_BAR; PG8_MMA(0, 0, At, B0); PG8_MMA(0, 1, At, B1); PG8_BAR; PG8_SCHED;
      PG8_LDA(At, 0, 1); PG8_STAGE(PG8_SB(0, 0), b2, voffB); PG8_STAGE(PG8_SB(0, 1), b2 + hstep, voffB); PG8_STAGE(PG8_SA(0, 0), a2, voffA);
      PG8_WAIT_V(8); PG8_WAIT_L(0); PG8_BAR; PG8_MMA(1, 0, At, B0); PG8_MMA(1, 1, At, B1); PG8_BAR; PG8_SCHED;
      PG8_LDB(B0, 1, 0); PG8_LDB(B1, 1, 1); PG8_SCHED; PG8_LDA(At, 1, 0); PG8_STAGE(PG8_SA(0, 1), a2 + hstep, voffA);
      PG8_WAIT_V(8); PG8_WAIT_L(0); PG8_BAR; PG8_MMA(0, 0, At, B0); PG8_MMA(0, 1, At, B1); PG8_BAR; PG8_SCHED;
      PG8_LDA(At, 1, 1); PG8_STAGE(PG8_SB(1, 0), b3, voffB); PG8_STAGE(PG8_SB(1, 1), b3 + hstep, voffB); PG8_STAGE(PG8_SA(1, 0), a3, voffA);
      PG8_WAIT_V(8); PG8_WAIT_L(0); PG8_BAR; PG8_MMA(1, 0, At, B0); PG8_MMA(1, 1, At, B1); PG8_BAR; PG8_SCHED;
    }
    if (wr == 0) PG8_BAR;
    E(acc, cur, wr, wc, fr, fq);
    if (!has_next) break;
#pragma unroll
    for (int a = 0; a < 2; ++a)
#pragma unroll
      for (int b = 0; b < 2; ++b)
#pragma unroll
        for (int m = 0; m < 4; ++m)
#pragma unroll
          for (int n = 0; n < 2; ++n) acc[a][b][m][n] = (f32x4){0.f, 0.f, 0.f, 0.f};
    cur = nxt; cA = nA; cB = nB; ++ui;
    if (wr == 1) PG8_BAR;
  }
  PG8_WAIT_V(0);
  PG8_BAR;
#undef PG8_SA
#undef PG8_SB
#undef PG8_STAGE
#undef PG8_LDA
#undef PG8_LDB
#undef PG8_MMA
#undef PG8_WAIT_V
#undef PG8_WAIT_L
#undef PG8_BAR
#undef PG8_SCHED
}
}

enum EpiKind { K_EVIN = 0, K_UQ = 1, K_UKV = 2, K_ODIN = 3, K_RELU2 = 4, K_RESID = 5 };
struct EpiB {
  int kind;
  unsigned char* ws;
  const float* base; float* outf;
  __device__ __forceinline__ void store8(unsigned char* b, unsigned off, f32x4 v0, f32x4 v1) const {
    u32x4 w; w.x = cvt_pk_bf16(v0[0], v0[1]); w.y = cvt_pk_bf16(v0[2], v0[3]); w.z = cvt_pk_bf16(v1[0], v1[1]); w.w = cvt_pk_bf16(v1[2], v1[3]);
    *(u32x4*)(b + off) = w;
  }
  __device__ __forceinline__ void rope8(f32x4& v0, f32x4& v1, const float* ct, const float* st, unsigned toff) const {
    const f32x4 c = *(const f32x4*)((const char*)ct + toff), s = *(const f32x4*)((const char*)st + toff);
    f32x4 a0, a1;
    a0[0] = v0[0] * c[0] - v0[1] * s[0]; a0[1] = v0[1] * c[0] + v0[0] * s[0];
    a0[2] = v0[2] * c[1] - v0[3] * s[1]; a0[3] = v0[3] * c[1] + v0[2] * s[1];
    a1[0] = v1[0] * c[2] - v1[1] * s[2]; a1[1] = v1[1] * c[2] + v1[0] * s[2];
    a1[2] = v1[2] * c[3] - v1[3] * s[3]; a1[3] = v1[3] * c[3] + v1[2] * s[3];
    v0 = a0; v1 = a1;
  }
  __device__ __forceinline__ void vt8(unsigned char* vt, unsigned off, f32x4 v0, f32x4 v1) const {
    *(bf16_t*)(vt + off + 0 * SEQ * 2) = f2bf(v0[0]); *(bf16_t*)(vt + off + 1 * SEQ * 2) = f2bf(v0[1]); *(bf16_t*)(vt + off + 2 * SEQ * 2) = f2bf(v0[2]); *(bf16_t*)(vt + off + 3 * SEQ * 2) = f2bf(v0[3]);
    *(bf16_t*)(vt + off + 4 * SEQ * 2) = f2bf(v1[0]); *(bf16_t*)(vt + off + 5 * SEQ * 2) = f2bf(v1[1]); *(bf16_t*)(vt + off + 6 * SEQ * 2) = f2bf(v1[2]); *(bf16_t*)(vt + off + 7 * SEQ * 2) = f2bf(v1[3]);
  }
  __device__ __forceinline__ void operator()(const f32x4 (&acc)[2][2][4][2], const pg8::Unit& u, int wr, int wc, int fr, int fq) const {
    const int pn = u.pn;
    unsigned char* const big = ws + WS_BIG;
    const float* const cos64 = (const float*)(ws + WS_COS64); const float* const sin64 = (const float*)(ws + WS_SIN64);
    const float* const cos32 = (const float*)(ws + WS_COS32); const float* const sin32 = (const float*)(ws + WS_SIN32);
#pragma unroll
    for (int ai = 0; ai < 2; ++ai)
#pragma unroll
      for (int m = 0; m < 4; ++m) {
        asm volatile("" ::: "memory");
        const unsigned row = u.pm * 256 + ai * 128 + wr * 64 + m * 16 + fr;
        const unsigned b = row >> 13, pos = row & (SEQ - 1);
#pragma unroll
        for (int bj = 0; bj < 2; ++bj) {
          const unsigned col = pn * 256 + bj * 128 + wc * 32 + 8 * fq;
          f32x4 v0 = acc[ai][bj][m][0], v1 = acc[ai][bj][m][1];
          if (kind == K_RESID) {
            const unsigned o = (row * DM + col) * 4u;
            *(f32x4*)((char*)outf + o) = *(const f32x4*)((const char*)base + o) + v0; *(f32x4*)((char*)outf + o + 16) = *(const f32x4*)((const char*)base + o + 16) + v1;
          } else if (kind == K_RELU2) {
#pragma unroll
            for (int e = 0; e < 4; ++e) { float a = fmaxf(v0[e], 0.f), c = fmaxf(v1[e], 0.f); v0[e] = a * a; v1[e] = c * c; }
            store8(big, (row * FF + col) * 2u, v0, v1);
          } else if (kind == K_EVIN) {
            if (pn < 4) { const float sc = pn < 2 ? C_NA : 1.f; store8(big + B_QKNA, (row * 1024 + col) * 2u, v0 * sc, v1 * sc); }
            else if (pn < 6) { vt8(big + B_VTNA, ((b * 512 + (col - 1024)) * SEQ + vtidx(pos)) * 2u, v0, v1); }
            else if (pn == 6) { store8(big + B_CRAW, (row * 384 + (col - 1536)) * 2u, v0, v1); }
            else {
              if (bj == 0) store8(big + B_CRAW, (row * 384 + 256 + (col - 1792)) * 2u, v0, v1);
              else if (wc == 0) { rope8(v0, v1, cos32, sin32, (pos * 16 + 4 * fq) * 4u); store8(big + B_KPE, (row * 32 + 8 * fq) * 2u, v0, v1); }
            }
          } else if (kind == K_UQ) {
            if (pn == 2) rope8(v0, v1, cos32, sin32, (pos * 16 + ((col & 31) >> 1)) * 4u);
            store8(big + B_QMLA, (row * 768 + col) * 2u, v0 * C_MLA, v1 * C_MLA);
          } else if (kind == K_UKV) {
            if (pn < 2) store8(big + B_KN, (row * 512 + col) * 2u, v0, v1);
            else vt8(big + B_VTMLA, ((b * 512 + (col - 512)) * SEQ + vtidx(pos)) * 2u, v0, v1);
          } else {
            const int s = pn >> 1;
            if (s < 6) {
              rope8(v0, v1, cos64, sin64, (pos * 32 + ((col & 63) >> 1)) * 4u);
              const float sc = (s & 1) ? 1.f : C_NA;
              store8(big + B_QK, (row * 3072 + col) * 2u, v0 * sc, v1 * sc);
            } else {
              const int gq = s - 6, sh = 2 * gq;
              const unsigned lidx = ((pos & ((1u << sh) - 1)) << (13 - sh)) | (pos >> sh);
              vt8(big + B_VT, (((b * 3 + gq) * 512 + (col - s * 512)) * SEQ + vtidx(lidx)) * 2u, v0, v1);
            }
          }
        }
      }
  }
};

enum ColMap { CM_ID = 0, CM_EVIN = 1, CM_UQ = 2, CM_UKV = 3, CM_ODIN = 4 };
__device__ __forceinline__ int colmap(int kind, int n) {
  switch (kind) {
    case CM_EVIN: { if (n < 1920) return n; if (n >= 1952) return -1; const int j = n - 1920, k = j >> 1; return 1920 + ((j & 1) ? k + 16 : k); }
    case CM_UQ: { if (n < 512) return (n >> 6) * 96 + (n & 63); const int h = (n - 512) >> 5, j = (n - 512) & 31, k = j >> 1; return h * 96 + 64 + ((j & 1) ? k + 16 : k); }
    case CM_UKV: { if (n < 512) return (n >> 6) * 128 + (n & 63); const int n2 = n - 512; return (n2 >> 6) * 128 + 64 + (n2 & 63); }
    case CM_ODIN: { const int ch = n / OD_NC, n1 = n - ch * OD_NC, s = n1 >> 9, hl = (n1 & 511) >> 6, j = n1 & 63;
      int gq, t, js; if (s < 6) { gq = s >> 1; t = s & 1; const int k = j >> 1; js = (j & 1) ? k + 32 : k; } else { gq = s - 6; t = 2; js = j; }
      return ((gq * 3 + t) * 16 + (8 * ch + hl)) * 64 + js; }
    default: return n;
  }
}
__device__ __forceinline__ void transpose_item(const float* W, int K, int Nsrc, int Nout, bf16_t* WT, int cm, LAS float* scr, int item, int lane) {
  const int nblk = Nout / 32, kb = item / nblk, nb = item % nblk, k0 = 64 * kb, n0 = 32 * nb;
  const int sc = colmap(cm, n0 + (lane & 31));
#pragma unroll 8
  for (int i = 0; i < 32; ++i) { const int kk = 2 * i + (lane >> 5); scr[kk * 33 + (lane & 31)] = sc >= 0 ? W[(size_t)(k0 + kk) * Nsrc + sc] : 0.f; }
  asm volatile("s_waitcnt lgkmcnt(0)" ::: "memory");
  const int c = lane & 7;
#pragma unroll
  for (int j = 0; j < 4; ++j) { const int n = (lane >> 3) + 8 * j; const LAS float* s = scr + (8 * c) * 33 + n;
    u32x4 o; o.x = cvt_pk_bf16(s[0 * 33], s[1 * 33]); o.y = cvt_pk_bf16(s[2 * 33], s[3 * 33]); o.z = cvt_pk_bf16(s[4 * 33], s[5 * 33]); o.w = cvt_pk_bf16(s[6 * 33], s[7 * 33]);
    *(u32x4*)(WT + (size_t)(n0 + n) * K + k0 + 8 * c) = o; }
  asm volatile("s_waitcnt lgkmcnt(0)" ::: "memory");
}
__device__ __forceinline__ void rms_row_bf16(const float* xrow, const float* g, bf16_t* orow, int lane) {
  const f32x4* xr = (const f32x4*)xrow + lane; const f32x4* gr = (const f32x4*)g + lane;
  f32x4 v[4]; float s = 0.f;
#pragma unroll
  for (int j = 0; j < 4; ++j) { v[j] = xr[64 * j]; s += (v[j].x * v[j].x + v[j].y * v[j].y) + (v[j].z * v[j].z + v[j].w * v[j].w); }
  const float rstd = 1.f / sqrtf(wave_sum(s) * (1.f / DM) + RMS_EPS);
  u32x2* o8 = (u32x2*)orow + lane;
#pragma unroll
  for (int j = 0; j < 4; ++j) { const f32x4 gg = gr[64 * j]; u32x2 w; w.x = cvt_pk_bf16(v[j].x * rstd * gg.x, v[j].y * rstd * gg.y); w.y = cvt_pk_bf16(v[j].z * rstd * gg.z, v[j].w * rstd * gg.w); o8[64 * j] = w; }
}
__device__ __forceinline__ void rms_row_f32(const float* xrow, const float* g, float* orow, int lane) {
  const f32x4* xr = (const f32x4*)xrow + lane; const f32x4* gr = (const f32x4*)g + lane;
  f32x4 v[4]; float s = 0.f;
#pragma unroll
  for (int j = 0; j < 4; ++j) { v[j] = xr[64 * j]; s += (v[j].x * v[j].x + v[j].y * v[j].y) + (v[j].z * v[j].z + v[j].w * v[j].w); }
  const float rstd = 1.f / sqrtf(wave_sum(s) * (1.f / DM) + RMS_EPS);
  f32x4* o = (f32x4*)orow + lane;
#pragma unroll
  for (int j = 0; j < 4; ++j) { const f32x4 gg = gr[64 * j]; o[64 * j] = v[j] * rstd * gg; }
}
__device__ __forceinline__ void sincos_acc(float angf, float& sn, float& cs) {
  const double x = (double)angf;
  const double n = __builtin_rint(x * 0.63661977236758134308);
  double r = __builtin_fma(-n, 1.57079632679489655800e+00, x); r = __builtin_fma(-n, 6.12323399573676603587e-17, r);
  const double r2 = r * r;
  double sp = 1.0 / 6227020800.0; sp = sp * r2 - 1.0 / 39916800.0; sp = sp * r2 + 1.0 / 362880.0; sp = sp * r2 - 1.0 / 5040.0; sp = sp * r2 + 1.0 / 120.0; sp = sp * r2 - 1.0 / 6.0; sp = sp * r2 + 1.0; sp *= r;
  double cp = -1.0 / 87178291200.0; cp = cp * r2 + 1.0 / 479001600.0; cp = cp * r2 - 1.0 / 3628800.0; cp = cp * r2 + 1.0 / 40320.0; cp = cp * r2 - 1.0 / 720.0; cp = cp * r2 + 1.0 / 24.0; cp = cp * r2 - 0.5; cp = cp * r2 + 1.0;
  const int q = ((int)(long long)n) & 3;
  const double s_ = (q & 1) ? cp : sp, c_ = (q & 1) ? sp : cp;
  sn = (float)((q & 2) ? -s_ : s_);
  cs = (float)(((q + 1) & 2) ? -c_ : c_);
}

__device__ __forceinline__ int crow(int r, int hi) { return (r & 3) + 8 * (r >> 2) + 4 * hi; }
__device__ __forceinline__ float half_max(float m) { auto rr = __builtin_amdgcn_permlane32_swap(__float_as_uint(m), __float_as_uint(m), false, false); return fmaxf(__uint_as_float(rr[0]), __uint_as_float(rr[1])); }
__device__ __forceinline__ float half_sum(float m) { auto rr = __builtin_amdgcn_permlane32_swap(__float_as_uint(m), __float_as_uint(m), false, false); return __uint_as_float(rr[0]) + __uint_as_float(rr[1]); }
__device__ __forceinline__ bf16x8 ldg8(const unsigned char* base, unsigned off) { return *(const bf16x8*)(base + off); }
__device__ __forceinline__ void softmax_pv(f32x16& s, const bf16x8 (&vf)[4], f32x16& o0, f32x16& o1, float& mrun, float& lrun) {
  float mx = fmaxf(s[0], s[1]);
#pragma unroll
  for (int r = 2; r < 16; ++r) mx = fmaxf(mx, s[r]);
  mx = half_max(mx);
  const float mnew = fmaxf(mrun, mx), alpha = __builtin_amdgcn_exp2f(mrun - mnew); mrun = mnew;
  float ls = 0.f;
#pragma unroll
  for (int r = 0; r < 16; ++r) { s[r] = __builtin_amdgcn_exp2f(s[r] - mnew); ls += s[r]; }
  lrun = lrun * alpha + ls;
  if (__builtin_amdgcn_ballot_w64(alpha != 1.f) != 0ull) {
#pragma unroll
    for (int r = 0; r < 16; ++r) { o0[r] *= alpha; o1[r] *= alpha; }
  }
  u32x4 w0, w1;
  w0.x = cvt_pk_bf16(s[0], s[1]); w0.y = cvt_pk_bf16(s[2], s[3]); w0.z = cvt_pk_bf16(s[4], s[5]); w0.w = cvt_pk_bf16(s[6], s[7]);
  w1.x = cvt_pk_bf16(s[8], s[9]); w1.y = cvt_pk_bf16(s[10], s[11]); w1.z = cvt_pk_bf16(s[12], s[13]); w1.w = cvt_pk_bf16(s[14], s[15]);
  const bf16x8 p0 = __builtin_bit_cast(bf16x8, w0), p1 = __builtin_bit_cast(bf16x8, w1);
  o0 = __builtin_amdgcn_mfma_f32_32x32x16_bf16(vf[0], p0, o0, 0, 0, 0); o0 = __builtin_amdgcn_mfma_f32_32x32x16_bf16(vf[1], p1, o0, 0, 0, 0);
  o1 = __builtin_amdgcn_mfma_f32_32x32x16_bf16(vf[2], p0, o1, 0, 0, 0); o1 = __builtin_amdgcn_mfma_f32_32x32x16_bf16(vf[3], p1, o1, 0, 0, 0);
}
__device__ __forceinline__ void store_ot(unsigned char* base, unsigned rowoff, const f32x16& o0, const f32x16& o1, float il, int hi) {
#pragma unroll
  for (int a = 0; a < 4; ++a) {
    u32x2 w; w.x = cvt_pk_bf16(o0[4 * a] * il, o0[4 * a + 1] * il); w.y = cvt_pk_bf16(o0[4 * a + 2] * il, o0[4 * a + 3] * il);
    *(u32x2*)(base + rowoff + (8 * a + 4 * hi) * 2) = w;
    u32x2 v; v.x = cvt_pk_bf16(o1[4 * a] * il, o1[4 * a + 1] * il); v.y = cvt_pk_bf16(o1[4 * a + 2] * il, o1[4 * a + 3] * il);
    *(u32x2*)(base + rowoff + (32 + 8 * a + 4 * hi) * 2) = v;
  }
}

constexpr int MLA_STEP_BYTES = 40960, MLA_NSTEP = SEQ / 128;
__device__ __forceinline__ void mla_attn_phase(unsigned char* big, unsigned char* att, LAS unsigned char* lds, int bx, int G, int wave, int lane) {
  const int r32 = lane & 31, hi = lane >> 5;
  for (int u = bx; u < 512; u += G) {
    const int bh = u >> 5, qb = u & 31, b = bh >> 3, h = bh & 7;
    const unsigned m0 = b * SEQ + qb * 256 + wave * 32 + r32;
    bf16x8 qf[6];
#pragma unroll
    for (int c = 0; c < 4; ++c) qf[c] = ldg8(big + B_QMLA, (m0 * 768 + h * 64 + 16 * c + 8 * hi) * 2u);
#pragma unroll
    for (int c = 0; c < 2; ++c) qf[4 + c] = ldg8(big + B_QMLA, (m0 * 768 + 512 + h * 32 + 16 * c + 8 * hi) * 2u);
    const unsigned char* kn = big + B_KN + ((size_t)b * SEQ * 512 + h * 64) * 2;
    const unsigned char* kp = big + B_KPE + ((size_t)b * SEQ * 32) * 2;
    const unsigned char* vt = big + B_VTMLA + ((size_t)(b * 8 + h) * 64 * SEQ) * 2;
    const unsigned char* sbase[5]; unsigned sstride[5], loff[5];
#pragma unroll
    for (int i = 0; i < 5; ++i) {
      const int sl = wave * 5 + i, tt = sl / 10, f = sl % 10;
      if (f < 4) { sbase[i] = kn + (size_t)tt * (32 * 512 * 2); loff[i] = (r32 * 512 + 16 * f + 8 * hi) * 2u; sstride[i] = 128 * 512 * 2; }
      else if (f < 6) { sbase[i] = kp + (size_t)tt * (32 * 32 * 2); loff[i] = (r32 * 32 + 16 * (f - 4) + 8 * hi) * 2u; sstride[i] = 128 * 32 * 2; }
      else { const int d0 = (f - 6) >> 1, j = (f - 6) & 1; sbase[i] = vt + (size_t)tt * 64; loff[i] = ((d0 * 32 + r32) * SEQ + 16 * j + 8 * hi) * 2u; sstride[i] = 256; }
    }
#define MLA_ISSUE(st, rs) do { _Pragma("unroll") for (int i = 0; i < 5; ++i) \
      __builtin_amdgcn_global_load_lds((const unsigned*)(sbase[i] + (size_t)(st) * sstride[i] + loff[i]), (LAS unsigned*)(lds + (rs) * MLA_STEP_BYTES + (wave * 5 + i) * 1024), 16, 0, 0); } while (0)
#define MLA_FRAGS(KF, VF, base) do { \
      _Pragma("unroll") for (int c = 0; c < 6; ++c) KF[c] = *(const LAS bf16x8*)(lds + (base) + c * 1024 + lane * 16); \
      _Pragma("unroll") for (int c = 0; c < 4; ++c) VF[c] = *(const LAS bf16x8*)(lds + (base) + (6 + c) * 1024 + lane * 16); } while (0)
#define MLA_TILE(KF, VF) do { f32x16 s = {0.f, 0.f, 0.f, 0.f, 0.f, 0.f, 0.f, 0.f, 0.f, 0.f, 0.f, 0.f, 0.f, 0.f, 0.f, 0.f}; \
      _Pragma("unroll") for (int c = 0; c < 6; ++c) s = __builtin_amdgcn_mfma_f32_32x32x16_bf16(KF[c], qf[c], s, 0, 0, 0); \
      softmax_pv(s, VF, o0, o1, mrun, lrun); } while (0)
    f32x16 o0 = {0.f, 0.f, 0.f, 0.f, 0.f, 0.f, 0.f, 0.f, 0.f, 0.f, 0.f, 0.f, 0.f, 0.f, 0.f, 0.f}, o1 = o0;
    float mrun = NEG_BIG, lrun = 0.f;
    MLA_ISSUE(0, 0); MLA_ISSUE(1, 1);
    int rs = 0;
    for (int st = 0; st < MLA_NSTEP; ++st) {
      if (st + 1 < MLA_NSTEP) asm volatile("s_waitcnt vmcnt(5)" ::: "memory"); else asm volatile("s_waitcnt vmcnt(0)" ::: "memory");
      __builtin_amdgcn_s_barrier();
      asm volatile("" ::: "memory");
      if (st + 2 < MLA_NSTEP) { const int rn = (rs >= 1) ? rs - 1 : 2; MLA_ISSUE(st + 2, rn); }
      const int sb = rs * MLA_STEP_BYTES;
      bf16x8 kfa[6], vfa[4], kfb[6], vfb[4];
      MLA_FRAGS(kfa, vfa, sb);
      MLA_FRAGS(kfb, vfb, sb + 10240);
      MLA_TILE(kfa, vfa);
      MLA_FRAGS(kfa, vfa, sb + 20480);
      MLA_TILE(kfb, vfb);
      MLA_FRAGS(kfb, vfb, sb + 30720);
      MLA_TILE(kfa, vfa);
      MLA_TILE(kfb, vfb);
      asm volatile("s_waitcnt lgkmcnt(0)" ::: "memory");
      rs = (rs == 2) ? 0 : rs + 1;
    }
#undef MLA_ISSUE
#undef MLA_FRAGS
#undef MLA_TILE
    const float il = 1.f / half_sum(lrun);
    store_ot(att, (m0 * 1024 + 512 + h * 64) * 2u, o0, o1, il, hi);
    __builtin_amdgcn_s_barrier();
  }
}

__device__ __forceinline__ void na_attn_phase(unsigned char* big, unsigned char* att, const float* rpb, int gw, int NGW, int lane) {
  const int r32 = lane & 31, hi = lane >> 5;
  for (int wt = gw; wt < 4096; wt += NGW) {
    const int w = wt & 1, h = (wt >> 1) & 7, r = (wt >> 4) & 127, b = wt >> 11;
    const int rs = min(max(r - 4, 0), 120), c = 32 * w + r32, cs = min(max(c - 8, 0), 48);
    const unsigned m0 = b * SEQ + r * 64 + c;
    bf16x8 qf[4];
#pragma unroll
    for (int cc = 0; cc < 4; ++cc) qf[cc] = ldg8(big + B_QKNA, (m0 * 1024 + h * 64 + 16 * cc + 8 * hi) * 2u);
    const unsigned char* kb = big + B_QKNA + ((size_t)(b * SEQ + rs * 64) * 1024 + 512 + h * 64) * 2;
    const unsigned char* vt = big + B_VTNA + ((size_t)(b * 8 + h) * 64 * SEQ + rs * 64) * 2;
    const unsigned ko = (r32 * 1024 + 8 * hi) * 2u, vto = (r32 * SEQ + 8 * hi) * 2u;
    const float* bias_h = rpb + h * 15 * 31;
    f32x16 o0 = {0.f, 0.f, 0.f, 0.f, 0.f, 0.f, 0.f, 0.f, 0.f, 0.f, 0.f, 0.f, 0.f, 0.f, 0.f, 0.f}, o1 = o0;
    float mrun = NEG_BIG, lrun = 0.f;
    for (int t = 0; t < 16; ++t) {
      bf16x8 kf[4], vf[4];
#pragma unroll
      for (int cc = 0; cc < 4; ++cc) kf[cc] = ldg8(kb + (size_t)t * (32 * 1024 * 2), ko + 32 * cc);
#pragma unroll
      for (int d0 = 0; d0 < 2; ++d0)
#pragma unroll
        for (int j = 0; j < 2; ++j) vf[2 * d0 + j] = ldg8(vt + (size_t)t * 64, vto + d0 * (32 * SEQ * 2) + j * 32);
      f32x16 s = {0.f, 0.f, 0.f, 0.f, 0.f, 0.f, 0.f, 0.f, 0.f, 0.f, 0.f, 0.f, 0.f, 0.f, 0.f, 0.f};
#pragma unroll
      for (int cc = 0; cc < 4; ++cc) s = __builtin_amdgcn_mfma_f32_32x32x16_bf16(kf[cc], qf[cc], s, 0, 0, 0);
      const int kr = rs + (t >> 1);
      const float* brow = bias_h + (kr - r + 7) * 31;
#pragma unroll
      for (int rr = 0; rr < 16; ++rr) {
        const int kc = 32 * (t & 1) + crow(rr, hi), rel = kc - c + 15;
        const bool ok = (kc >= cs) && (kc < cs + 16);
        const float bv = brow[min(max(rel, 0), 30)];
        s[rr] = ok ? s[rr] + bv * LOG2E : NEG_BIG;
      }
      softmax_pv(s, vf, o0, o1, mrun, lrun);
    }
    const float il = 1.f / half_sum(lrun);
    store_ot(att, (m0 * 1024 + h * 64) * 2u, o0, o1, il, hi);
  }
}

__device__ __forceinline__ void dil_attn_phase(unsigned char* big, unsigned char* att, int ch, int bx, int G, int wave, int lane, int tid) {
  const int r32 = lane & 31, hi = lane >> 5;
  float* lse = (float*)(big + B_LSE);
  for (int u = bx; u < 256; u += G) {
    const int b = u >> 7, hl = (u >> 4) & 7, P0 = (u & 15) * 512;
    for (int wt = wave; wt < 48; wt += 8) {
      const int gq = wt >> 4, j = wt & 15, sh = 2 * gq;
      const int rho = (gq == 0) ? 0 : (gq == 1) ? (j >> 2) : j, it = (gq == 0) ? j : (gq == 1) ? (j & 3) : 0;
      const int i0 = (P0 >> sh) + 32 * it, nseq = SEQ >> sh;
      const unsigned mq = b * SEQ + ((i0 + r32) << sh) + rho;
      bf16x8 qf[4];
#pragma unroll
      for (int cc = 0; cc < 4; ++cc) qf[cc] = ldg8(big + B_QK, (mq * 3072 + gq * 1024 + hl * 64 + 16 * cc + 8 * hi) * 2u);
      const unsigned char* vt = big + B_VT + ((size_t)((b * 3 + gq) * 8 + hl) * 64 * SEQ + rho * nseq) * 2;
      const unsigned vto = (r32 * SEQ + 8 * hi) * 2u;
      f32x16 o0 = {0.f, 0.f, 0.f, 0.f, 0.f, 0.f, 0.f, 0.f, 0.f, 0.f, 0.f, 0.f, 0.f, 0.f, 0.f, 0.f}, o1 = o0;
      float mrun = NEG_BIG, lrun = 0.f;
      for (int t = 0; t < 5; ++t) {
        const int k0 = i0 - 64 + 32 * t;
        if (k0 < 0 || k0 >= nseq) continue;
        const unsigned mk = b * SEQ + ((k0 + r32) << sh) + rho;
        bf16x8 kf[4], vf[4];
#pragma unroll
        for (int cc = 0; cc < 4; ++cc) kf[cc] = ldg8(big + B_QK, (mk * 3072 + gq * 1024 + 512 + hl * 64 + 16 * cc + 8 * hi) * 2u);
#pragma unroll
        for (int d0 = 0; d0 < 2; ++d0)
#pragma unroll
          for (int jj = 0; jj < 2; ++jj) vf[2 * d0 + jj] = ldg8(vt + (size_t)k0 * 2, vto + d0 * (32 * SEQ * 2) + jj * 32);
        f32x16 s = {0.f, 0.f, 0.f, 0.f, 0.f, 0.f, 0.f, 0.f, 0.f, 0.f, 0.f, 0.f, 0.f, 0.f, 0.f, 0.f};
#pragma unroll
        for (int cc = 0; cc < 4; ++cc) s = __builtin_amdgcn_mfma_f32_32x32x16_bf16(kf[cc], qf[cc], s, 0, 0, 0);
        if (t == 0) {
#pragma unroll
          for (int rr = 0; rr < 16; ++rr) s[rr] = (crow(rr, hi) >= r32) ? s[rr] : NEG_BIG;
        } else if (t == 4) {
#pragma unroll
          for (int rr = 0; rr < 16; ++rr) s[rr] = (crow(rr, hi) <= r32) ? s[rr] : NEG_BIG;
        }
        softmax_pv(s, vf, o0, o1, mrun, lrun);
      }
      const float lt = half_sum(lrun), il = 1.f / lt;
      store_ot(big + B_QK, (mq * 3072 + gq * 1024 + hl * 64) * 2u, o0, o1, il, hi);
      if (hi == 0) lse[(mq * 8 + hl) * 3 + gq] = mrun + __builtin_amdgcn_logf(lt);
    }
    __threadfence(); __syncthreads();
    {
      const unsigned m = b * SEQ + P0 + tid;
      const float l0 = lse[(m * 8 + hl) * 3 + 0], l1 = lse[(m * 8 + hl) * 3 + 1], l2 = lse[(m * 8 + hl) * 3 + 2];
      const float lm = fmaxf(l0, fmaxf(l1, l2));
      float w0 = __builtin_amdgcn_exp2f(l0 - lm), w1 = __builtin_amdgcn_exp2f(l1 - lm), w2 = __builtin_amdgcn_exp2f(l2 - lm);
      const float iw = 1.f / (w0 + w1 + w2); w0 *= iw; w1 *= iw; w2 *= iw;
#pragma unroll
      for (int jj = 0; jj < 8; ++jj) {
        float a0[8], a1[8], a2[8];
        unpack8(*(const u32x4*)(big + B_QK + ((size_t)m * 3072 + 0 * 1024 + hl * 64 + 8 * jj) * 2), a0);
        unpack8(*(const u32x4*)(big + B_QK + ((size_t)m * 3072 + 1 * 1024 + hl * 64 + 8 * jj) * 2), a1);
        unpack8(*(const u32x4*)(big + B_QK + ((size_t)m * 3072 + 2 * 1024 + hl * 64 + 8 * jj) * 2), a2);
        float f[8];
#pragma unroll
        for (int e = 0; e < 8; ++e) f[e] = w0 * a0[e] + w1 * a1[e] + w2 * a2[e];
        u32x4 wv; wv.x = cvt_pk_bf16(f[0], f[1]); wv.y = cvt_pk_bf16(f[2], f[3]); wv.z = cvt_pk_bf16(f[4], f[5]); wv.w = cvt_pk_bf16(f[6], f[7]);
        *(u32x4*)(att + ((size_t)m * 1024 + (8 * ch + hl) * 64 + 8 * jj) * 2) = wv;
      }
    }
    __syncthreads();
  }
}

#define XB_TMO      128
#define XB_XCNT(j)  (256  + 64 * (j))
#define XB_XSUB(j)  (1280 + 64 * (j))
#define XB_XGEN(j)  (2304 + 64 * (j))
#define XB_TOP      3328
#define XB_TOPGEN   3392
#define XCD_BAR_WORDS 3456
#define XB_SPIN_CAP (1u << 18)
__device__ __forceinline__ unsigned xb_ld(unsigned* p)              { return __hip_atomic_load(p, __ATOMIC_RELAXED, __HIP_MEMORY_SCOPE_AGENT); }
__device__ __forceinline__ unsigned xb_add(unsigned* p, unsigned v) { return __hip_atomic_fetch_add(p, v, __ATOMIC_RELAXED, __HIP_MEMORY_SCOPE_AGENT); }
__device__ __forceinline__ unsigned xb_xcc_id() { return (unsigned)__builtin_amdgcn_s_getreg((3 << 11) | 20) & 0xFu; }
#define XB_SPIN(cond, bar) do { unsigned _sp = 0; while (cond) { __builtin_amdgcn_s_sleep(1); \
    if ((++_sp & 255u) == 0u) { if (xb_ld(&(bar)[XB_TMO])) break; if (_sp > XB_SPIN_CAP) { atomicAdd(&(bar)[XB_TMO], 1u); break; } } } } while (0)
struct XcdBarrier { unsigned* bar; unsigned x; volatile LAS unsigned* st; };
__device__ __forceinline__ XcdBarrier xcd_barrier_post(unsigned* bar, volatile LAS unsigned* st) {
  XcdBarrier b; b.bar = bar; b.x = xb_xcc_id(); b.st = st;
  if (threadIdx.x == 0) (void)xb_add(&bar[XB_XCNT(b.x)], 1u);
  return b;
}
__device__ __forceinline__ void xcd_barrier_complete(unsigned* bar, unsigned x, unsigned& nloc, unsigned& nx) {
  const unsigned G = gridDim.x * gridDim.y * gridDim.z;
  unsigned sum, cnt, mine, sp = 0u;
  for (;;) {
    sum = 0u; cnt = 0u; mine = 0u;
#pragma unroll
    for (unsigned j = 0; j < 16; ++j) { const unsigned c = xb_ld(&bar[XB_XCNT(j)]); sum += c; cnt += (c > 0u) ? 1u : 0u; mine = (j == x) ? c : mine; }
    if (sum == G) break;
    __builtin_amdgcn_s_sleep(1);
    if ((++sp & 255u) == 0u) { if (xb_ld(&bar[XB_TMO])) break; if (sp > XB_SPIN_CAP) { atomicAdd(&bar[XB_TMO], 1u); break; } }
  }
  nloc = mine > 0u ? mine : 1u; nx = cnt > 0u ? cnt : 1u;
}
__device__ __forceinline__ void xcd_barrier(const XcdBarrier& b) {
  asm volatile("s_waitcnt vmcnt(0)" ::: "memory");
  __syncthreads();
  if (threadIdx.x == 0) {
    unsigned* bar = b.bar;
    __builtin_amdgcn_s_waitcnt(0);
    unsigned nloc = b.st[0], nx = b.st[1];
    if (nloc == 0u) { xcd_barrier_complete(bar, b.x, nloc, nx); b.st[0] = nloc; b.st[1] = nx; }
    const unsigned old = xb_add(&bar[XB_XSUB(b.x)], 1u);
    const unsigned gen = old / nloc;
    if (old + 1u == (gen + 1u) * nloc) {
      __builtin_amdgcn_fence(__ATOMIC_RELEASE, "agent");
      asm volatile("s_waitcnt vmcnt(0)" ::: "memory");
      const unsigned og = xb_add(&bar[XB_TOP], 1u);
      const unsigned tg = og / nx;
      if (og + 1u == (tg + 1u) * nx) xb_add(&bar[XB_TOPGEN], 1u);
      else XB_SPIN(xb_ld(&bar[XB_TOPGEN]) == tg, bar);
      __builtin_amdgcn_fence(__ATOMIC_ACQUIRE, "agent");
      xb_add(&bar[XB_XGEN(b.x)], 1u);
      asm volatile("s_waitcnt vmcnt(0)" ::: "memory");
    } else {
      XB_SPIN(xb_ld(&bar[XB_XGEN(b.x)]) == gen, bar);
      __builtin_amdgcn_fence(__ATOMIC_ACQUIRE, "agent");
      asm volatile("s_waitcnt vmcnt(0)" ::: "memory");
    }
  }
  __syncthreads();
}

__device__ __forceinline__ const void* ldptr(LAS unsigned char* lds, int i) {
  const volatile LAS unsigned* p = (const volatile LAS unsigned*)(lds + 131072) + 2 * i;
  const unsigned lo = __builtin_amdgcn_readfirstlane(p[0]), hi = __builtin_amdgcn_readfirstlane(p[1]);
  return (const void*)(((unsigned long long)hi << 32) | lo);
}
struct Args { const float* in[15]; float* out; unsigned char* ws; int ph_lo, ph_hi; };

__global__ void __launch_bounds__(512, 2) fwd(Args a) {
  extern __shared__ __attribute__((aligned(16))) unsigned char lds_raw[];
  LAS unsigned char* lds = (LAS unsigned char*)lds_raw;
  cg::grid_group grid = cg::this_grid();
  const int G = gridDim.x, bx = blockIdx.x;
  const int gsz = G * 512, NGW = G * 8;
  if (threadIdx.x < 15) ((LAS unsigned long long*)(lds + 131072))[threadIdx.x] = (unsigned long long)a.in[threadIdx.x];
  if (threadIdx.x == 15) ((LAS unsigned long long*)(lds + 131072))[15] = (unsigned long long)a.out;
  if (threadIdx.x == 16) ((LAS unsigned long long*)(lds + 131072))[16] = (unsigned long long)a.ws;
  if (threadIdx.x == 17) { ((LAS unsigned*)(lds + 131072 + 256))[0] = 0u; ((LAS unsigned*)(lds + 131072 + 256))[1] = 0u; }
  if (bx == 0) for (int i = threadIdx.x; i < XCD_BAR_WORDS; i += 512) ((unsigned*)a.ws)[i] = 0u;
  __syncthreads();
  XcdBarrier xbar; xbar.bar = (unsigned*)a.ws; xbar.x = 0; xbar.st = (volatile LAS unsigned*)(lds + 131072 + 256);
#define INP(i) ((const float*)ldptr(lds, (i)))

  if (a.ph_lo == 0) {
    const int gtid0 = bx * 512 + threadIdx.x;
    float* cos64 = (float*)(a.ws + WS_COS64); float* sin64 = (float*)(a.ws + WS_SIN64); float* cos32 = (float*)(a.ws + WS_COS32); float* sin32 = (float*)(a.ws + WS_SIN32);
    for (int i = gtid0; i < SEQ * 32; i += gsz) { const int pos = i >> 5, kk = i & 31; float sn, cs; sincos_acc((float)pos * INV64[kk], sn, cs); cos64[i] = cs; sin64[i] = sn; }
    for (int i = gtid0; i < SEQ * 16; i += gsz) { const int pos = i >> 4, kk = i & 15; float sn, cs; sincos_acc((float)pos * INV64[2 * kk], sn, cs); cos32[i] = cs; sin32[i] = sn; }
  }
#ifdef ONE_LAUNCH
  for (int ph = a.ph_lo; ph < a.ph_hi; ++ph) {
#else
  { const int ph = a.ph_lo;
#endif
    int tid = threadIdx.x; asm volatile("" : "+v"(tid));
    const int lane = tid & 63, wave = __builtin_amdgcn_readfirstlane(tid >> 6), gtid = bx * 512 + tid, gw = bx * 8 + wave;
    unsigned char* ws = a.ws;
    float* X = a.out;
    unsigned char* big = ws + WS_BIG;
    bf16_t* XN = (bf16_t*)(ws + WS_XN); bf16_t* ATT = (bf16_t*)(ws + WS_ATT);
    const float* cos64 = (const float*)(ws + WS_COS64); const float* sin64 = (const float*)(ws + WS_SIN64);
    const float* cos32 = (const float*)(ws + WS_COS32); const float* sin32 = (const float*)(ws + WS_SIN32);
    if (ph == NPH - 1) {
      for (int m = gw; m < M; m += NGW) rms_row_f32(X + (size_t)m * DM, INP(3), X + (size_t)m * DM, lane);
    } else {
      const int L = ph / 9, k = ph % 9, e = L >> 1; const bool even = !(L & 1);
      const float* xsrc = (L == 0) ? INP(0) : X;
      if (k == 0) {
        LAS float* scr = (LAS float*)(lds + wave * 16384);
        const float* w1 = INP(13) + (size_t)L * DM * FF; const float* w2 = INP(14) + (size_t)L * FF * DM;
        const float* wo = even ? INP(10) + (size_t)e * DM * DM : INP(12) + (size_t)e * DM * DM;
        const int nin = even ? EV_N : 2 * OD_NC;
        const int I_IN = 16 * (nin / 32), I_O = 16 * 32, I_1 = 16 * 128, I_2 = 64 * 32, I_UQ = even ? 4 * 24 : 0, I_UKV = even ? 2 * 32 : 0;
        const int NIT = I_IN + I_O + I_1 + I_2 + I_UQ + I_UKV;
        for (int it = gw; it < NIT; it += NGW) {
          int r = it;
          if (r < I_IN) { if (even) transpose_item(INP(4) + (size_t)e * DM * 1952, DM, 1952, EV_N, (bf16_t*)(ws + WS_W + W_IN), CM_EVIN, scr, r, lane);
                          else transpose_item(INP(11) + (size_t)e * DM * 9216, DM, 9216, 2 * OD_NC, (bf16_t*)(ws + WS_W + W_IN), CM_ODIN, scr, r, lane); continue; } r -= I_IN;
          if (r < I_O) { transpose_item(wo, DM, DM, DM, (bf16_t*)(ws + WS_W + W_O), CM_ID, scr, r, lane); continue; } r -= I_O;
          if (r < I_1) { transpose_item(w1, DM, FF, FF, (bf16_t*)(ws + WS_W + W_1), CM_ID, scr, r, lane); continue; } r -= I_1;
          if (r < I_2) { transpose_item(w2, FF, DM, DM, (bf16_t*)(ws + WS_W + W_2), CM_ID, scr, r, lane); continue; } r -= I_2;
          if (r < I_UQ) { transpose_item(INP(7) + (size_t)e * 256 * 768, 256, 768, 768, (bf16_t*)(ws + WS_W + W_UQ), CM_UQ, scr, r, lane); continue; } r -= I_UQ;
          transpose_item(INP(9) + (size_t)e * 128 * 1024, 128, 1024, 1024, (bf16_t*)(ws + WS_W + W_UKV), CM_UKV, scr, r, lane);
        }
        for (int m = gw; m < M; m += NGW) rms_row_bf16(xsrc + (size_t)m * DM, INP(1) + L * DM, XN + (size_t)m * DM, lane);
      } else if (k == 6) {
        for (int m = gw; m < M; m += NGW) rms_row_bf16(X + (size_t)m * DM, INP(2) + L * DM, XN + (size_t)m * DM, lane);
      } else if (even && k == 2) {
        const bf16_t* CR = (const bf16_t*)(big + B_CRAW); bf16_t* CQN = (bf16_t*)(big + B_CQN); bf16_t* CKVN = (bf16_t*)(big + B_CKVN);
        const float* gq = INP(6) + e * 256; const float* gkv = INP(8) + e * 128;
        for (int m = gw; m < M; m += NGW) {
          const u32x2 w = *(const u32x2*)(CR + (size_t)m * 384 + 4 * lane);
          const float v0 = bflo(w.x), v1 = bfhi(w.x), v2 = bflo(w.y), v3 = bfhi(w.y);
          const float rq = 1.f / sqrtf(wave_sum(v0 * v0 + v1 * v1 + v2 * v2 + v3 * v3) * (1.f / 256.f) + RMS_EPS);
          const f32x4 g4 = *(const f32x4*)(gq + 4 * lane);
          u32x2 o; o.x = cvt_pk_bf16(v0 * rq * g4.x, v1 * rq * g4.y); o.y = cvt_pk_bf16(v2 * rq * g4.z, v3 * rq * g4.w);
          *(u32x2*)(CQN + (size_t)m * 256 + 4 * lane) = o;
          const unsigned w2 = *(const unsigned*)(CR + (size_t)m * 384 + 256 + 2 * lane);
          const float u0 = bflo(w2), u1 = bfhi(w2);
          const float rk = 1.f / sqrtf(wave_sum(u0 * u0 + u1 * u1) * (1.f / 128.f) + RMS_EPS);
          const f32x2 g2 = *(const f32x2*)(gkv + 2 * lane);
          *(unsigned*)(CKVN + (size_t)m * 128 + 2 * lane) = cvt_pk_bf16(u0 * rk * g2.x, u1 * rk * g2.y);
        }
      } else if (even && k == 4) {
        na_attn_phase(big, (unsigned char*)ATT, INP(5) + (size_t)e * 8 * 15 * 31, gw, NGW, lane);
        mla_attn_phase(big, (unsigned char*)ATT, lds, bx, G, wave, lane);
      } else if (!even && (k == 2 || k == 4)) {
        dil_attn_phase(big, (unsigned char*)ATT, (k == 2) ? 0 : 1, bx, G, wave, lane, tid);
      } else {
        const int nsub = (even && k == 3) ? 2 : 1;
        for (int sub = 0; sub < nsub; ++sub) {
          pg8::Gemm g; pg8::StaticOrder S; EpiB E; E.ws = ws;
          g.M = M;
          E.base = (k == 5) ? xsrc : X; E.outf = X;
          if (k == 5) { g.A = ATT; g.Bt = (const bf16_t*)(ws + WS_W + W_O); g.N = DM; g.K = DM; E.kind = K_RESID; }
          else if (k == 8) { g.A = (const bf16_t*)big; g.Bt = (const bf16_t*)(ws + WS_W + W_2); g.N = DM; g.K = FF; E.kind = K_RESID; }
          else if (k == 7) { g.A = XN; g.Bt = (const bf16_t*)(ws + WS_W + W_1); g.N = FF; g.K = DM; E.kind = K_RELU2; }
          else if (even && k == 1) { g.A = XN; g.Bt = (const bf16_t*)(ws + WS_W + W_IN); g.N = EV_N; g.K = DM; E.kind = K_EVIN; }
          else if (even) {
            if (sub == 0) { g.A = (const bf16_t*)(big + B_CQN); g.Bt = (const bf16_t*)(ws + WS_W + W_UQ); g.N = 768; g.K = 256; E.kind = K_UQ; }
            else { g.A = (const bf16_t*)(big + B_CKVN); g.Bt = (const bf16_t*)(ws + WS_W + W_UKV); g.N = 1024; g.K = 128; E.kind = K_UKV; }
          } else { const int ch = (k == 1) ? 0 : 1; g.A = XN; g.Bt = (const bf16_t*)(ws + WS_W + W_IN) + (size_t)ch * OD_NC * DM; g.N = OD_NC; g.K = DM; E.kind = K_ODIN; }
          S.init(M, g.N, G, bx);
          pg8::gemm_phase<EpiB>(lds, g, S, E);
        }
      }
    }
#ifdef ONE_LAUNCH
    if (ph + 1 < a.ph_hi) {
      if (ph == a.ph_lo) { grid.sync(); xbar = xcd_barrier_post((unsigned*)a.ws, (volatile LAS unsigned*)(lds + 131072 + 256)); }
      else xcd_barrier(xbar);
    }
#endif
  }
}

extern "C" void kernel_launch(void* const* d_in, const int* in_sizes, int n_in, void* d_out, int out_size, void* d_ws, size_t ws_size, hipStream_t stream) {
  static int grid = 0;
  if (!grid) {
    if (n_in != 15 || out_size != M * DM || ws_size < WS_END) { fprintf(stderr, "kernel_launch: unexpected sizes n_in %d out %d ws %zu (need %zu)\n", n_in, out_size, ws_size, (size_t)WS_END); grid = -1; return; }
    int dev = 0, cus = 0, per_cu = 0;
    (void)hipGetDevice(&dev);
    (void)hipDeviceGetAttribute(&cus, hipDeviceAttributeMultiprocessorCount, dev);
    (void)hipFuncSetAttribute((const void*)fwd, hipFuncAttributeMaxDynamicSharedMemorySize, LDS_BYTES);
    (void)hipOccupancyMaxActiveBlocksPerMultiprocessor(&per_cu, (const void*)fwd, 512, LDS_BYTES);
    if (per_cu < 1) per_cu = 1;
    grid = cus * per_cu;
  }
  if (grid < 0) return;
  Args a{};
  for (int i = 0; i < 15; ++i) a.in[i] = (const float*)d_in[i];
  a.out = (float*)d_out; a.ws = (unsigned char*)d_ws;
#ifndef ONE_LAUNCH
  for (int ph = 0; ph < NPH; ++ph) {
    a.ph_lo = ph; a.ph_hi = ph + 1;
    hipLaunchKernelGGL(fwd, dim3(grid), dim3(512), LDS_BYTES, stream, a);
  }
#else
  a.ph_lo = 0; a.ph_hi = NPH;
  void* args[] = {&a};
  hipError_t er = hipLaunchCooperativeKernel((const void*)fwd, dim3(grid), dim3(512), args, LDS_BYTES, stream);
  if (er != hipSuccess) fprintf(stderr, "cooperative launch failed: %s (grid %d)\n", hipGetErrorString(er), grid);
#endif
}
```

```cpp
#include <hip/hip_runtime.h>
#include <hip/hip_cooperative_groups.h>
#include <cstdio>
#include <cstdint>
namespace cg = cooperative_groups;
#define ONE_LAUNCH 1

#define LAS __attribute__((address_space(3)))
typedef unsigned short bf16_t;
typedef short bf16x8 __attribute__((ext_vector_type(8)));
typedef float f32x4 __attribute__((ext_vector_type(4)));
typedef float f32x2 __attribute__((ext_vector_type(2)));
typedef float f32x16 __attribute__((ext_vector_type(16)));
typedef unsigned u32x4 __attribute__((ext_vector_type(4)));
typedef unsigned u32x2 __attribute__((ext_vector_type(2)));

constexpr int M = 16384, SEQ = 8192, DM = 1024, FF = 4096;
constexpr int EV_N = 2048;
constexpr int OD_NC = 4608;
constexpr float LOG2E = 1.4426950408889634f;
constexpr float C_NA = 0.125f * LOG2E;
constexpr float C_MLA = 0.10206207261596575f * LOG2E;
constexpr float RMS_EPS = 1e-6f;
constexpr float NEG_BIG = -1e30f;

constexpr size_t MiB = 1u << 20;
constexpr size_t WS_COS64 = 1 * MiB, WS_SIN64 = 2 * MiB, WS_COS32 = 3 * MiB, WS_SIN32 = 3 * MiB + 512 * 1024;
constexpr size_t WS_W = 4 * MiB;
constexpr size_t W_IN = 0, W_O = 18 * MiB, W_1 = 20 * MiB, W_2 = 28 * MiB, W_UQ = 36 * MiB, W_UKV = 36 * MiB + 512 * 1024;
constexpr size_t WS_XN = 41 * MiB;
constexpr size_t WS_ATT = 73 * MiB;
constexpr size_t WS_BIG = 105 * MiB;
constexpr size_t B_QKNA = 0, B_VTNA = 32 * MiB, B_CRAW = 48 * MiB, B_CQN = 60 * MiB, B_CKVN = 68 * MiB, B_KPE = 72 * MiB,
                 B_QMLA = 73 * MiB, B_KN = 97 * MiB, B_VTMLA = 113 * MiB;
constexpr size_t B_QK = 0, B_VT = 96 * MiB, B_LSE = 144 * MiB;
constexpr size_t WS_END = WS_BIG + 146 * MiB;

constexpr int LDS_BYTES = 147456;
constexpr int NPH = 37;

__device__ const float INV64[32] = {
  1.000000000e+00f, 7.498942018e-01f, 5.623413324e-01f, 4.216965139e-01f, 3.162277639e-01f, 2.371373922e-01f, 1.778279394e-01f, 1.333521456e-01f,
  1.000000015e-01f, 7.498941571e-02f, 5.623412877e-02f, 4.216964915e-02f, 3.162277862e-02f, 2.371373586e-02f, 1.778279431e-02f, 1.333521493e-02f,
  9.999999776e-03f, 7.498942316e-03f, 5.623413250e-03f, 4.216964822e-03f, 3.162277862e-03f, 2.371373819e-03f, 1.778279431e-03f, 1.333521446e-03f,
  1.000000047e-03f, 7.498941850e-04f, 5.623413017e-04f, 4.216965463e-04f, 3.162277862e-04f, 2.371373848e-04f, 1.778279402e-04f, 1.333521504e-04f};

__device__ __forceinline__ unsigned cvt_pk_bf16(float lo, float hi) { unsigned r; asm volatile("v_cvt_pk_bf16_f32 %0, %1, %2" : "=v"(r) : "v"(lo), "v"(hi)); return r; }
__device__ __forceinline__ bf16_t f2bf(float f) { return (bf16_t)(cvt_pk_bf16(f, 0.f) & 0xffffu); }
__device__ __forceinline__ float bf2f(unsigned short h) { return __uint_as_float(((unsigned)h) << 16); }
__device__ __forceinline__ float bflo(unsigned w) { return __uint_as_float(w << 16); }
__device__ __forceinline__ float bfhi(unsigned w) { return __uint_as_float(w & 0xffff0000u); }
__device__ __forceinline__ int vtidx(int p) { return (p & ~12) | ((p & 4) << 1) | ((p & 8) >> 1); }
__device__ __forceinline__ float wave_sum(float v) {
#pragma unroll
  for (int o = 1; o < 64; o <<= 1) v += __shfl_xor(v, o);
  return v;
}
__device__ __forceinline__ void unpack8(const u32x4 w, float* f) {
  f[0] = bflo(w.x); f[1] = bfhi(w.x); f[2] = bflo(w.y); f[3] = bfhi(w.y); f[4] = bflo(w.z); f[5] = bfhi(w.z); f[6] = bflo(w.w); f[7] = bfhi(w.w);
}

namespace pg8 {
constexpr int BM = 256, BK = 64, HALF = 128, HTB = HALF * BK * 2, STAGE_BYTES = 8 * HTB, NXCD = 8, WGM = 8;
__host__ __device__ __forceinline__ int lds_byte(int r, int c) { const int st = (r >> 4) * 2 + (c >> 5), rr = r & 15, cc = c & 31, ob = rr * 64 + cc * 2; return st * 1024 + (ob ^ (((ob >> 9) & 1) << 5)); }
__host__ __device__ __forceinline__ void stage_rc(int b, int& R, int& C) { const int st = b / 1024, sb = b % 1024, swz = sb ^ (((sb >> 9) & 1) << 5); R = (st >> 1) * 16 + swz / 64; C = (st & 1) * 32 + (swz % 64) / 2; }
__host__ __device__ __forceinline__ int perm32(int rho) { const int n = rho >> 4, i = rho & 15; return 8 * (i >> 2) + 4 * n + (i & 3); }

struct Unit { int pm, pn; };
struct Gemm { const bf16_t* A; const bf16_t* Bt; int M, N, K; };
struct StaticOrder {
  int nM, nN, nwg, G, c;
  __device__ void init(int M_, int N_, int G_, int c_) { nM = M_ / BM; nN = N_ / BM; nwg = nM * nN; G = G_; c = c_; }
  __device__ bool next(int i, Unit& u) const {
    const long L = (long)i * G + c; if (L >= nwg) return false;
    int wgid = (int)L; { const int q = nwg / NXCD, r = nwg % NXCD, xcd = wgid % NXCD, off = wgid / NXCD; wgid = (xcd < r ? xcd * (q + 1) : r * (q + 1) + (xcd - r) * q) + off; }
    const int nig = WGM * nN, gid = wgid / nig, fm = gid * WGM, gsz = (nM - fm) < WGM ? (nM - fm) : WGM;
    u.pm = fm + ((wgid % nig) % gsz); u.pn = (wgid % nig) / gsz; return true;
  }
};

template <class Epi>
__device__ __forceinline__ void gemm_phase(LAS unsigned char* lds, const Gemm g, const StaticOrder& S, const Epi& E) {
  int tid = threadIdx.x; asm volatile("" : "+v"(tid));
  const int wid = __builtin_amdgcn_readfirstlane(tid >> 6), lane = tid & 63, wr = wid >> 2, wc = wid & 3, fr = lane & 15, fq = lane >> 4;
  constexpr bool PERM = true; const int K = g.K, nt = K / BK;
  unsigned voffA[2], voffB[2];
#pragma unroll
  for (int i = 0; i < 2; ++i) { int R, C; stage_rc(tid * 16 + i * 8192, R, C); const int Rb = PERM ? ((R & ~31) + perm32(R & 31)) : R;
    voffA[i] = (unsigned)(R * K + C) * 2u; voffB[i] = (unsigned)(Rb * K + C) * 2u; }
  const size_t kstep = (size_t)(BK * 2);
  const size_t hstep = (size_t)HALF * K * 2;
  const size_t tstep = 2 * hstep;
  const unsigned ldsw = (unsigned)wid * 1024u;
  const int aoff = lds_byte(wr * 64 + fr, fq * 8), boff = lds_byte(wc * 32 + fr, fq * 8);
#define PG8_SA(b, h) (((b) * 2 + (h)) * HTB)
#define PG8_SB(b, h) ((4 + (b) * 2 + (h)) * HTB)
#define PG8_STAGE(bufoff, gbase, voff) do { _Pragma("unroll") for (int _i = 0; _i < 2; ++_i) \
    __builtin_amdgcn_global_load_lds((const unsigned*)((const char*)(gbase) + (voff)[_i]), (LAS unsigned*)(lds + (bufoff) + ldsw + _i * 8192), 16, 0, 0); } while (0)
#define PG8_LDA(dst, b, h) do { _Pragma("unroll") for (int m = 0; m < 4; ++m) _Pragma("unroll") for (int k = 0; k < 2; ++k) dst[m][k] = *(const LAS bf16x8*)(lds + PG8_SA(b, h) + aoff + m * 2048 + k * 1024); } while (0)
#define PG8_LDB(dst, b, h) do { _Pragma("unroll") for (int n = 0; n < 2; ++n) _Pragma("unroll") for (int k = 0; k < 2; ++k) dst[n][k] = *(const LAS bf16x8*)(lds + PG8_SB(b, h) + boff + n * 2048 + k * 1024); } while (0)
#define PG8_MMA(ai, bj, At, Bt) do { __builtin_amdgcn_s_setprio(1); _Pragma("unroll") for (int m = 0; m < 4; ++m) _Pragma("unroll") for (int n = 0; n < 2; ++n) _Pragma("unroll") for (int k = 0; k < 2; ++k) \
    acc[ai][bj][m][n] = __builtin_amdgcn_mfma_f32_16x16x32_bf16(Bt[n][k], At[m][k], acc[ai][bj][m][n], 0, 0, 0); __builtin_amdgcn_s_setprio(0); } while (0)
#define PG8_WAIT_V(n) asm volatile("s_waitcnt vmcnt(" #n ")" ::: "memory")
#define PG8_WAIT_L(n) asm volatile("s_waitcnt lgkmcnt(" #n ")" ::: "memory")
#define PG8_BAR __builtin_amdgcn_s_barrier()
#define PG8_SCHED __builtin_amdgcn_sched_barrier(0)
  Unit cur, nxt; int ui = 0;
  if (!S.next(0, cur)) return;
  f32x4 acc[2][2][4][2];
#pragma unroll
  for (int a = 0; a < 2; ++a)
#pragma unroll
    for (int b = 0; b < 2; ++b)
#pragma unroll
      for (int m = 0; m < 4; ++m)
#pragma unroll
        for (int n = 0; n < 2; ++n) acc[a][b][m][n] = (f32x4){0.f, 0.f, 0.f, 0.f};
  bf16x8 At[4][2], B0[2][2], B1[2][2];
  const char* cA = (const char*)g.A + (size_t)cur.pm * tstep; const char* cB = (const char*)g.Bt + (size_t)cur.pn * tstep;
  PG8_STAGE(PG8_SB(0, 0), cB, voffB); PG8_STAGE(PG8_SB(0, 1), cB + hstep, voffB); PG8_STAGE(PG8_SA(0, 0), cA, voffA); PG8_STAGE(PG8_SA(0, 1), cA + hstep, voffA);
  if (wr == 1) PG8_BAR;
  PG8_WAIT_V(2); PG8_BAR;
  PG8_STAGE(PG8_SB(1, 0), cB + kstep, voffB); PG8_STAGE(PG8_SA(1, 0), cA + kstep, voffA); PG8_STAGE(PG8_SB(1, 1), cB + hstep + kstep, voffB);
  PG8_WAIT_V(6); PG8_BAR;
  for (;;) {
    const bool has_next = S.next(ui + 1, nxt);
    const char* nA = has_next ? (const char*)g.A + (size_t)nxt.pm * tstep : cA; const char* nB = has_next ? (const char*)g.Bt + (size_t)nxt.pn * tstep : cB;
    for (int t = 0; t < nt; t += 2) {
      const bool last = (t == nt - 2);
      const char* a1 = cA + (size_t)(t + 1) * kstep;
      const char* a2 = last ? nA : cA + (size_t)(t + 2) * kstep; const char* b2 = last ? nB : cB + (size_t)(t + 2) * kstep;
      const char* a3 = a2 + kstep; const char* b3 = b2 + kstep;
      PG8_LDB(B0, 0, 0); PG8_LDB(B1, 0, 1); PG8_SCHED; PG8_LDA(At, 0, 0); PG8_STAGE(PG8_SA(1, 1), a1 + hstep, voffA);
      PG8_WAIT_V(8); PG8_WAIT_L(0); PG8_BAR; PG8_MMA(0, 0, At, B0); PG8_MMA(0, 1, At, B1); PG8_BAR; PG8_SCHED;
      PG8_LDA(At, 0, 1); PG8_STAGE(PG8_SB(0, 0), b2, voffB); PG8_STAGE(PG8_SB(0, 1), b2 + hstep, voffB); PG8_STAGE(PG8_SA(0, 0), a2, voffA);
      PG8_WAIT_V(8); PG8_WAIT_L(0); PG8_BAR; PG8_MMA(1, 0, At, B0); PG8_MMA(1, 1, At, B1); PG8_BAR; PG8_SCHED;
      PG8_LDB(B0, 1, 0); PG8_LDB(B1, 1, 1); PG8_SCHED; PG8_LDA(At, 1, 0); PG8_STAGE(PG8_SA(0, 1), a2 + hstep, voffA);
      PG8_WAIT_V(8); PG8_WAIT_L(0); PG8_BAR; PG8_MMA(0, 0, At, B0); PG8_MMA(0, 1, At, B1); PG8_BAR; PG8_SCHED;
      PG8_LDA(At, 1, 1); PG8_STAGE(PG8_SB(1, 0), b3, voffB); PG8_STAGE(PG8_SB(1, 1), b3 + hstep, voffB); PG8_STAGE(PG8_SA(1, 0), a3, voffA);
      PG8_WAIT_V(8); PG8_WAIT_L(0); PG8_BAR; PG8_MMA(1, 0, At, B0); PG8_MMA(1, 1, At, B1); PG8_BAR; PG8_SCHED;
    }
    if (wr == 0) PG8_BAR;
    E(acc, cur, wr, wc, fr, fq);
    if (!has_next) break;
#pragma unroll
    for (int a = 0; a < 2; ++a)
#pragma unroll
      for (int b = 0; b < 2; ++b)
#pragma unroll
        for (int m = 0; m < 4; ++m)
#pragma unroll
          for (int n = 0; n < 2; ++n) acc[a][b][m][n] = (f32x4){0.f, 0.f, 0.f, 0.f};
    cur = nxt; cA = nA; cB = nB; ++ui;
    if (wr == 1) PG8_BAR;
  }
  PG8_WAIT_V(0);
  PG8_BAR;
#undef PG8_SA
#undef PG8_SB
#undef PG8_STAGE
#undef PG8_LDA
#undef PG8_LDB
#undef PG8_MMA
#undef PG8_WAIT_V
#undef PG8_WAIT_L
#undef PG8_BAR
#undef PG8_SCHED
}
}

enum EpiKind { K_EVIN = 0, K_UQ = 1, K_UKV = 2, K_ODIN = 3, K_RELU2 = 4, K_RESID = 5 };
struct EpiB {
  int kind;
  unsigned char* ws;
  const float* base; float* outf;
  __device__ __forceinline__ void store8(unsigned char* b, unsigned off, f32x4 v0, f32x4 v1) const {
    u32x4 w; w.x = cvt_pk_bf16(v0[0], v0[1]); w.y = cvt_pk_bf16(v0[2], v0[3]); w.z = cvt_pk_bf16(v1[0], v1[1]); w.w = cvt_pk_bf16(v1[2], v1[3]);
    *(u32x4*)(b + off) = w;
  }
  __device__ __forceinline__ void rope8(f32x4& v0, f32x4& v1, const float* ct, const float* st, unsigned toff) const {
    const f32x4 c = *(const f32x4*)((const char*)ct + toff), s = *(const f32x4*)((const char*)st + toff);
    f32x4 a0, a1;
    a0[0] = v0[0] * c[0] - v0[1] * s[0]; a0[1] = v0[1] * c[0] + v0[0] * s[0];
    a0[2] = v0[2] * c[1] - v0[3] * s[1]; a0[3] = v0[3] * c[1] + v0[2] * s[1];
    a1[0] = v1[0] * c[2] - v1[1] * s[2]; a1[1] = v1[1] * c[2] + v1[0] * s[2];
    a1[2] = v1[2] * c[3] - v1[3] * s[3]; a1[3] = v1[3] * c[3] + v1[2] * s[3];
    v0 = a0; v1 = a1;
  }
  __device__ __forceinline__ void vt8(unsigned char* vt, unsigned off, f32x4 v0, f32x4 v1) const {
    *(bf16_t*)(vt + off + 0 * SEQ * 2) = f2bf(v0[0]); *(bf16_t*)(vt + off + 1 * SEQ * 2) = f2bf(v0[1]); *(bf16_t*)(vt + off + 2 * SEQ * 2) = f2bf(v0[2]); *(bf16_t*)(vt + off + 3 * SEQ * 2) = f2bf(v0[3]);
    *(bf16_t*)(vt + off + 4 * SEQ * 2) = f2bf(v1[0]); *(bf16_t*)(vt + off + 5 * SEQ * 2) = f2bf(v1[1]); *(bf16_t*)(vt + off + 6 * SEQ * 2) = f2bf(v1[2]); *(bf16_t*)(vt + off + 7 * SEQ * 2) = f2bf(v1[3]);
  }
  __device__ __forceinline__ void operator()(const f32x4 (&acc)[2][2][4][2], const pg8::Unit& u, int wr, int wc, int fr, int fq) const {
    const int pn = u.pn;
    unsigned char* const big = ws + WS_BIG;
    const float* const cos64 = (const float*)(ws + WS_COS64); const float* const sin64 = (const float*)(ws + WS_SIN64);
    const float* const cos32 = (const float*)(ws + WS_COS32); const float* const sin32 = (const float*)(ws + WS_SIN32);
#pragma unroll
    for (int ai = 0; ai < 2; ++ai)
#pragma unroll
      for (int m = 0; m < 4; ++m) {
        asm volatile("" ::: "memory");
        const unsigned row = u.pm * 256 + ai * 128 + wr * 64 + m * 16 + fr;
        const unsigned b = row >> 13, pos = row & (SEQ - 1);
#pragma unroll
        for (int bj = 0; bj < 2; ++bj) {
          const unsigned col = pn * 256 + bj * 128 + wc * 32 + 8 * fq;
          f32x4 v0 = acc[ai][bj][m][0], v1 = acc[ai][bj][m][1];
          if (kind == K_RESID) {
            const unsigned o = (row * DM + col) * 4u;
            *(f32x4*)((char*)outf + o) = *(const f32x4*)((const char*)base + o) + v0; *(f32x4*)((char*)outf + o + 16) = *(const f32x4*)((const char*)base + o + 16) + v1;
          } else if (kind == K_RELU2) {
#pragma unroll
            for (int e = 0; e < 4; ++e) { float a = fmaxf(v0[e], 0.f), c = fmaxf(v1[e], 0.f); v0[e] = a * a; v1[e] = c * c; }
            store8(big, (row * FF + col) * 2u, v0, v1);
          } else if (kind == K_EVIN) {
            if (pn < 4) { const float sc = pn < 2 ? C_NA : 1.f; store8(big + B_QKNA, (row * 1024 + col) * 2u, v0 * sc, v1 * sc); }
            else if (pn < 6) { vt8(big + B_VTNA, ((b * 512 + (col - 1024)) * SEQ + vtidx(pos)) * 2u, v0, v1); }
            else if (pn == 6) { store8(big + B_CRAW, (row * 384 + (col - 1536)) * 2u, v0, v1); }
            else {
              if (bj == 0) store8(big + B_CRAW, (row * 384 + 256 + (col - 1792)) * 2u, v0, v1);
              else if (wc == 0) { rope8(v0, v1, cos32, sin32, (pos * 16 + 4 * fq) * 4u); store8(big + B_KPE, (row * 32 + 8 * fq) * 2u, v0, v1); }
            }
          } else if (kind == K_UQ) {
            if (pn == 2) rope8(v0, v1, cos32, sin32, (pos * 16 + ((col & 31) >> 1)) * 4u);
            store8(big + B_QMLA, (row * 768 + col) * 2u, v0 * C_MLA, v1 * C_MLA);
          } else if (kind == K_UKV) {
            if (pn < 2) store8(big + B_KN, (row * 512 + col) * 2u, v0, v1);
            else vt8(big + B_VTMLA, ((b * 512 + (col - 512)) * SEQ + vtidx(pos)) * 2u, v0, v1);
          } else {
            const int s = pn >> 1;
            if (s < 6) {
              rope8(v0, v1, cos64, sin64, (pos * 32 + ((col & 63) >> 1)) * 4u);
              const float sc = (s & 1) ? 1.f : C_NA;
              store8(big + B_QK, (row * 3072 + col) * 2u, v0 * sc, v1 * sc);
            } else {
              const int gq = s - 6, sh = 2 * gq;
              const unsigned lidx = ((pos & ((1u << sh) - 1)) << (13 - sh)) | (pos >> sh);
              vt8(big + B_VT, (((b * 3 + gq) * 512 + (col - s * 512)) * SEQ + vtidx(lidx)) * 2u, v0, v1);
            }
          }
        }
      }
  }
};

enum ColMap { CM_ID = 0, CM_EVIN = 1, CM_UQ = 2, CM_UKV = 3, CM_ODIN = 4 };
__device__ __forceinline__ int colmap(int kind, int n) {
  switch (kind) {
    case CM_EVIN: { if (n < 1920) return n; if (n >= 1952) return -1; const int j = n - 1920, k = j >> 1; return 1920 + ((j & 1) ? k + 16 : k); }
    case CM_UQ: { if (n < 512) return (n >> 6) * 96 + (n & 63); const int h = (n - 512) >> 5, j = (n - 512) & 31, k = j >> 1; return h * 96 + 64 + ((j & 1) ? k + 16 : k); }
    case CM_UKV: { if (n < 512) return (n >> 6) * 128 + (n & 63); const int n2 = n - 512; return (n2 >> 6) * 128 + 64 + (n2 & 63); }
    case CM_ODIN: { const int ch = n / OD_NC, n1 = n - ch * OD_NC, s = n1 >> 9, hl = (n1 & 511) >> 6, j = n1 & 63;
      int gq, t, js; if (s < 6) { gq = s >> 1; t = s & 1; const int k = j >> 1; js = (j & 1) ? k + 32 : k; } else { gq = s - 6; t = 2; js = j; }
      return ((gq * 3 + t) * 16 + (8 * ch + hl)) * 64 + js; }
    default: return n;
  }
}
__device__ __forceinline__ void transpose_item(const float* W, int K, int Nsrc, int Nout, bf16_t* WT, int cm, LAS float* scr, int item, int lane) {
  const int nblk = Nout / 32, kb = item / nblk, nb = item % nblk, k0 = 64 * kb, n0 = 32 * nb;
  const int sc = colmap(cm, n0 + (lane & 31));
#pragma unroll 8
  for (int i = 0; i < 32; ++i) { const int kk = 2 * i + (lane >> 5); scr[kk * 33 + (lane & 31)] = sc >= 0 ? W[(size_t)(k0 + kk) * Nsrc + sc] : 0.f; }
  asm volatile("s_waitcnt lgkmcnt(0)" ::: "memory");
  const int c = lane & 7;
#pragma unroll
  for (int j = 0; j < 4; ++j) { const int n = (lane >> 3) + 8 * j; const LAS float* s = scr + (8 * c) * 33 + n;
    u32x4 o; o.x = cvt_pk_bf16(s[0 * 33], s[1 * 33]); o.y = cvt_pk_bf16(s[2 * 33], s[3 * 33]); o.z = cvt_pk_bf16(s[4 * 33], s[5 * 33]); o.w = cvt_pk_bf16(s[6 * 33], s[7 * 33]);
    *(u32x4*)(WT + (size_t)(n0 + n) * K + k0 + 8 * c) = o; }
  asm volatile("s_waitcnt lgkmcnt(0)" ::: "memory");
}
__device__ __forceinline__ void rms_row_bf16(const float* xrow, const float* g, bf16_t* orow, int lane) {
  const f32x4* xr = (const f32x4*)xrow + lane; const f32x4* gr = (const f32x4*)g + lane;
  f32x4 v[4]; float s = 0.f;
#pragma unroll
  for (int j = 0; j < 4; ++j) { v[j] = xr[64 * j]; s += (v[j].x * v[j].x + v[j].y * v[j].y) + (v[j].z * v[j].z + v[j].w * v[j].w); }
  const float rstd = 1.f / sqrtf(wave_sum(s) * (1.f / DM) + RMS_EPS);
  u32x2* o8 = (u32x2*)orow + lane;
#pragma unroll
  for (int j = 0; j < 4; ++j) { const f32x4 gg = gr[64 * j]; u32x2 w; w.x = cvt_pk_bf16(v[j].x * rstd * gg.x, v[j].y * rstd * gg.y); w.y = cvt_pk_bf16(v[j].z * rstd * gg.z, v[j].w * rstd * gg.w); o8[64 * j] = w; }
}
__device__ __forceinline__ void rms_row_f32(const float* xrow, const float* g, float* orow, int lane) {
  const f32x4* xr = (const f32x4*)xrow + lane; const f32x4* gr = (const f32x4*)g + lane;
  f32x4 v[4]; float s = 0.f;
#pragma unroll
  for (int j = 0; j < 4; ++j) { v[j] = xr[64 * j]; s += (v[j].x * v[j].x + v[j].y * v[j].y) + (v[j].z * v[j].z + v[j].w * v[j].w); }
  const float rstd = 1.f / sqrtf(wave_sum(s) * (1.f / DM) + RMS_EPS);
  f32x4* o = (f32x4*)orow + lane;
#pragma unroll
  for (int j = 0; j < 4; ++j) { const f32x4 gg = gr[64 * j]; o[64 * j] = v[j] * rstd * gg; }
}
__device__ __forceinline__ void sincos_acc(float angf, float& sn, float& cs) {
  const double x = (double)angf;
  const double n = __builtin_rint(x * 0.63661977236758134308);
  double r = __builtin_fma(-n, 1.57079632679489655800e+00, x); r = __builtin_fma(-n, 6.12323399573676603587e-17, r);
  const double r2 = r * r;
  double sp = 1.0 / 6227020800.0; sp = sp * r2 - 1.0 / 39916800.0; sp = sp * r2 + 1.0 / 362880.0; sp = sp * r2 - 1.0 / 5040.0; sp = sp * r2 + 1.0 / 120.0; sp = sp * r2 - 1.0 / 6.0; sp = sp * r2 + 1.0; sp *= r;
  double cp = -1.0 / 87178291200.0; cp = cp * r2 + 1.0 / 479001600.0; cp = cp * r2 - 1.0 / 3628800.0; cp = cp * r2 + 1.0 / 40320.0; cp = cp * r2 - 1.0 / 720.0; cp = cp * r2 + 1.0 / 24.0; cp = cp * r2 - 0.5; cp = cp * r2 + 1.0;
  const int q = ((int)(long long)n) & 3;
  const double s_ = (q & 1) ? cp : sp, c_ = (q & 1) ? sp : cp;
  sn = (float)((q & 2) ? -s_ : s_);
  cs = (float)(((q + 1) & 2) ? -c_ : c_);
}

__device__ __forceinline__ int crow(int r, int hi) { return (r & 3) + 8 * (r >> 2) + 4 * hi; }
__device__ __forceinline__ float half_max(float m) { auto rr = __builtin_amdgcn_permlane32_swap(__float_as_uint(m), __float_as_uint(m), false, false); return fmaxf(__uint_as_float(rr[0]), __uint_as_float(rr[1])); }
__device__ __forceinline__ float half_sum(float m) { auto rr = __builtin_amdgcn_permlane32_swap(__float_as_uint(m), __float_as_uint(m), false, false); return __uint_as_float(rr[0]) + __uint_as_float(rr[1]); }
__device__ __forceinline__ bf16x8 ldg8(const unsigned char* base, unsigned off) { return *(const bf16x8*)(base + off); }
__device__ __forceinline__ void softmax_pv(f32x16& s, const bf16x8 (&vf)[4], f32x16& o0, f32x16& o1, float& mrun, float& lrun) {
  float mx = fmaxf(s[0], s[1]);
#pragma unroll
  for (int r = 2; r < 16; ++r) mx = fmaxf(mx, s[r]);
  mx = half_max(mx);
  const float mnew = fmaxf(mrun, mx), alpha = __builtin_amdgcn_exp2f(mrun - mnew); mrun = mnew;
  float ls = 0.f;
#pragma unroll
  for (int r = 0; r < 16; ++r) { s[r] = __builtin_amdgcn_exp2f(s[r] - mnew); ls += s[r]; }
  lrun = lrun * alpha + ls;
  if (__builtin_amdgcn_ballot_w64(alpha != 1.f) != 0ull) {
#pragma unroll
    for (int r = 0; r < 16; ++r) { o0[r] *= alpha; o1[r] *= alpha; }
  }
  u32x4 w0, w1;
  w0.x = cvt_pk_bf16(s[0], s[1]); w0.y = cvt_pk_bf16(s[2], s[3]); w0.z = cvt_pk_bf16(s[4], s[5]); w0.w = cvt_pk_bf16(s[6], s[7]);
  w1.x = cvt_pk_bf16(s[8], s[9]); w1.y = cvt_pk_bf16(s[10], s[11]); w1.z = cvt_pk_bf16(s[12], s[13]); w1.w = cvt_pk_bf16(s[14], s[15]);
  const bf16x8 p0 = __builtin_bit_cast(bf16x8, w0), p1 = __builtin_bit_cast(bf16x8, w1);
  o0 = __builtin_amdgcn_mfma_f32_32x32x16_bf16(vf[0], p0, o0, 0, 0, 0); o0 = __builtin_amdgcn_mfma_f32_32x32x16_bf16(vf[1], p1, o0, 0, 0, 0);
  o1 = __builtin_amdgcn_mfma_f32_32x32x16_bf16(vf[2], p0, o1, 0, 0, 0); o1 = __builtin_amdgcn_mfma_f32_32x32x16_bf16(vf[3], p1, o1, 0, 0, 0);
}
__device__ __forceinline__ void store_ot(unsigned char* base, unsigned rowoff, const f32x16& o0, const f32x16& o1, float il, int hi) {
#pragma unroll
  for (int a = 0; a < 4; ++a) {
    u32x2 w; w.x = cvt_pk_bf16(o0[4 * a] * il, o0[4 * a + 1] * il); w.y = cvt_pk_bf16(o0[4 * a + 2] * il, o0[4 * a + 3] * il);
    *(u32x2*)(base + rowoff + (8 * a + 4 * hi) * 2) = w;
    u32x2 v; v.x = cvt_pk_bf16(o1[4 * a] * il, o1[4 * a + 1] * il); v.y = cvt_pk_bf16(o1[4 * a + 2] * il, o1[4 * a + 3] * il);
    *(u32x2*)(base + rowoff + (32 + 8 * a + 4 * hi) * 2) = v;
  }
}

constexpr int MLA_STEP_BYTES = 40960, MLA_NSTEP = SEQ / 128;
__device__ __forceinline__ void mla_attn_phase(unsigned char* big, unsigned char* att, LAS unsigned char* lds, int bx, int G, int wave, int lane) {
  const int r32 = lane & 31, hi = lane >> 5;
  for (int u = bx; u < 512; u += G) {
    const int bh = u >> 5, qb = u & 31, b = bh >> 3, h = bh & 7;
    const unsigned m0 = b * SEQ + qb * 256 + wave * 32 + r32;
    bf16x8 qf[6];
#pragma unroll
    for (int c = 0; c < 4; ++c) qf[c] = ldg8(big + B_QMLA, (m0 * 768 + h * 64 + 16 * c + 8 * hi) * 2u);
#pragma unroll
    for (int c = 0; c < 2; ++c) qf[4 + c] = ldg8(big + B_QMLA, (m0 * 768 + 512 + h * 32 + 16 * c + 8 * hi) * 2u);
    const unsigned char* kn = big + B_KN + ((size_t)b * SEQ * 512 + h * 64) * 2;
    const unsigned char* kp = big + B_KPE + ((size_t)b * SEQ * 32) * 2;
    const unsigned char* vt = big + B_VTMLA + ((size_t)(b * 8 + h) * 64 * SEQ) * 2;
    const unsigned char* sbase[5]; unsigned sstride[5], loff[5];
#pragma unroll
    for (int i = 0; i < 5; ++i) {
      const int sl = wave * 5 + i, tt = sl / 10, f = sl % 10;
      if (f < 4) { sbase[i] = kn + (size_t)tt * (32 * 512 * 2); loff[i] = (r32 * 512 + 16 * f + 8 * hi) * 2u; sstride[i] = 128 * 512 * 2; }
      else if (f < 6) { sbase[i] = kp + (size_t)tt * (32 * 32 * 2); loff[i] = (r32 * 32 + 16 * (f - 4) + 8 * hi) * 2u; sstride[i] = 128 * 32 * 2; }
      else { const int d0 = (f - 6) >> 1, j = (f - 6) & 1; sbase[i] = vt + (size_t)tt * 64; loff[i] = ((d0 * 32 + r32) * SEQ + 16 * j + 8 * hi) * 2u; sstride[i] = 256; }
    }
#define MLA_ISSUE(st, rs) do { _Pragma("unroll") for (int i = 0; i < 5; ++i) \
      __builtin_amdgcn_global_load_lds((const unsigned*)(sbase[i] + (size_t)(st) * sstride[i] + loff[i]), (LAS unsigned*)(lds + (rs) * MLA_STEP_BYTES + (wave * 5 + i) * 1024), 16, 0, 0); } while (0)
#define MLA_FRAGS(KF, VF, base) do { \
      _Pragma("unroll") for (int c = 0; c < 6; ++c) KF[c] = *(const LAS bf16x8*)(lds + (base) + c * 1024 + lane * 16); \
      _Pragma("unroll") for (int c = 0; c < 4; ++c) VF[c] = *(const LAS bf16x8*)(lds + (base) + (6 + c) * 1024 + lane * 16); } while (0)
#define MLA_TILE(KF, VF) do { f32x16 s = {0.f, 0.f, 0.f, 0.f, 0.f, 0.f, 0.f, 0.f, 0.f, 0.f, 0.f, 0.f, 0.f, 0.f, 0.f, 0.f}; \
      _Pragma("unroll") for (int c = 0; c < 6; ++c) s = __builtin_amdgcn_mfma_f32_32x32x16_bf16(KF[c], qf[c], s, 0, 0, 0); \
      softmax_pv(s, VF, o0, o1, mrun, lrun); } while (0)
    f32x16 o0 = {0.f, 0.f, 0.f, 0.f, 0.f, 0.f, 0.f, 0.f, 0.f, 0.f, 0.f, 0.f, 0.f, 0.f, 0.f, 0.f}, o1 = o0;
    float mrun = NEG_BIG, lrun = 0.f;
    MLA_ISSUE(0, 0); MLA_ISSUE(1, 1);
    int rs = 0;
    for (int st = 0; st < MLA_NSTEP; ++st) {
      if (st + 1 < MLA_NSTEP) asm volatile("s_waitcnt vmcnt(5)" ::: "memory"); else asm volatile("s_waitcnt vmcnt(0)" ::: "memory");
      __builtin_amdgcn_s_barrier();
      asm volatile("" ::: "memory");
      if (st + 2 < MLA_NSTEP) { const int rn = (rs >= 1) ? rs - 1 : 2; MLA_ISSUE(st + 2, rn); }
      const int sb = rs * MLA_STEP_BYTES;
      bf16x8 kfa[6], vfa[4], kfb[6], vfb[4];
      MLA_FRAGS(kfa, vfa, sb);
      MLA_FRAGS(kfb, vfb, sb + 10240);
      MLA_TILE(kfa, vfa);
      MLA_FRAGS(kfa, vfa, sb + 20480);
      MLA_TILE(kfb, vfb);
      MLA_FRAGS(kfb, vfb, sb + 30720);
      MLA_TILE(kfa, vfa);
      MLA_TILE(kfb, vfb);
      asm volatile("s_waitcnt lgkmcnt(0)" ::: "memory");
      rs = (rs == 2) ? 0 : rs + 1;
    }
#undef MLA_ISSUE
#undef MLA_FRAGS
#undef MLA_TILE
    const float il = 1.f / half_sum(lrun);
    store_ot(att, (m0 * 1024 + 512 + h * 64) * 2u, o0, o1, il, hi);
    __builtin_amdgcn_s_barrier();
  }
}

__device__ __forceinline__ void na_attn_phase(unsigned char* big, unsigned char* att, const float* rpb, int gw, int NGW, int lane) {
  const int r32 = lane & 31, hi = lane >> 5;
  for (int wt = gw; wt < 4096; wt += NGW) {
    const int w = wt & 1, h = (wt >> 1) & 7, r = (wt >> 4) & 127, b = wt >> 11;
    const int rs = min(max(r - 4, 0), 120), c = 32 * w + r32, cs = min(max(c - 8, 0), 48);
    const unsigned m0 = b * SEQ + r * 64 + c;
    bf16x8 qf[4];
#pragma unroll
    for (int cc = 0; cc < 4; ++cc) qf[cc] = ldg8(big + B_QKNA, (m0 * 1024 + h * 64 + 16 * cc + 8 * hi) * 2u);
    const unsigned char* kb = big + B_QKNA + ((size_t)(b * SEQ + rs * 64) * 1024 + 512 + h * 64) * 2;
    const unsigned char* vt = big + B_VTNA + ((size_t)(b * 8 + h) * 64 * SEQ + rs * 64) * 2;
    const unsigned ko = (r32 * 1024 + 8 * hi) * 2u, vto = (r32 * SEQ + 8 * hi) * 2u;
    const float* bias_h = rpb + h * 15 * 31;
    f32x16 o0 = {0.f, 0.f, 0.f, 0.f, 0.f, 0.f, 0.f, 0.f, 0.f, 0.f, 0.f, 0.f, 0.f, 0.f, 0.f, 0.f}, o1 = o0;
    float mrun = NEG_BIG, lrun = 0.f;
    for (int t = 0; t < 16; ++t) {
      bf16x8 kf[4], vf[4];
#pragma unroll
      for (int cc = 0; cc < 4; ++cc) kf[cc] = ldg8(kb + (size_t)t * (32 * 1024 * 2), ko + 32 * cc);
#pragma unroll
      for (int d0 = 0; d0 < 2; ++d0)
#pragma unroll
        for (int j = 0; j < 2; ++j) vf[2 * d0 + j] = ldg8(vt + (size_t)t * 64, vto + d0 * (32 * SEQ * 2) + j * 32);
      f32x16 s = {0.f, 0.f, 0.f, 0.f, 0.f, 0.f, 0.f, 0.f, 0.f, 0.f, 0.f, 0.f, 0.f, 0.f, 0.f, 0.f};
#pragma unroll
      for (int cc = 0; cc < 4; ++cc) s = __builtin_amdgcn_mfma_f32_32x32x16_bf16(kf[cc], qf[cc], s, 0, 0, 0);
      const int kr = rs + (t >> 1);
      const float* brow = bias_h + (kr - r + 7) * 31;
#pragma unroll
      for (int rr = 0; rr < 16; ++rr) {
        const int kc = 32 * (t & 1) + crow(rr, hi), rel = kc - c + 15;
        const bool ok = (kc >= cs) && (kc < cs + 16);
        const float bv = brow[min(max(rel, 0), 30)];
        s[rr] = ok ? s[rr] + bv * LOG2E : NEG_BIG;
      }
      softmax_pv(s, vf, o0, o1, mrun, lrun);
    }
    const float il = 1.f / half_sum(lrun);
    store_ot(att, (m0 * 1024 + h * 64) * 2u, o0, o1, il, hi);
  }
}

struct DilWT { unsigned mq; int gq, sh, rho, i0, nseq; const unsigned char* vt; };
__device__ __forceinline__ DilWT dil_wt(int wt, int b, int hl, int P0, int r32, const unsigned char* big) {
  DilWT w; w.gq = wt >> 4; const int j = wt & 15; w.sh = 2 * w.gq;
  w.rho = (w.gq == 0) ? 0 : (w.gq == 1) ? (j >> 2) : j; const int it = (w.gq == 0) ? j : (w.gq == 1) ? (j & 3) : 0;
  w.i0 = (P0 >> w.sh) + 32 * it; w.nseq = SEQ >> w.sh;
  w.mq = b * SEQ + ((w.i0 + r32) << w.sh) + w.rho;
  w.vt = big + B_VT + ((size_t)((b * 3 + w.gq) * 8 + hl) * 64 * SEQ + w.rho * w.nseq) * 2;
  return w;
}
__device__ __forceinline__ void dil_attn_phase(unsigned char* big, unsigned char* att, int ch, int bx, int G, int wave, int lane, int tid) {
  const int r32 = lane & 31, hi = lane >> 5;
  float* lse = (float*)(big + B_LSE);
  for (int u = bx; u < 256; u += G) {
    const int b = u >> 7, hl = (u >> 4) & 7, P0 = (u & 15) * 512;
    const unsigned vto = (r32 * SEQ + 8 * hi) * 2u;
    f32x16 o0, o1; float mrun, lrun;
    bf16x8 qx[4], qy[4], ka[4], va[4], kb[4], vb[4];
#define DIL_LOADQ(Q, W) do { _Pragma("unroll") for (int cc = 0; cc < 4; ++cc) Q[cc] = ldg8(big + B_QK, (W.mq * 3072 + W.gq * 1024 + hl * 64 + 16 * cc + 8 * hi) * 2u); } while (0)
#define DIL_LOAD(KF, VF, W, T) do { const int k0_ = W.i0 - 64 + 32 * (T), k0c_ = min(max(k0_, 0), W.nseq - 32); \
      const unsigned mk_ = b * SEQ + ((k0c_ + r32) << W.sh) + W.rho; \
      _Pragma("unroll") for (int cc = 0; cc < 4; ++cc) KF[cc] = ldg8(big + B_QK, (mk_ * 3072 + W.gq * 1024 + 512 + hl * 64 + 16 * cc + 8 * hi) * 2u); \
      _Pragma("unroll") for (int d0 = 0; d0 < 2; ++d0) _Pragma("unroll") for (int jj = 0; jj < 2; ++jj) VF[2 * d0 + jj] = ldg8(W.vt + (size_t)k0c_ * 2, vto + d0 * (32 * SEQ * 2) + jj * 32); } while (0)
#define DIL_COMP(KF, VF, Q, W, T) do { \
      if ((T) == 0) { _Pragma("unroll") for (int rr = 0; rr < 16; ++rr) { o0[rr] = 0.f; o1[rr] = 0.f; } mrun = NEG_BIG; lrun = 0.f; } \
      const int k0_ = W.i0 - 64 + 32 * (T); const bool tv_ = (k0_ >= 0) && (k0_ < W.nseq); \
      if (tv_) { \
      f32x16 s = {0.f, 0.f, 0.f, 0.f, 0.f, 0.f, 0.f, 0.f, 0.f, 0.f, 0.f, 0.f, 0.f, 0.f, 0.f, 0.f}; \
      _Pragma("unroll") for (int cc = 0; cc < 4; ++cc) s = __builtin_amdgcn_mfma_f32_32x32x16_bf16(KF[cc], Q[cc], s, 0, 0, 0); \
      _Pragma("unroll") for (int rr = 0; rr < 16; ++rr) { \
        const bool ok_ = ((T) == 0 ? (crow(rr, hi) >= r32) : (T) == 4 ? (crow(rr, hi) <= r32) : true); \
        s[rr] = ok_ ? s[rr] : NEG_BIG; } \
      softmax_pv(s, VF, o0, o1, mrun, lrun); } \
      if ((T) == 4) { const float lt_ = half_sum(lrun), il_ = 1.f / lt_; \
        store_ot(big + B_QK, (W.mq * 3072 + W.gq * 1024 + hl * 64) * 2u, o0, o1, il_, hi); \
        if (hi == 0) lse[(W.mq * 8 + hl) * 3 + W.gq] = mrun + __builtin_amdgcn_logf(lt_); } } while (0)
    DilWT WX = dil_wt(wave, b, hl, P0, r32, big), WY = WX;
    DIL_LOADQ(qx, WX); DIL_LOAD(ka, va, WX, 0);
    for (int pair = 0; pair < 3; ++pair) {
      WY = dil_wt(wave + 8 * (2 * pair + 1), b, hl, P0, r32, big);
      DIL_LOAD(kb, vb, WX, 1); DIL_COMP(ka, va, qx, WX, 0);
      DIL_LOAD(ka, va, WX, 2); DIL_COMP(kb, vb, qx, WX, 1);
      DIL_LOAD(kb, vb, WX, 3); DIL_COMP(ka, va, qx, WX, 2);
      DIL_LOAD(ka, va, WX, 4); DIL_COMP(kb, vb, qx, WX, 3);
      DIL_LOADQ(qy, WY); DIL_LOAD(kb, vb, WY, 0); DIL_COMP(ka, va, qx, WX, 4);
      DIL_LOAD(ka, va, WY, 1); DIL_COMP(kb, vb, qy, WY, 0);
      DIL_LOAD(kb, vb, WY, 2); DIL_COMP(ka, va, qy, WY, 1);
      DIL_LOAD(ka, va, WY, 3); DIL_COMP(kb, vb, qy, WY, 2);
      DIL_LOAD(kb, vb, WY, 4); DIL_COMP(ka, va, qy, WY, 3);
      if (pair < 2) { WX = dil_wt(wave + 8 * (2 * pair + 2), b, hl, P0, r32, big); DIL_LOADQ(qx, WX); DIL_LOAD(ka, va, WX, 0); }
      DIL_COMP(kb, vb, qy, WY, 4);
    }
#undef DIL_LOADQ
#undef DIL_LOAD
#undef DIL_COMP
    __syncthreads();
    {
      const unsigned m = b * SEQ + P0 + tid;
      const float l0 = lse[(m * 8 + hl) * 3 + 0], l1 = lse[(m * 8 + hl) * 3 + 1], l2 = lse[(m * 8 + hl) * 3 + 2];
      const float lm = fmaxf(l0, fmaxf(l1, l2));
      float w0 = __builtin_amdgcn_exp2f(l0 - lm), w1 = __builtin_amdgcn_exp2f(l1 - lm), w2 = __builtin_amdgcn_exp2f(l2 - lm);
      const float iw = 1.f / (w0 + w1 + w2); w0 *= iw; w1 *= iw; w2 *= iw;
#pragma unroll
      for (int jj = 0; jj < 8; ++jj) {
        float a0[8], a1[8], a2[8];
        unpack8(*(const u32x4*)(big + B_QK + ((size_t)m * 3072 + 0 * 1024 + hl * 64 + 8 * jj) * 2), a0);
        unpack8(*(const u32x4*)(big + B_QK + ((size_t)m * 3072 + 1 * 1024 + hl * 64 + 8 * jj) * 2), a1);
        unpack8(*(const u32x4*)(big + B_QK + ((size_t)m * 3072 + 2 * 1024 + hl * 64 + 8 * jj) * 2), a2);
        float f[8];
#pragma unroll
        for (int e = 0; e < 8; ++e) f[e] = w0 * a0[e] + w1 * a1[e] + w2 * a2[e];
        u32x4 wv; wv.x = cvt_pk_bf16(f[0], f[1]); wv.y = cvt_pk_bf16(f[2], f[3]); wv.z = cvt_pk_bf16(f[4], f[5]); wv.w = cvt_pk_bf16(f[6], f[7]);
        *(u32x4*)(att + ((size_t)m * 1024 + (8 * ch + hl) * 64 + 8 * jj) * 2) = wv;
      }
    }
    __syncthreads();
  }
}

#define XB_TMO      128
#define XB_XCNT(j)  (256  + 64 * (j))
#define XB_XSUB(j)  (1280 + 64 * (j))
#define XB_XGEN(j)  (2304 + 64 * (j))
#define XB_TOP      3328
#define XB_TOPGEN   3392
#define XCD_BAR_WORDS 3456
#define XB_SPIN_CAP (1u << 18)
__device__ __forceinline__ unsigned xb_ld(unsigned* p)              { return __hip_atomic_load(p, __ATOMIC_RELAXED, __HIP_MEMORY_SCOPE_AGENT); }
__device__ __forceinline__ unsigned xb_add(unsigned* p, unsigned v) { return __hip_atomic_fetch_add(p, v, __ATOMIC_RELAXED, __HIP_MEMORY_SCOPE_AGENT); }
__device__ __forceinline__ unsigned xb_xcc_id() { return (unsigned)__builtin_amdgcn_s_getreg((3 << 11) | 20) & 0xFu; }
#define XB_SPIN(cond, bar) do { unsigned _sp = 0; while (cond) { __builtin_amdgcn_s_sleep(1); \
    if ((++_sp & 255u) == 0u) { if (xb_ld(&(bar)[XB_TMO])) break; if (_sp > XB_SPIN_CAP) { atomicAdd(&(bar)[XB_TMO], 1u); break; } } } } while (0)
struct XcdBarrier { unsigned* bar; unsigned x; volatile LAS unsigned* st; };
__device__ __forceinline__ XcdBarrier xcd_barrier_post(unsigned* bar, volatile LAS unsigned* st) {
  XcdBarrier b; b.bar = bar; b.x = xb_xcc_id(); b.st = st;
  if (threadIdx.x == 0) (void)xb_add(&bar[XB_XCNT(b.x)], 1u);
  return b;
}
__device__ __forceinline__ void xcd_barrier_complete(unsigned* bar, unsigned x, unsigned& nloc, unsigned& nx) {
  const unsigned G = gridDim.x * gridDim.y * gridDim.z;
  unsigned sum, cnt, mine, sp = 0u;
  for (;;) {
    sum = 0u; cnt = 0u; mine = 0u;
#pragma unroll
    for (unsigned j = 0; j < 16; ++j) { const unsigned c = xb_ld(&bar[XB_XCNT(j)]); sum += c; cnt += (c > 0u) ? 1u : 0u; mine = (j == x) ? c : mine; }
    if (sum == G) break;
    __builtin_amdgcn_s_sleep(1);
    if ((++sp & 255u) == 0u) { if (xb_ld(&bar[XB_TMO])) break; if (sp > XB_SPIN_CAP) { atomicAdd(&bar[XB_TMO], 1u); break; } }
  }
  nloc = mine > 0u ? mine : 1u; nx = cnt > 0u ? cnt : 1u;
}
__device__ __forceinline__ void xcd_barrier(const XcdBarrier& b) {
  asm volatile("s_waitcnt vmcnt(0)" ::: "memory");
  __syncthreads();
  if (threadIdx.x == 0) {
    unsigned* bar = b.bar;
    __builtin_amdgcn_s_waitcnt(0);
    unsigned nloc = b.st[0], nx = b.st[1];
    if (nloc == 0u) { xcd_barrier_complete(bar, b.x, nloc, nx); b.st[0] = nloc; b.st[1] = nx; }
    const unsigned old = xb_add(&bar[XB_XSUB(b.x)], 1u);
    const unsigned gen = old / nloc;
    if (old + 1u == (gen + 1u) * nloc) {
      __builtin_amdgcn_fence(__ATOMIC_RELEASE, "agent");
      asm volatile("s_waitcnt vmcnt(0)" ::: "memory");
      const unsigned og = xb_add(&bar[XB_TOP], 1u);
      const unsigned tg = og / nx;
      if (og + 1u == (tg + 1u) * nx) xb_add(&bar[XB_TOPGEN], 1u);
      else XB_SPIN(xb_ld(&bar[XB_TOPGEN]) == tg, bar);
      __builtin_amdgcn_fence(__ATOMIC_ACQUIRE, "agent");
      xb_add(&bar[XB_XGEN(b.x)], 1u);
      asm volatile("s_waitcnt vmcnt(0)" ::: "memory");
    } else {
      XB_SPIN(xb_ld(&bar[XB_XGEN(b.x)]) == gen, bar);
      __builtin_amdgcn_fence(__ATOMIC_ACQUIRE, "agent");
      asm volatile("s_waitcnt vmcnt(0)" ::: "memory");
    }
  }
  __syncthreads();
}

__device__ __forceinline__ const void* ldptr(LAS unsigned char* lds, int i) {
  const volatile LAS unsigned* p = (const volatile LAS unsigned*)(lds + 131072) + 2 * i;
  const unsigned lo = __builtin_amdgcn_readfirstlane(p[0]), hi = __builtin_amdgcn_readfirstlane(p[1]);
  return (const void*)(((unsigned long long)hi << 32) | lo);
}
struct Args { const float* in[15]; float* out; unsigned char* ws; int ph_lo, ph_hi; };

__global__ void __launch_bounds__(512, 2) fwd(Args a) {
  extern __shared__ __attribute__((aligned(16))) unsigned char lds_raw[];
  LAS unsigned char* lds = (LAS unsigned char*)lds_raw;
  cg::grid_group grid = cg::this_grid();
  const int G = gridDim.x, bx = blockIdx.x;
  const int gsz = G * 512, NGW = G * 8;
  if (threadIdx.x < 15) ((LAS unsigned long long*)(lds + 131072))[threadIdx.x] = (unsigned long long)a.in[threadIdx.x];
  if (threadIdx.x == 15) ((LAS unsigned long long*)(lds + 131072))[15] = (unsigned long long)a.out;
  if (threadIdx.x == 16) ((LAS unsigned long long*)(lds + 131072))[16] = (unsigned long long)a.ws;
  if (threadIdx.x == 17) { ((LAS unsigned*)(lds + 131072 + 256))[0] = 0u; ((LAS unsigned*)(lds + 131072 + 256))[1] = 0u; }
  if (bx == 0) for (int i = threadIdx.x; i < XCD_BAR_WORDS; i += 512) ((unsigned*)a.ws)[i] = 0u;
  __syncthreads();
  XcdBarrier xbar; xbar.bar = (unsigned*)a.ws; xbar.x = 0; xbar.st = (volatile LAS unsigned*)(lds + 131072 + 256);
#define INP(i) ((const float*)ldptr(lds, (i)))

  if (a.ph_lo == 0) {
    const int gtid0 = bx * 512 + threadIdx.x;
    float* cos64 = (float*)(a.ws + WS_COS64); float* sin64 = (float*)(a.ws + WS_SIN64); float* cos32 = (float*)(a.ws + WS_COS32); float* sin32 = (float*)(a.ws + WS_SIN32);
    for (int i = gtid0; i < SEQ * 32; i += gsz) { const int pos = i >> 5, kk = i & 31; float sn, cs; sincos_acc((float)pos * INV64[kk], sn, cs); cos64[i] = cs; sin64[i] = sn; }
    for (int i = gtid0; i < SEQ * 16; i += gsz) { const int pos = i >> 4, kk = i & 15; float sn, cs; sincos_acc((float)pos * INV64[2 * kk], sn, cs); cos32[i] = cs; sin32[i] = sn; }
  }
#ifdef ONE_LAUNCH
  for (int ph = a.ph_lo; ph < a.ph_hi; ++ph) {
#else
  { const int ph = a.ph_lo;
#endif
    int tid = threadIdx.x; asm volatile("" : "+v"(tid));
    const int lane = tid & 63, wave = __builtin_amdgcn_readfirstlane(tid >> 6), gtid = bx * 512 + tid, gw = bx * 8 + wave;
    unsigned char* ws = a.ws;
    float* X = a.out;
    unsigned char* big = ws + WS_BIG;
    bf16_t* XN = (bf16_t*)(ws + WS_XN); bf16_t* ATT = (bf16_t*)(ws + WS_ATT);
    const float* cos64 = (const float*)(ws + WS_COS64); const float* sin64 = (const float*)(ws + WS_SIN64);
    const float* cos32 = (const float*)(ws + WS_COS32); const float* sin32 = (const float*)(ws + WS_SIN32);
    if (ph == NPH - 1) {
      for (int m = gw; m < M; m += NGW) rms_row_f32(X + (size_t)m * DM, INP(3), X + (size_t)m * DM, lane);
    } else {
      const int L = ph / 9, k = ph % 9, e = L >> 1; const bool even = !(L & 1);
      const float* xsrc = (L == 0) ? INP(0) : X;
      if (k == 0) {
        LAS float* scr = (LAS float*)(lds + wave * 16384);
        const float* w1 = INP(13) + (size_t)L * DM * FF; const float* w2 = INP(14) + (size_t)L * FF * DM;
        const float* wo = even ? INP(10) + (size_t)e * DM * DM : INP(12) + (size_t)e * DM * DM;
        const int nin = even ? EV_N : 2 * OD_NC;
        const int I_IN = 16 * (nin / 32), I_O = 16 * 32, I_1 = 16 * 128, I_2 = 64 * 32, I_UQ = even ? 4 * 24 : 0, I_UKV = even ? 2 * 32 : 0;
        const int NIT = I_IN + I_O + I_1 + I_2 + I_UQ + I_UKV;
        for (int it = gw; it < NIT; it += NGW) {
          int r = it;
          if (r < I_IN) { if (even) transpose_item(INP(4) + (size_t)e * DM * 1952, DM, 1952, EV_N, (bf16_t*)(ws + WS_W + W_IN), CM_EVIN, scr, r, lane);
                          else transpose_item(INP(11) + (size_t)e * DM * 9216, DM, 9216, 2 * OD_NC, (bf16_t*)(ws + WS_W + W_IN), CM_ODIN, scr, r, lane); continue; } r -= I_IN;
          if (r < I_O) { transpose_item(wo, DM, DM, DM, (bf16_t*)(ws + WS_W + W_O), CM_ID, scr, r, lane); continue; } r -= I_O;
          if (r < I_1) { transpose_item(w1, DM, FF, FF, (bf16_t*)(ws + WS_W + W_1), CM_ID, scr, r, lane); continue; } r -= I_1;
          if (r < I_2) { transpose_item(w2, FF, DM, DM, (bf16_t*)(ws + WS_W + W_2), CM_ID, scr, r, lane); continue; } r -= I_2;
          if (r < I_UQ) { transpose_item(INP(7) + (size_t)e * 256 * 768, 256, 768, 768, (bf16_t*)(ws + WS_W + W_UQ), CM_UQ, scr, r, lane); continue; } r -= I_UQ;
          transpose_item(INP(9) + (size_t)e * 128 * 1024, 128, 1024, 1024, (bf16_t*)(ws + WS_W + W_UKV), CM_UKV, scr, r, lane);
        }
        for (int m = gw; m < M; m += NGW) rms_row_bf16(xsrc + (size_t)m * DM, INP(1) + L * DM, XN + (size_t)m * DM, lane);
      } else if (k == 6) {
        for (int m = gw; m < M; m += NGW) rms_row_bf16(X + (size_t)m * DM, INP(2) + L * DM, XN + (size_t)m * DM, lane);
      } else if (even && k == 2) {
        const bf16_t* CR = (const bf16_t*)(big + B_CRAW); bf16_t* CQN = (bf16_t*)(big + B_CQN); bf16_t* CKVN = (bf16_t*)(big + B_CKVN);
        const float* gq = INP(6) + e * 256; const float* gkv = INP(8) + e * 128;
        for (int m = gw; m < M; m += NGW) {
          const u32x2 w = *(const u32x2*)(CR + (size_t)m * 384 + 4 * lane);
          const float v0 = bflo(w.x), v1 = bfhi(w.x), v2 = bflo(w.y), v3 = bfhi(w.y);
          const float rq = 1.f / sqrtf(wave_sum(v0 * v0 + v1 * v1 + v2 * v2 + v3 * v3) * (1.f / 256.f) + RMS_EPS);
          const f32x4 g4 = *(const f32x4*)(gq + 4 * lane);
          u32x2 o; o.x = cvt_pk_bf16(v0 * rq * g4.x, v1 * rq * g4.y); o.y = cvt_pk_bf16(v2 * rq * g4.z, v3 * rq * g4.w);
          *(u32x2*)(CQN + (size_t)m * 256 + 4 * lane) = o;
          const unsigned w2 = *(const unsigned*)(CR + (size_t)m * 384 + 256 + 2 * lane);
          const float u0 = bflo(w2), u1 = bfhi(w2);
          const float rk = 1.f / sqrtf(wave_sum(u0 * u0 + u1 * u1) * (1.f / 128.f) + RMS_EPS);
          const f32x2 g2 = *(const f32x2*)(gkv + 2 * lane);
          *(unsigned*)(CKVN + (size_t)m * 128 + 2 * lane) = cvt_pk_bf16(u0 * rk * g2.x, u1 * rk * g2.y);
        }
      } else if (even && k == 4) {
        na_attn_phase(big, (unsigned char*)ATT, INP(5) + (size_t)e * 8 * 15 * 31, gw, NGW, lane);
        mla_attn_phase(big, (unsigned char*)ATT, lds, bx, G, wave, lane);
      } else if (!even && (k == 2 || k == 4)) {
        dil_attn_phase(big, (unsigned char*)ATT, (k == 2) ? 0 : 1, bx, G, wave, lane, tid);
      } else {
        const int nsub = (even && k == 3) ? 2 : 1;
        for (int sub = 0; sub < nsub; ++sub) {
          pg8::Gemm g; pg8::StaticOrder S; EpiB E; E.ws = ws;
          g.M = M;
          E.base = (k == 5) ? xsrc : X; E.outf = X;
          if (k == 5) { g.A = ATT; g.Bt = (const bf16_t*)(ws + WS_W + W_O); g.N = DM; g.K = DM; E.kind = K_RESID; }
          else if (k == 8) { g.A = (const bf16_t*)big; g.Bt = (const bf16_t*)(ws + WS_W + W_2); g.N = DM; g.K = FF; E.kind = K_RESID; }
          else if (k == 7) { g.A = XN; g.Bt = (const bf16_t*)(ws + WS_W + W_1); g.N = FF; g.K = DM; E.kind = K_RELU2; }
          else if (even && k == 1) { g.A = XN; g.Bt = (const bf16_t*)(ws + WS_W + W_IN); g.N = EV_N; g.K = DM; E.kind = K_EVIN; }
          else if (even) {
            if (sub == 0) { g.A = (const bf16_t*)(big + B_CQN); g.Bt = (const bf16_t*)(ws + WS_W + W_UQ); g.N = 768; g.K = 256; E.kind = K_UQ; }
            else { g.A = (const bf16_t*)(big + B_CKVN); g.Bt = (const bf16_t*)(ws + WS_W + W_UKV); g.N = 1024; g.K = 128; E.kind = K_UKV; }
          } else { const int ch = (k == 1) ? 0 : 1; g.A = XN; g.Bt = (const bf16_t*)(ws + WS_W + W_IN) + (size_t)ch * OD_NC * DM; g.N = OD_NC; g.K = DM; E.kind = K_ODIN; }
          S.init(M, g.N, G, bx);
          pg8::gemm_phase<EpiB>(lds, g, S, E);
        }
      }
    }
#ifdef ONE_LAUNCH
    if (ph + 1 < a.ph_hi) {
      if (ph == a.ph_lo) { grid.sync(); xbar = xcd_barrier_post((unsigned*)a.ws, (volatile LAS unsigned*)(lds + 131072 + 256)); }
      else xcd_barrier(xbar);
    }
#endif
  }
}

extern "C" void kernel_launch(void* const* d_in, const int* in_sizes, int n_in, void* d_out, int out_size, void* d_ws, size_t ws_size, hipStream_t stream) {
  static int grid = 0;
  if (!grid) {
    if (n_in != 15 || out_size != M * DM || ws_size < WS_END) { fprintf(stderr, "kernel_launch: unexpected sizes n_in %d out %d ws %zu (need %zu)\n", n_in, out_size, ws_size, (size_t)WS_END); grid = -1; return; }
    int dev = 0, cus = 0, per_cu = 0;
    (void)hipGetDevice(&dev);
    (void)hipDeviceGetAttribute(&cus, hipDeviceAttributeMultiprocessorCount, dev);
    (void)hipFuncSetAttribute((const void*)fwd, hipFuncAttributeMaxDynamicSharedMemorySize, LDS_BYTES);
    (void)hipOccupancyMaxActiveBlocksPerMultiprocessor(&per_cu, (const void*)fwd, 512, LDS_BYTES);
    if (per_cu < 1) per_cu = 1;
    grid = cus * per_cu;
  }
  if (grid < 0) return;
  Args a{};
  for (int i = 0; i < 15; ++i) a.in[i] = (const float*)d_in[i];
  a.out = (float*)d_out; a.ws = (unsigned char*)d_ws;
#ifndef ONE_LAUNCH
  for (int ph = 0; ph < NPH; ++ph) {
    a.ph_lo = ph; a.ph_hi = ph + 1;
    hipLaunchKernelGGL(fwd, dim3(grid), dim3(512), LDS_BYTES, stream, a);
  }
#else
  a.ph_lo = 0; a.ph_hi = NPH;
  void* args[] = {&a};
  hipError_t er = hipLaunchCooperativeKernel((const void*)fwd, dim3(grid), dim3(512), args, LDS_BYTES, stream);
  if (er != hipSuccess) fprintf(stderr, "cooperative launch failed: %s (grid %d)\n", hipGetErrorString(er), grid);
#endif
}
```

```cpp
#include <hip/hip_runtime.h>
#include <hip/hip_cooperative_groups.h>
#include <cstdio>
#include <cstdint>
namespace cg = cooperative_groups;
#define ONE_LAUNCH 1

#define LAS __attribute__((address_space(3)))
typedef unsigned short bf16_t;
typedef short bf16x8 __attribute__((ext_vector_type(8)));
typedef float f32x4 __attribute__((ext_vector_type(4)));
typedef float f32x2 __attribute__((ext_vector_type(2)));
typedef float f32x16 __attribute__((ext_vector_type(16)));
typedef unsigned u32x4 __attribute__((ext_vector_type(4)));
typedef unsigned u32x2 __attribute__((ext_vector_type(2)));

constexpr int M = 16384, SEQ = 8192, DM = 1024, FF = 4096;
constexpr int EV_N = 2048;
constexpr int OD_NC = 4608;
constexpr float LOG2E = 1.4426950408889634f;
constexpr float C_NA = 0.125f * LOG2E;
constexpr float C_MLA = 0.10206207261596575f * LOG2E;
constexpr float RMS_EPS = 1e-6f;
constexpr float NEG_BIG = -1e30f;

constexpr size_t MiB = 1u << 20;
constexpr size_t WS_COS64 = 1 * MiB, WS_SIN64 = 2 * MiB, WS_COS32 = 3 * MiB, WS_SIN32 = 3 * MiB + 512 * 1024;
constexpr size_t WS_W = 4 * MiB;
constexpr size_t W_IN = 0, W_O = 18 * MiB, W_1 = 20 * MiB, W_2 = 28 * MiB, W_UQ = 36 * MiB, W_UKV = 36 * MiB + 512 * 1024;
constexpr size_t WS_XN = 41 * MiB;
constexpr size_t WS_ATT = 73 * MiB;
constexpr size_t WS_BIG = 105 * MiB;
constexpr size_t B_QKNA = 0, B_VTNA = 32 * MiB, B_CQN = 60 * MiB, B_CKVN = 68 * MiB, B_KPE = 72 * MiB,
                 B_QMLA = 73 * MiB, B_KN = 97 * MiB, B_VTMLA = 113 * MiB;
constexpr size_t B_QK = 0, B_VT = 96 * MiB, B_LSE = 144 * MiB;
constexpr size_t WS_END = 255 * MiB;

constexpr int LDS_BYTES = 147456;
constexpr int NPH = 31;
constexpr size_t WS_SS_MIX = 252 * MiB, WS_SS_MLP = 253 * MiB, WS_SS_Q = 254 * MiB, WS_SS_KV = 254 * MiB + 512 * 1024;

__device__ const float INV64[32] = {
  1.000000000e+00f, 7.498942018e-01f, 5.623413324e-01f, 4.216965139e-01f, 3.162277639e-01f, 2.371373922e-01f, 1.778279394e-01f, 1.333521456e-01f,
  1.000000015e-01f, 7.498941571e-02f, 5.623412877e-02f, 4.216964915e-02f, 3.162277862e-02f, 2.371373586e-02f, 1.778279431e-02f, 1.333521493e-02f,
  9.999999776e-03f, 7.498942316e-03f, 5.623413250e-03f, 4.216964822e-03f, 3.162277862e-03f, 2.371373819e-03f, 1.778279431e-03f, 1.333521446e-03f,
  1.000000047e-03f, 7.498941850e-04f, 5.623413017e-04f, 4.216965463e-04f, 3.162277862e-04f, 2.371373848e-04f, 1.778279402e-04f, 1.333521504e-04f};

__device__ __forceinline__ unsigned cvt_pk_bf16(float lo, float hi) { unsigned r; asm volatile("v_cvt_pk_bf16_f32 %0, %1, %2" : "=v"(r) : "v"(lo), "v"(hi)); return r; }
__device__ __forceinline__ bf16_t f2bf(float f) { return (bf16_t)(cvt_pk_bf16(f, 0.f) & 0xffffu); }
__device__ __forceinline__ float bf2f(unsigned short h) { return __uint_as_float(((unsigned)h) << 16); }
__device__ __forceinline__ float bflo(unsigned w) { return __uint_as_float(w << 16); }
__device__ __forceinline__ float bfhi(unsigned w) { return __uint_as_float(w & 0xffff0000u); }
__device__ __forceinline__ int vtidx(int p) { return (p & ~12) | ((p & 4) << 1) | ((p & 8) >> 1); }
__device__ __forceinline__ float wave_sum(float v) {
#pragma unroll
  for (int o = 1; o < 64; o <<= 1) v += __shfl_xor(v, o);
  return v;
}
__device__ __forceinline__ void unpack8(const u32x4 w, float* f) {
  f[0] = bflo(w.x); f[1] = bfhi(w.x); f[2] = bflo(w.y); f[3] = bfhi(w.y); f[4] = bflo(w.z); f[5] = bfhi(w.z); f[6] = bflo(w.w); f[7] = bfhi(w.w);
}

namespace pg8 {
constexpr int BM = 256, BK = 64, HALF = 128, HTB = HALF * BK * 2, STAGE_BYTES = 8 * HTB, NXCD = 8, WGM = 8;
__host__ __device__ __forceinline__ int lds_byte(int r, int c) { const int st = (r >> 4) * 2 + (c >> 5), rr = r & 15, cc = c & 31, ob = rr * 64 + cc * 2; return st * 1024 + (ob ^ (((ob >> 9) & 1) << 5)); }
__host__ __device__ __forceinline__ void stage_rc(int b, int& R, int& C) { const int st = b / 1024, sb = b % 1024, swz = sb ^ (((sb >> 9) & 1) << 5); R = (st >> 1) * 16 + swz / 64; C = (st & 1) * 32 + (swz % 64) / 2; }
__host__ __device__ __forceinline__ int perm32(int rho) { const int n = rho >> 4, i = rho & 15; return 8 * (i >> 2) + 4 * n + (i & 3); }

struct Unit { int pm, pn; };
struct Gemm { const bf16_t* A; const bf16_t* Bt; int M, N, K; };
struct StaticOrder {
  int nM, nN, nwg, G, c;
  __device__ void init(int M_, int N_, int G_, int c_) { nM = M_ / BM; nN = N_ / BM; nwg = nM * nN; G = G_; c = c_; }
  __device__ bool next(int i, Unit& u) const {
    const long L = (long)i * G + c; if (L >= nwg) return false;
    int wgid = (int)L; { const int q = nwg / NXCD, r = nwg % NXCD, xcd = wgid % NXCD, off = wgid / NXCD; wgid = (xcd < r ? xcd * (q + 1) : r * (q + 1) + (xcd - r) * q) + off; }
    const int nig = WGM * nN, gid = wgid / nig, fm = gid * WGM, gsz = (nM - fm) < WGM ? (nM - fm) : WGM;
    u.pm = fm + ((wgid % nig) % gsz); u.pn = (wgid % nig) / gsz; return true;
  }
};

template <class Epi>
__device__ __forceinline__ void gemm_phase(LAS unsigned char* lds, const Gemm g, const StaticOrder& S, const Epi& E) {
  int tid = threadIdx.x; asm volatile("" : "+v"(tid));
  const int wid = __builtin_amdgcn_readfirstlane(tid >> 6), lane = tid & 63, wr = wid >> 2, wc = wid & 3, fr = lane & 15, fq = lane >> 4;
  constexpr bool PERM = true; const int K = g.K, nt = K / BK;
  unsigned voffA[2], voffB[2];
#pragma unroll
  for (int i = 0; i < 2; ++i) { int R, C; stage_rc(tid * 16 + i * 8192, R, C); const int Rb = PERM ? ((R & ~31) + perm32(R & 31)) : R;
    voffA[i] = (unsigned)(R * K + C) * 2u; voffB[i] = (unsigned)(Rb * K + C) * 2u; }
  const size_t kstep = (size_t)(BK * 2);
  const size_t hstep = (size_t)HALF * K * 2;
  const size_t tstep = 2 * hstep;
  const unsigned ldsw = (unsigned)wid * 1024u;
  const int aoff = lds_byte(wr * 64 + fr, fq * 8), boff = lds_byte(wc * 32 + fr, fq * 8);
#define PG8_SA(b, h) (((b) * 2 + (h)) * HTB)
#define PG8_SB(b, h) ((4 + (b) * 2 + (h)) * HTB)
#define PG8_STAGE(bufoff, gbase, voff) do { _Pragma("unroll") for (int _i = 0; _i < 2; ++_i) \
    __builtin_amdgcn_global_load_lds((const unsigned*)((const char*)(gbase) + (voff)[_i]), (LAS unsigned*)(lds + (bufoff) + ldsw + _i * 8192), 16, 0, 0); } while (0)
#define PG8_LDA(dst, b, h) do { _Pragma("unroll") for (int m = 0; m < 4; ++m) _Pragma("unroll") for (int k = 0; k < 2; ++k) dst[m][k] = *(const LAS bf16x8*)(lds + PG8_SA(b, h) + aoff + m * 2048 + k * 1024); } while (0)
#define PG8_LDB(dst, b, h) do { _Pragma("unroll") for (int n = 0; n < 2; ++n) _Pragma("unroll") for (int k = 0; k < 2; ++k) dst[n][k] = *(const LAS bf16x8*)(lds + PG8_SB(b, h) + boff + n * 2048 + k * 1024); } while (0)
#define PG8_MMA(ai, bj, At, Bt) do { __builtin_amdgcn_s_setprio(1); _Pragma("unroll") for (int m = 0; m < 4; ++m) _Pragma("unroll") for (int n = 0; n < 2; ++n) _Pragma("unroll") for (int k = 0; k < 2; ++k) \
    acc[ai][bj][m][n] = __builtin_amdgcn_mfma_f32_16x16x32_bf16(Bt[n][k], At[m][k], acc[ai][bj][m][n], 0, 0, 0); __builtin_amdgcn_s_setprio(0); } while (0)
#define PG8_WAIT_V(n) asm volatile("s_waitcnt vmcnt(" #n ")" ::: "memory")
#define PG8_WAIT_L(n) asm volatile("s_waitcnt lgkmcnt(" #n ")" ::: "memory")
#define PG8_BAR __builtin_amdgcn_s_barrier()
#define PG8_SCHED __builtin_amdgcn_sched_barrier(0)
  Unit cur, nxt; int ui = 0;
  if (!S.next(0, cur)) return;
  f32x4 acc[2][2][4][2];
#pragma unroll
  for (int a = 0; a < 2; ++a)
#pragma unroll
    for (int b = 0; b < 2; ++b)
#pragma unroll
      for (int m = 0; m < 4; ++m)
#pragma unroll
        for (int n = 0; n < 2; ++n) acc[a][b][m][n] = (f32x4){0.f, 0.f, 0.f, 0.f};
  bf16x8 At[4][2], B0[2][2], B1[2][2];
  const char* cA = (const char*)g.A + (size_t)cur.pm * tstep; const char* cB = (const char*)g.Bt + (size_t)cur.pn * tstep;
  PG8_STAGE(PG8_SB(0, 0), cB, voffB); PG8_STAGE(PG8_SB(0, 1), cB + hstep, voffB); PG8_STAGE(PG8_SA(0, 0), cA, voffA); PG8_STAGE(PG8_SA(0, 1), cA + hstep, voffA);
  if (wr == 1) PG8_BAR;
  PG8_WAIT_V(2); PG8_BAR;
  PG8_STAGE(PG8_SB(1, 0), cB + kstep, voffB); PG8_STAGE(PG8_SA(1, 0), cA + kstep, voffA); PG8_STAGE(PG8_SB(1, 1), cB + hstep + kstep, voffB);
  PG8_WAIT_V(6); PG8_BAR;
  for (;;) {
    const bool has_next = S.next(ui + 1, nxt);
    const char* nA = has_next ? (const char*)g.A + (size_t)nxt.pm * tstep : cA; const char* nB = has_next ? (const char*)g.Bt + (size_t)nxt.pn * tstep : cB;
    for (int t = 0; t < nt; t += 2) {
      const bool last = (t == nt - 2);
      const char* a1 = cA + (size_t)(t + 1) * kstep;
      const char* a2 = last ? nA : cA + (size_t)(t + 2) * kstep; const char* b2 = last ? nB : cB + (size_t)(t + 2) * kstep;
      const char* a3 = a2 + kstep; const char* b3 = b2 + kstep;
      PG8_LDB(B0, 0, 0); PG8_LDB(B1, 0, 1); PG8_SCHED; PG8_LDA(At, 0, 0); PG8_STAGE(PG8_SA(1, 1), a1 + hstep, voffA);
      PG8_WAIT_V(8); PG8_WAIT_L(0); PG8_BAR; PG8_MMA(0, 0, At, B0); PG8_MMA(0, 1, At, B1); PG8_BAR; PG8_SCHED;
      PG8_LDA(At, 0, 1); PG8_STAGE(PG8_SB(0, 0), b2, voffB); PG8_STAGE(PG8_SB(0, 1), b2 + hstep, voffB); PG8_STAGE(PG8_SA(0, 0), a2, voffA);
      PG8_WAIT_V(8); PG8_WAIT_L(0); PG8_BAR; PG8_MMA(1, 0, At, B0); PG8_MMA(1, 1, At, B1); PG8_BAR; PG8_SCHED;
      PG8_LDB(B0, 1, 0); PG8_LDB(B1, 1, 1); PG8_SCHED; PG8_LDA(At, 1, 0); PG8_STAGE(PG8_SA(0, 1), a2 + hstep, voffA);
      PG8_WAIT_V(8); PG8_WAIT_L(0); PG8_BAR; PG8_MMA(0, 0, At, B0); PG8_MMA(0, 1, At, B1); PG8_BAR; PG8_SCHED;
      PG8_LDA(At, 1, 1); PG8_STAGE(PG8_SB(1, 0), b3, voffB); PG8_STAGE(PG8_SB(1, 1), b3 + hstep, voffB); PG8_STAGE(PG8_SA(1, 0), a3, voffA);
      PG8_WAIT_V(8); PG8_WAIT_L(0); PG8_BAR; PG8_MMA(1, 0, At, B0); PG8_MMA(1, 1, At, B1); PG8_BAR; PG8_SCHED;
    }
    if (wr == 0) PG8_BAR;
    E(acc, cur, wr, wc, fr, fq);
    if (!has_next) break;
#pragma unroll
    for (int a = 0; a < 2; ++a)
#pragma unroll
      for (int b = 0; b < 2; ++b)
#pragma unroll
        for (int m = 0; m < 4; ++m)
#pragma unroll
          for (int n = 0; n < 2; ++n) acc[a][b][m][n] = (f32x4){0.f, 0.f, 0.f, 0.f};
    cur = nxt; cA = nA; cB = nB; ++ui;
    if (wr == 1) PG8_BAR;
  }
  PG8_WAIT_V(0);
  PG8_BAR;
#undef PG8_SA
#undef PG8_SB
#undef PG8_STAGE
#undef PG8_LDA
#undef PG8_LDB
#undef PG8_MMA
#undef PG8_WAIT_V
#undef PG8_WAIT_L
#undef PG8_BAR
#undef PG8_SCHED
}
}

enum EpiKind { K_EVIN = 0, K_UQ = 1, K_UKV = 2, K_ODIN = 3, K_RELU2 = 4, K_RESID = 5 };
struct EpiB {
  int kind;
  unsigned char* ws;
  const float* base; float* outf;
  const float* ss_in; float* ss_out;
  __device__ __forceinline__ void store8(unsigned char* b, unsigned off, f32x4 v0, f32x4 v1) const {
    u32x4 w; w.x = cvt_pk_bf16(v0[0], v0[1]); w.y = cvt_pk_bf16(v0[2], v0[3]); w.z = cvt_pk_bf16(v1[0], v1[1]); w.w = cvt_pk_bf16(v1[2], v1[3]);
    *(u32x4*)(b + off) = w;
  }
  __device__ __forceinline__ void rope8(f32x4& v0, f32x4& v1, const float* ct, const float* st, unsigned toff) const {
    const f32x4 c = *(const f32x4*)((const char*)ct + toff), s = *(const f32x4*)((const char*)st + toff);
    f32x4 a0, a1;
    a0[0] = v0[0] * c[0] - v0[1] * s[0]; a0[1] = v0[1] * c[0] + v0[0] * s[0];
    a0[2] = v0[2] * c[1] - v0[3] * s[1]; a0[3] = v0[3] * c[1] + v0[2] * s[1];
    a1[0] = v1[0] * c[2] - v1[1] * s[2]; a1[1] = v1[1] * c[2] + v1[0] * s[2];
    a1[2] = v1[2] * c[3] - v1[3] * s[3]; a1[3] = v1[3] * c[3] + v1[2] * s[3];
    v0 = a0; v1 = a1;
  }
  __device__ __forceinline__ void vt8(unsigned char* vt, unsigned off, f32x4 v0, f32x4 v1) const {
    *(bf16_t*)(vt + off + 0 * SEQ * 2) = f2bf(v0[0]); *(bf16_t*)(vt + off + 1 * SEQ * 2) = f2bf(v0[1]); *(bf16_t*)(vt + off + 2 * SEQ * 2) = f2bf(v0[2]); *(bf16_t*)(vt + off + 3 * SEQ * 2) = f2bf(v0[3]);
    *(bf16_t*)(vt + off + 4 * SEQ * 2) = f2bf(v1[0]); *(bf16_t*)(vt + off + 5 * SEQ * 2) = f2bf(v1[1]); *(bf16_t*)(vt + off + 6 * SEQ * 2) = f2bf(v1[2]); *(bf16_t*)(vt + off + 7 * SEQ * 2) = f2bf(v1[3]);
  }
  __device__ __forceinline__ void operator()(const f32x4 (&acc)[2][2][4][2], const pg8::Unit& u, int wr, int wc, int fr, int fq) const {
    const int pn = u.pn;
    unsigned char* const big = ws + WS_BIG;
    const float* const cos64 = (const float*)(ws + WS_COS64); const float* const sin64 = (const float*)(ws + WS_SIN64);
    const float* const cos32 = (const float*)(ws + WS_COS32); const float* const sin32 = (const float*)(ws + WS_SIN32);
#pragma unroll
    for (int ai = 0; ai < 2; ++ai)
#pragma unroll
      for (int m = 0; m < 4; ++m) {
        asm volatile("" ::: "memory");
        const unsigned row = u.pm * 256 + ai * 128 + wr * 64 + m * 16 + fr;
        const unsigned b = row >> 13, pos = row & (SEQ - 1);
        float rs = 1.f;
        if (kind == K_EVIN || kind == K_ODIN || kind == K_RELU2) {
          const f32x4* sp = (const f32x4*)((const char*)ss_in + row * 64u); const f32x4 p0 = sp[0], p1 = sp[1], p2 = sp[2], p3 = sp[3];
          const float t = (((p0[0] + p0[1]) + (p0[2] + p0[3])) + ((p1[0] + p1[1]) + (p1[2] + p1[3]))) + (((p2[0] + p2[1]) + (p2[2] + p2[3])) + ((p3[0] + p3[1]) + (p3[2] + p3[3])));
          rs = __builtin_amdgcn_rsqf(t * (1.f / DM) + RMS_EPS);
        } else if (kind == K_UQ) { const f32x4 p = *(const f32x4*)(ws + WS_SS_Q + row * 16u); rs = __builtin_amdgcn_rsqf(((p[0] + p[1]) + (p[2] + p[3])) * (1.f / 256.f) + RMS_EPS); }
        else if (kind == K_UKV) { const f32x4 p = *(const f32x4*)(ws + WS_SS_KV + row * 16u); rs = __builtin_amdgcn_rsqf(((p[0] + p[1]) + (p[2] + p[3])) * (1.f / 128.f) + RMS_EPS); }
        float part = 0.f;
#pragma unroll
        for (int bj = 0; bj < 2; ++bj) {
          const unsigned col = pn * 256 + bj * 128 + wc * 32 + 8 * fq;
          f32x4 v0 = acc[ai][bj][m][0] * rs, v1 = acc[ai][bj][m][1] * rs;
          if (kind == K_RESID) {
            const unsigned o = (row * DM + col) * 4u;
            v0 += *(const f32x4*)((const char*)base + o); v1 += *(const f32x4*)((const char*)base + o + 16);
            *(f32x4*)((char*)outf + o) = v0; *(f32x4*)((char*)outf + o + 16) = v1;
            store8(ws + WS_XN, (row * DM + col) * 2u, v0, v1);
            part += (v0[0] * v0[0] + v0[1] * v0[1]) + (v0[2] * v0[2] + v0[3] * v0[3]) + (v1[0] * v1[0] + v1[1] * v1[1]) + (v1[2] * v1[2] + v1[3] * v1[3]);
          } else if (kind == K_RELU2) {
#pragma unroll
            for (int e = 0; e < 4; ++e) { float a = fmaxf(v0[e], 0.f), c = fmaxf(v1[e], 0.f); v0[e] = a * a; v1[e] = c * c; }
            store8(big, (row * FF + col) * 2u, v0, v1);
          } else if (kind == K_EVIN) {
            if (pn < 4) { const float sc = pn < 2 ? C_NA : 1.f; store8(big + B_QKNA, (row * 1024 + col) * 2u, v0 * sc, v1 * sc); }
            else if (pn < 6) { vt8(big + B_VTNA, ((b * 512 + (col - 1024)) * SEQ + vtidx(pos)) * 2u, v0, v1); }
            else if (pn == 6) { store8(big + B_CQN, (row * 256 + (col - 1536)) * 2u, v0, v1);
              part += (v0[0] * v0[0] + v0[1] * v0[1]) + (v0[2] * v0[2] + v0[3] * v0[3]) + (v1[0] * v1[0] + v1[1] * v1[1]) + (v1[2] * v1[2] + v1[3] * v1[3]); }
            else {
              if (bj == 0) { store8(big + B_CKVN, (row * 128 + (col - 1792)) * 2u, v0, v1);
                part += (v0[0] * v0[0] + v0[1] * v0[1]) + (v0[2] * v0[2] + v0[3] * v0[3]) + (v1[0] * v1[0] + v1[1] * v1[1]) + (v1[2] * v1[2] + v1[3] * v1[3]); }
              else if (wc == 0) { rope8(v0, v1, cos32, sin32, (pos * 16 + 4 * fq) * 4u); store8(big + B_KPE, (row * 32 + 8 * fq) * 2u, v0, v1); }
            }
          } else if (kind == K_UQ) {
            if (pn == 2) rope8(v0, v1, cos32, sin32, (pos * 16 + ((col & 31) >> 1)) * 4u);
            store8(big + B_QMLA, (row * 768 + col) * 2u, v0 * C_MLA, v1 * C_MLA);
          } else if (kind == K_UKV) {
            if (pn < 2) store8(big + B_KN, (row * 512 + col) * 2u, v0, v1);
            else vt8(big + B_VTMLA, ((b * 512 + (col - 512)) * SEQ + vtidx(pos)) * 2u, v0, v1);
          } else {
            const int s = pn >> 1;
            if (s < 6) {
              rope8(v0, v1, cos64, sin64, (pos * 32 + ((col & 63) >> 1)) * 4u);
              const float sc = (s & 1) ? 1.f : C_NA;
              store8(big + B_QK, (row * 3072 + col) * 2u, v0 * sc, v1 * sc);
            } else {
              const int gq = s - 6, sh = 2 * gq;
              const unsigned lidx = ((pos & ((1u << sh) - 1)) << (13 - sh)) | (pos >> sh);
              vt8(big + B_VT, (((b * 3 + gq) * 512 + (col - s * 512)) * SEQ + vtidx(lidx)) * 2u, v0, v1);
            }
          }
        }
        if (kind == K_RESID || (kind == K_EVIN && pn >= 6)) {
          part += __shfl_xor(part, 16); part += __shfl_xor(part, 32);
          if (fq == 0) {
            if (kind == K_RESID) ss_out[row * 16 + pn * 4 + wc] = part;
            else ((float*)(ws + (pn == 6 ? WS_SS_Q : WS_SS_KV)))[row * 4 + wc] = part;
          }
        }
      }
  }
};

enum ColMap { CM_ID = 0, CM_EVIN = 1, CM_UQ = 2, CM_UKV = 3, CM_ODIN = 4 };
__device__ __forceinline__ int colmap(int kind, int n) {
  switch (kind) {
    case CM_EVIN: { if (n < 1920) return n; if (n >= 1952) return -1; const int j = n - 1920, k = j >> 1; return 1920 + ((j & 1) ? k + 16 : k); }
    case CM_UQ: { if (n < 512) return (n >> 6) * 96 + (n & 63); const int h = (n - 512) >> 5, j = (n - 512) & 31, k = j >> 1; return h * 96 + 64 + ((j & 1) ? k + 16 : k); }
    case CM_UKV: { if (n < 512) return (n >> 6) * 128 + (n & 63); const int n2 = n - 512; return (n2 >> 6) * 128 + 64 + (n2 & 63); }
    case CM_ODIN: { const int ch = n / OD_NC, n1 = n - ch * OD_NC, s = n1 >> 9, hl = (n1 & 511) >> 6, j = n1 & 63;
      int gq, t, js; if (s < 6) { gq = s >> 1; t = s & 1; const int k = j >> 1; js = (j & 1) ? k + 32 : k; } else { gq = s - 6; t = 2; js = j; }
      return ((gq * 3 + t) * 16 + (8 * ch + hl)) * 64 + js; }
    default: return n;
  }
}
__device__ __forceinline__ void transpose_item(const float* W, int K, int Nsrc, int Nout, bf16_t* WT, int cm, LAS float* scr, int item, int lane, const float* gain) {
  const int nblk = Nout / 32, kb = item / nblk, nb = item % nblk, k0 = 64 * kb, n0 = 32 * nb;
  const int sc = colmap(cm, n0 + (lane & 31));
#pragma unroll 8
  for (int i = 0; i < 32; ++i) { const int kk = 2 * i + (lane >> 5); const float gk = gain ? gain[k0 + kk] : 1.f; scr[kk * 33 + (lane & 31)] = sc >= 0 ? W[(size_t)(k0 + kk) * Nsrc + sc] * gk : 0.f; }
  asm volatile("s_waitcnt lgkmcnt(0)" ::: "memory");
  const int c = lane & 7;
#pragma unroll
  for (int j = 0; j < 4; ++j) { const int n = (lane >> 3) + 8 * j; const LAS float* s = scr + (8 * c) * 33 + n;
    u32x4 o; o.x = cvt_pk_bf16(s[0 * 33], s[1 * 33]); o.y = cvt_pk_bf16(s[2 * 33], s[3 * 33]); o.z = cvt_pk_bf16(s[4 * 33], s[5 * 33]); o.w = cvt_pk_bf16(s[6 * 33], s[7 * 33]);
    *(u32x4*)(WT + (size_t)(n0 + n) * K + k0 + 8 * c) = o; }
  asm volatile("s_waitcnt lgkmcnt(0)" ::: "memory");
}
__device__ __forceinline__ void rms_row_bf16(const float* xrow, const float* g, bf16_t* orow, int lane) {
  const f32x4* xr = (const f32x4*)xrow + lane; const f32x4* gr = (const f32x4*)g + lane;
  f32x4 v[4]; float s = 0.f;
#pragma unroll
  for (int j = 0; j < 4; ++j) { v[j] = xr[64 * j]; s += (v[j].x * v[j].x + v[j].y * v[j].y) + (v[j].z * v[j].z + v[j].w * v[j].w); }
  const float rstd = 1.f / sqrtf(wave_sum(s) * (1.f / DM) + RMS_EPS);
  u32x2* o8 = (u32x2*)orow + lane;
#pragma unroll
  for (int j = 0; j < 4; ++j) { const f32x4 gg = gr[64 * j]; u32x2 w; w.x = cvt_pk_bf16(v[j].x * rstd * gg.x, v[j].y * rstd * gg.y); w.y = cvt_pk_bf16(v[j].z * rstd * gg.z, v[j].w * rstd * gg.w); o8[64 * j] = w; }
}
__device__ __forceinline__ void rms_row_f32(const float* xrow, const float* g, float* orow, int lane) {
  const f32x4* xr = (const f32x4*)xrow + lane; const f32x4* gr = (const f32x4*)g + lane;
  f32x4 v[4]; float s = 0.f;
#pragma unroll
  for (int j = 0; j < 4; ++j) { v[j] = xr[64 * j]; s += (v[j].x * v[j].x + v[j].y * v[j].y) + (v[j].z * v[j].z + v[j].w * v[j].w); }
  const float rstd = 1.f / sqrtf(wave_sum(s) * (1.f / DM) + RMS_EPS);
  f32x4* o = (f32x4*)orow + lane;
#pragma unroll
  for (int j = 0; j < 4; ++j) { const f32x4 gg = gr[64 * j]; o[64 * j] = v[j] * rstd * gg; }
}
__device__ __forceinline__ void sincos_acc(float angf, float& sn, float& cs) {
  const double x = (double)angf;
  const double n = __builtin_rint(x * 0.63661977236758134308);
  double r = __builtin_fma(-n, 1.57079632679489655800e+00, x); r = __builtin_fma(-n, 6.12323399573676603587e-17, r);
  const double r2 = r * r;
  double sp = 1.0 / 6227020800.0; sp = sp * r2 - 1.0 / 39916800.0; sp = sp * r2 + 1.0 / 362880.0; sp = sp * r2 - 1.0 / 5040.0; sp = sp * r2 + 1.0 / 120.0; sp = sp * r2 - 1.0 / 6.0; sp = sp * r2 + 1.0; sp *= r;
  double cp = -1.0 / 87178291200.0; cp = cp * r2 + 1.0 / 479001600.0; cp = cp * r2 - 1.0 / 3628800.0; cp = cp * r2 + 1.0 / 40320.0; cp = cp * r2 - 1.0 / 720.0; cp = cp * r2 + 1.0 / 24.0; cp = cp * r2 - 0.5; cp = cp * r2 + 1.0;
  const int q = ((int)(long long)n) & 3;
  const double s_ = (q & 1) ? cp : sp, c_ = (q & 1) ? sp : cp;
  sn = (float)((q & 2) ? -s_ : s_);
  cs = (float)(((q + 1) & 2) ? -c_ : c_);
}

__device__ __forceinline__ int crow(int r, int hi) { return (r & 3) + 8 * (r >> 2) + 4 * hi; }
__device__ __forceinline__ float half_max(float m) { auto rr = __builtin_amdgcn_permlane32_swap(__float_as_uint(m), __float_as_uint(m), false, false); return fmaxf(__uint_as_float(rr[0]), __uint_as_float(rr[1])); }
__device__ __forceinline__ float half_sum(float m) { auto rr = __builtin_amdgcn_permlane32_swap(__float_as_uint(m), __float_as_uint(m), false, false); return __uint_as_float(rr[0]) + __uint_as_float(rr[1]); }
__device__ __forceinline__ bf16x8 ldg8(const unsigned char* base, unsigned off) { return *(const bf16x8*)(base + off); }
__device__ __forceinline__ void softmax_pv(f32x16& s, const bf16x8 (&vf)[4], f32x16& o0, f32x16& o1, float& mrun, float& lrun) {
  float mx = fmaxf(s[0], s[1]);
#pragma unroll
  for (int r = 2; r < 16; ++r) mx = fmaxf(mx, s[r]);
  mx = half_max(mx);
  const float mnew = fmaxf(mrun, mx), alpha = __builtin_amdgcn_exp2f(mrun - mnew); mrun = mnew;
  float ls = 0.f;
#pragma unroll
  for (int r = 0; r < 16; ++r) { s[r] = __builtin_amdgcn_exp2f(s[r] - mnew); ls += s[r]; }
  lrun = lrun * alpha + ls;
  if (__builtin_amdgcn_ballot_w64(alpha != 1.f) != 0ull) {
#pragma unroll
    for (int r = 0; r < 16; ++r) { o0[r] *= alpha; o1[r] *= alpha; }
  }
  u32x4 w0, w1;
  w0.x = cvt_pk_bf16(s[0], s[1]); w0.y = cvt_pk_bf16(s[2], s[3]); w0.z = cvt_pk_bf16(s[4], s[5]); w0.w = cvt_pk_bf16(s[6], s[7]);
  w1.x = cvt_pk_bf16(s[8], s[9]); w1.y = cvt_pk_bf16(s[10], s[11]); w1.z = cvt_pk_bf16(s[12], s[13]); w1.w = cvt_pk_bf16(s[14], s[15]);
  const bf16x8 p0 = __builtin_bit_cast(bf16x8, w0), p1 = __builtin_bit_cast(bf16x8, w1);
  o0 = __builtin_amdgcn_mfma_f32_32x32x16_bf16(vf[0], p0, o0, 0, 0, 0); o0 = __builtin_amdgcn_mfma_f32_32x32x16_bf16(vf[1], p1, o0, 0, 0, 0);
  o1 = __builtin_amdgcn_mfma_f32_32x32x16_bf16(vf[2], p0, o1, 0, 0, 0); o1 = __builtin_amdgcn_mfma_f32_32x32x16_bf16(vf[3], p1, o1, 0, 0, 0);
}
__device__ __forceinline__ void store_ot(unsigned char* base, unsigned rowoff, const f32x16& o0, const f32x16& o1, float il, int hi) {
#pragma unroll
  for (int a = 0; a < 4; ++a) {
    u32x2 w; w.x = cvt_pk_bf16(o0[4 * a] * il, o0[4 * a + 1] * il); w.y = cvt_pk_bf16(o0[4 * a + 2] * il, o0[4 * a + 3] * il);
    *(u32x2*)(base + rowoff + (8 * a + 4 * hi) * 2) = w;
    u32x2 v; v.x = cvt_pk_bf16(o1[4 * a] * il, o1[4 * a + 1] * il); v.y = cvt_pk_bf16(o1[4 * a + 2] * il, o1[4 * a + 3] * il);
    *(u32x2*)(base + rowoff + (32 + 8 * a + 4 * hi) * 2) = v;
  }
}

constexpr int MLA_STEP_BYTES = 40960, MLA_NSTEP = SEQ / 128;
__device__ __forceinline__ void mla_attn_phase(unsigned char* big, unsigned char* att, LAS unsigned char* lds, int bx, int G, int wave, int lane) {
  const int r32 = lane & 31, hi = lane >> 5;
  for (int u = bx; u < 512; u += G) {
    const int bh = u >> 5, qb = u & 31, b = bh >> 3, h = bh & 7;
    const unsigned m0 = b * SEQ + qb * 256 + wave * 32 + r32;
    bf16x8 qf[6];
#pragma unroll
    for (int c = 0; c < 4; ++c) qf[c] = ldg8(big + B_QMLA, (m0 * 768 + h * 64 + 16 * c + 8 * hi) * 2u);
#pragma unroll
    for (int c = 0; c < 2; ++c) qf[4 + c] = ldg8(big + B_QMLA, (m0 * 768 + 512 + h * 32 + 16 * c + 8 * hi) * 2u);
    const unsigned char* kn = big + B_KN + ((size_t)b * SEQ * 512 + h * 64) * 2;
    const unsigned char* kp = big + B_KPE + ((size_t)b * SEQ * 32) * 2;
    const unsigned char* vt = big + B_VTMLA + ((size_t)(b * 8 + h) * 64 * SEQ) * 2;
    const unsigned char* sbase[5]; unsigned sstride[5], loff[5];
#pragma unroll
    for (int i = 0; i < 5; ++i) {
      const int sl = wave * 5 + i, tt = sl / 10, f = sl % 10;
      if (f < 4) { sbase[i] = kn + (size_t)tt * (32 * 512 * 2); loff[i] = (r32 * 512 + 16 * f + 8 * hi) * 2u; sstride[i] = 128 * 512 * 2; }
      else if (f < 6) { sbase[i] = kp + (size_t)tt * (32 * 32 * 2); loff[i] = (r32 * 32 + 16 * (f - 4) + 8 * hi) * 2u; sstride[i] = 128 * 32 * 2; }
      else { const int d0 = (f - 6) >> 1, j = (f - 6) & 1; sbase[i] = vt + (size_t)tt * 64; loff[i] = ((d0 * 32 + r32) * SEQ + 16 * j + 8 * hi) * 2u; sstride[i] = 256; }
    }
#define MLA_ISSUE(st, rs) do { _Pragma("unroll") for (int i = 0; i < 5; ++i) \
      __builtin_amdgcn_global_load_lds((const unsigned*)(sbase[i] + (size_t)(st) * sstride[i] + loff[i]), (LAS unsigned*)(lds + (rs) * MLA_STEP_BYTES + (wave * 5 + i) * 1024), 16, 0, 0); } while (0)
#define MLA_FRAGS(KF, VF, base) do { \
      _Pragma("unroll") for (int c = 0; c < 6; ++c) KF[c] = *(const LAS bf16x8*)(lds + (base) + c * 1024 + lane * 16); \
      _Pragma("unroll") for (int c = 0; c < 4; ++c) VF[c] = *(const LAS bf16x8*)(lds + (base) + (6 + c) * 1024 + lane * 16); } while (0)
#define MLA_TILE(KF, VF) do { f32x16 s = {0.f, 0.f, 0.f, 0.f, 0.f, 0.f, 0.f, 0.f, 0.f, 0.f, 0.f, 0.f, 0.f, 0.f, 0.f, 0.f}; \
      _Pragma("unroll") for (int c = 0; c < 6; ++c) s = __builtin_amdgcn_mfma_f32_32x32x16_bf16(KF[c], qf[c], s, 0, 0, 0); \
      softmax_pv(s, VF, o0, o1, mrun, lrun); } while (0)
    f32x16 o0 = {0.f, 0.f, 0.f, 0.f, 0.f, 0.f, 0.f, 0.f, 0.f, 0.f, 0.f, 0.f, 0.f, 0.f, 0.f, 0.f}, o1 = o0;
    float mrun = NEG_BIG, lrun = 0.f;
    MLA_ISSUE(0, 0); MLA_ISSUE(1, 1);
    int rs = 0;
    for (int st = 0; st < MLA_NSTEP; ++st) {
      if (st + 1 < MLA_NSTEP) asm volatile("s_waitcnt vmcnt(5)" ::: "memory"); else asm volatile("s_waitcnt vmcnt(0)" ::: "memory");
      __builtin_amdgcn_s_barrier();
      asm volatile("" ::: "memory");
      if (st + 2 < MLA_NSTEP) { const int rn = (rs >= 1) ? rs - 1 : 2; MLA_ISSUE(st + 2, rn); }
      const int sb = rs * MLA_STEP_BYTES;
      bf16x8 kfa[6], vfa[4], kfb[6], vfb[4];
      MLA_FRAGS(kfa, vfa, sb);
      MLA_FRAGS(kfb, vfb, sb + 10240);
      MLA_TILE(kfa, vfa);
      MLA_FRAGS(kfa, vfa, sb + 20480);
      MLA_TILE(kfb, vfb);
      MLA_FRAGS(kfb, vfb, sb + 30720);
      MLA_TILE(kfa, vfa);
      MLA_TILE(kfb, vfb);
      asm volatile("s_waitcnt lgkmcnt(0)" ::: "memory");
      rs = (rs == 2) ? 0 : rs + 1;
    }
#undef MLA_ISSUE
#undef MLA_FRAGS
#undef MLA_TILE
    const float il = 1.f / half_sum(lrun);
    store_ot(att, (m0 * 1024 + 512 + h * 64) * 2u, o0, o1, il, hi);
    __builtin_amdgcn_s_barrier();
  }
}

__device__ __forceinline__ void na_attn_phase(unsigned char* big, unsigned char* att, const float* rpb, int gw, int NGW, int lane) {
  const int r32 = lane & 31, hi = lane >> 5;
  for (int wt = gw; wt < 4096; wt += NGW) {
    const int w = wt & 1, h = (wt >> 1) & 7, r = (wt >> 4) & 127, b = wt >> 11;
    const int rs = min(max(r - 4, 0), 120), c = 32 * w + r32, cs = min(max(c - 8, 0), 48);
    const unsigned m0 = b * SEQ + r * 64 + c;
    bf16x8 qf[4];
#pragma unroll
    for (int cc = 0; cc < 4; ++cc) qf[cc] = ldg8(big + B_QKNA, (m0 * 1024 + h * 64 + 16 * cc + 8 * hi) * 2u);
    const unsigned char* kb = big + B_QKNA + ((size_t)(b * SEQ + rs * 64) * 1024 + 512 + h * 64) * 2;
    const unsigned char* vt = big + B_VTNA + ((size_t)(b * 8 + h) * 64 * SEQ + rs * 64) * 2;
    const unsigned ko = (r32 * 1024 + 8 * hi) * 2u, vto = (r32 * SEQ + 8 * hi) * 2u;
    const float* bias_h = rpb + h * 15 * 31;
    f32x16 o0 = {0.f, 0.f, 0.f, 0.f, 0.f, 0.f, 0.f, 0.f, 0.f, 0.f, 0.f, 0.f, 0.f, 0.f, 0.f, 0.f}, o1 = o0;
    float mrun = NEG_BIG, lrun = 0.f;
    for (int t = 0; t < 16; ++t) {
      bf16x8 kf[4], vf[4];
#pragma unroll
      for (int cc = 0; cc < 4; ++cc) kf[cc] = ldg8(kb + (size_t)t * (32 * 1024 * 2), ko + 32 * cc);
#pragma unroll
      for (int d0 = 0; d0 < 2; ++d0)
#pragma unroll
        for (int j = 0; j < 2; ++j) vf[2 * d0 + j] = ldg8(vt + (size_t)t * 64, vto + d0 * (32 * SEQ * 2) + j * 32);
      f32x16 s = {0.f, 0.f, 0.f, 0.f, 0.f, 0.f, 0.f, 0.f, 0.f, 0.f, 0.f, 0.f, 0.f, 0.f, 0.f, 0.f};
#pragma unroll
      for (int cc = 0; cc < 4; ++cc) s = __builtin_amdgcn_mfma_f32_32x32x16_bf16(kf[cc], qf[cc], s, 0, 0, 0);
      const int kr = rs + (t >> 1);
      const float* brow = bias_h + (kr - r + 7) * 31;
#pragma unroll
      for (int rr = 0; rr < 16; ++rr) {
        const int kc = 32 * (t & 1) + crow(rr, hi), rel = kc - c + 15;
        const bool ok = (kc >= cs) && (kc < cs + 16);
        const float bv = brow[min(max(rel, 0), 30)];
        s[rr] = ok ? s[rr] + bv * LOG2E : NEG_BIG;
      }
      softmax_pv(s, vf, o0, o1, mrun, lrun);
    }
    const float il = 1.f / half_sum(lrun);
    store_ot(att, (m0 * 1024 + h * 64) * 2u, o0, o1, il, hi);
  }
}

struct DilWT { unsigned mq; int gq, sh, rho, i0, nseq; const unsigned char* vt; };
__device__ __forceinline__ DilWT dil_wt(int wt, int b, int hl, int P0, int r32, const unsigned char* big) {
  DilWT w; w.gq = wt >> 4; const int j = wt & 15; w.sh = 2 * w.gq;
  w.rho = (w.gq == 0) ? 0 : (w.gq == 1) ? (j >> 2) : j; const int it = (w.gq == 0) ? j : (w.gq == 1) ? (j & 3) : 0;
  w.i0 = (P0 >> w.sh) + 32 * it; w.nseq = SEQ >> w.sh;
  w.mq = b * SEQ + ((w.i0 + r32) << w.sh) + w.rho;
  w.vt = big + B_VT + ((size_t)((b * 3 + w.gq) * 8 + hl) * 64 * SEQ + w.rho * w.nseq) * 2;
  return w;
}
__device__ __forceinline__ void dil_attn_phase(unsigned char* big, unsigned char* att, int ch, int bx, int G, int wave, int lane, int tid) {
  const int r32 = lane & 31, hi = lane >> 5;
  float* lse = (float*)(big + B_LSE);
  for (int u = bx; u < 256; u += G) {
    const int b = u >> 7, hl = (u >> 4) & 7, P0 = (u & 15) * 512;
    const unsigned vto = (r32 * SEQ + 8 * hi) * 2u;
    f32x16 o0, o1; float mrun, lrun;
    bf16x8 qx[4], qy[4], ka[4], va[4], kb[4], vb[4];
#define DIL_LOADQ(Q, W) do { _Pragma("unroll") for (int cc = 0; cc < 4; ++cc) Q[cc] = ldg8(big + B_QK, (W.mq * 3072 + W.gq * 1024 + hl * 64 + 16 * cc + 8 * hi) * 2u); } while (0)
#define DIL_LOAD(KF, VF, W, T) do { const int k0_ = W.i0 - 64 + 32 * (T), k0c_ = min(max(k0_, 0), W.nseq - 32); \
      const unsigned mk_ = b * SEQ + ((k0c_ + r32) << W.sh) + W.rho; \
      _Pragma("unroll") for (int cc = 0; cc < 4; ++cc) KF[cc] = ldg8(big + B_QK, (mk_ * 3072 + W.gq * 1024 + 512 + hl * 64 + 16 * cc + 8 * hi) * 2u); \
      _Pragma("unroll") for (int d0 = 0; d0 < 2; ++d0) _Pragma("unroll") for (int jj = 0; jj < 2; ++jj) VF[2 * d0 + jj] = ldg8(W.vt + (size_t)k0c_ * 2, vto + d0 * (32 * SEQ * 2) + jj * 32); } while (0)
#define DIL_COMP(KF, VF, Q, W, T) do { \
      if ((T) == 0) { _Pragma("unroll") for (int rr = 0; rr < 16; ++rr) { o0[rr] = 0.f; o1[rr] = 0.f; } mrun = NEG_BIG; lrun = 0.f; } \
      const int k0_ = W.i0 - 64 + 32 * (T); const bool tv_ = (k0_ >= 0) && (k0_ < W.nseq); \
      if (tv_) { \
      f32x16 s = {0.f, 0.f, 0.f, 0.f, 0.f, 0.f, 0.f, 0.f, 0.f, 0.f, 0.f, 0.f, 0.f, 0.f, 0.f, 0.f}; \
      _Pragma("unroll") for (int cc = 0; cc < 4; ++cc) s = __builtin_amdgcn_mfma_f32_32x32x16_bf16(KF[cc], Q[cc], s, 0, 0, 0); \
      _Pragma("unroll") for (int rr = 0; rr < 16; ++rr) { \
        const bool ok_ = ((T) == 0 ? (crow(rr, hi) >= r32) : (T) == 4 ? (crow(rr, hi) <= r32) : true); \
        s[rr] = ok_ ? s[rr] : NEG_BIG; } \
      softmax_pv(s, VF, o0, o1, mrun, lrun); } \
      if ((T) == 4) { const float lt_ = half_sum(lrun), il_ = 1.f / lt_; \
        store_ot(big + B_QK, (W.mq * 3072 + W.gq * 1024 + hl * 64) * 2u, o0, o1, il_, hi); \
        if (hi == 0) lse[(W.mq * 8 + hl) * 3 + W.gq] = mrun + __builtin_amdgcn_logf(lt_); } } while (0)
    DilWT WX = dil_wt(wave, b, hl, P0, r32, big), WY = WX;
    DIL_LOADQ(qx, WX); DIL_LOAD(ka, va, WX, 0);
    for (int pair = 0; pair < 3; ++pair) {
      WY = dil_wt(wave + 8 * (2 * pair + 1), b, hl, P0, r32, big);
      DIL_LOAD(kb, vb, WX, 1); DIL_COMP(ka, va, qx, WX, 0);
      DIL_LOAD(ka, va, WX, 2); DIL_COMP(kb, vb, qx, WX, 1);
      DIL_LOAD(kb, vb, WX, 3); DIL_COMP(ka, va, qx, WX, 2);
      DIL_LOAD(ka, va, WX, 4); DIL_COMP(kb, vb, qx, WX, 3);
      DIL_LOADQ(qy, WY); DIL_LOAD(kb, vb, WY, 0); DIL_COMP(ka, va, qx, WX, 4);
      DIL_LOAD(ka, va, WY, 1); DIL_COMP(kb, vb, qy, WY, 0);
      DIL_LOAD(kb, vb, WY, 2); DIL_COMP(ka, va, qy, WY, 1);
      DIL_LOAD(ka, va, WY, 3); DIL_COMP(kb, vb, qy, WY, 2);
      DIL_LOAD(kb, vb, WY, 4); DIL_COMP(ka, va, qy, WY, 3);
      if (pair < 2) { WX = dil_wt(wave + 8 * (2 * pair + 2), b, hl, P0, r32, big); DIL_LOADQ(qx, WX); DIL_LOAD(ka, va, WX, 0); }
      DIL_COMP(kb, vb, qy, WY, 4);
    }
#undef DIL_LOADQ
#undef DIL_LOAD
#undef DIL_COMP
    __syncthreads();
    {
      const unsigned m = b * SEQ + P0 + tid;
      const float l0 = lse[(m * 8 + hl) * 3 + 0], l1 = lse[(m * 8 + hl) * 3 + 1], l2 = lse[(m * 8 + hl) * 3 + 2];
      const float lm = fmaxf(l0, fmaxf(l1, l2));
      float w0 = __builtin_amdgcn_exp2f(l0 - lm), w1 = __builtin_amdgcn_exp2f(l1 - lm), w2 = __builtin_amdgcn_exp2f(l2 - lm);
      const float iw = 1.f / (w0 + w1 + w2); w0 *= iw; w1 *= iw; w2 *= iw;
#pragma unroll
      for (int jj = 0; jj < 8; ++jj) {
        float a0[8], a1[8], a2[8];
        unpack8(*(const u32x4*)(big + B_QK + ((size_t)m * 3072 + 0 * 1024 + hl * 64 + 8 * jj) * 2), a0);
        unpack8(*(const u32x4*)(big + B_QK + ((size_t)m * 3072 + 1 * 1024 + hl * 64 + 8 * jj) * 2), a1);
        unpack8(*(const u32x4*)(big + B_QK + ((size_t)m * 3072 + 2 * 1024 + hl * 64 + 8 * jj) * 2), a2);
        float f[8];
#pragma unroll
        for (int e = 0; e < 8; ++e) f[e] = w0 * a0[e] + w1 * a1[e] + w2 * a2[e];
        u32x4 wv; wv.x = cvt_pk_bf16(f[0], f[1]); wv.y = cvt_pk_bf16(f[2], f[3]); wv.z = cvt_pk_bf16(f[4], f[5]); wv.w = cvt_pk_bf16(f[6], f[7]);
        *(u32x4*)(att + ((size_t)m * 1024 + (8 * ch + hl) * 64 + 8 * jj) * 2) = wv;
      }
    }
    __syncthreads();
  }
}

#define XB_TMO      128
#define XB_XCNT(j)  (256  + 64 * (j))
#define XB_XSUB(j)  (1280 + 64 * (j))
#define XB_XGEN(j)  (2304 + 64 * (j))
#define XB_TOP      3328
#define XB_TOPGEN   3392
#define XCD_BAR_WORDS 3456
#define XB_SPIN_CAP (1u << 18)
__device__ __forceinline__ unsigned xb_ld(unsigned* p)              { return __hip_atomic_load(p, __ATOMIC_RELAXED, __HIP_MEMORY_SCOPE_AGENT); }
__device__ __forceinline__ unsigned xb_add(unsigned* p, unsigned v) { return __hip_atomic_fetch_add(p, v, __ATOMIC_RELAXED, __HIP_MEMORY_SCOPE_AGENT); }
__device__ __forceinline__ unsigned xb_xcc_id() { return (unsigned)__builtin_amdgcn_s_getreg((3 << 11) | 20) & 0xFu; }
#define XB_SPIN(cond, bar) do { unsigned _sp = 0; while (cond) { __builtin_amdgcn_s_sleep(1); \
    if ((++_sp & 255u) == 0u) { if (xb_ld(&(bar)[XB_TMO])) break; if (_sp > XB_SPIN_CAP) { atomicAdd(&(bar)[XB_TMO], 1u); break; } } } } while (0)
struct XcdBarrier { unsigned* bar; unsigned x; volatile LAS unsigned* st; };
__device__ __forceinline__ XcdBarrier xcd_barrier_post(unsigned* bar, volatile LAS unsigned* st) {
  XcdBarrier b; b.bar = bar; b.x = xb_xcc_id(); b.st = st;
  if (threadIdx.x == 0) (void)xb_add(&bar[XB_XCNT(b.x)], 1u);
  return b;
}
__device__ __forceinline__ void xcd_barrier_complete(unsigned* bar, unsigned x, unsigned& nloc, unsigned& nx) {
  const unsigned G = gridDim.x * gridDim.y * gridDim.z;
  unsigned sum, cnt, mine, sp = 0u;
  for (;;) {
    sum = 0u; cnt = 0u; mine = 0u;
#pragma unroll
    for (unsigned j = 0; j < 16; ++j) { const unsigned c = xb_ld(&bar[XB_XCNT(j)]); sum += c; cnt += (c > 0u) ? 1u : 0u; mine = (j == x) ? c : mine; }
    if (sum == G) break;
    __builtin_amdgcn_s_sleep(1);
    if ((++sp & 255u) == 0u) { if (xb_ld(&bar[XB_TMO])) break; if (sp > XB_SPIN_CAP) { atomicAdd(&bar[XB_TMO], 1u); break; } }
  }
  nloc = mine > 0u ? mine : 1u; nx = cnt > 0u ? cnt : 1u;
}
__device__ __forceinline__ void xcd_barrier(const XcdBarrier& b) {
  asm volatile("s_waitcnt vmcnt(0)" ::: "memory");
  __syncthreads();
  if (threadIdx.x == 0) {
    unsigned* bar = b.bar;
    __builtin_amdgcn_s_waitcnt(0);
    unsigned nloc = b.st[0], nx = b.st[1];
    if (nloc == 0u) { xcd_barrier_complete(bar, b.x, nloc, nx); b.st[0] = nloc; b.st[1] = nx; }
    const unsigned old = xb_add(&bar[XB_XSUB(b.x)], 1u);
    const unsigned gen = old / nloc;
    if (old + 1u == (gen + 1u) * nloc) {
      __builtin_amdgcn_fence(__ATOMIC_RELEASE, "agent");
      asm volatile("s_waitcnt vmcnt(0)" ::: "memory");
      const unsigned og = xb_add(&bar[XB_TOP], 1u);
      const unsigned tg = og / nx;
      if (og + 1u == (tg + 1u) * nx) xb_add(&bar[XB_TOPGEN], 1u);
      else XB_SPIN(xb_ld(&bar[XB_TOPGEN]) == tg, bar);
      __builtin_amdgcn_fence(__ATOMIC_ACQUIRE, "agent");
      xb_add(&bar[XB_XGEN(b.x)], 1u);
      asm volatile("s_waitcnt vmcnt(0)" ::: "memory");
    } else {
      XB_SPIN(xb_ld(&bar[XB_XGEN(b.x)]) == gen, bar);
      __builtin_amdgcn_fence(__ATOMIC_ACQUIRE, "agent");
      asm volatile("s_waitcnt vmcnt(0)" ::: "memory");
    }
  }
  __syncthreads();
}

__device__ __forceinline__ const void* ldptr(LAS unsigned char* lds, int i) {
  const volatile LAS unsigned* p = (const volatile LAS unsigned*)(lds + 131072) + 2 * i;
  const unsigned lo = __builtin_amdgcn_readfirstlane(p[0]), hi = __builtin_amdgcn_readfirstlane(p[1]);
  return (const void*)(((unsigned long long)hi << 32) | lo);
}
struct Args { const float* in[15]; float* out; unsigned char* ws; int ph_lo, ph_hi; };

__global__ void __launch_bounds__(512, 2) fwd(Args a) {
  extern __shared__ __attribute__((aligned(16))) unsigned char lds_raw[];
  LAS unsigned char* lds = (LAS unsigned char*)lds_raw;
  cg::grid_group grid = cg::this_grid();
  const int G = gridDim.x, bx = blockIdx.x;
  const int gsz = G * 512, NGW = G * 8;
  if (threadIdx.x < 15) ((LAS unsigned long long*)(lds + 131072))[threadIdx.x] = (unsigned long long)a.in[threadIdx.x];
  if (threadIdx.x == 15) ((LAS unsigned long long*)(lds + 131072))[15] = (unsigned long long)a.out;
  if (threadIdx.x == 16) ((LAS unsigned long long*)(lds + 131072))[16] = (unsigned long long)a.ws;
  if (threadIdx.x == 17) { ((LAS unsigned*)(lds + 131072 + 256))[0] = 0u; ((LAS unsigned*)(lds + 131072 + 256))[1] = 0u; }
  if (bx == 0) for (int i = threadIdx.x; i < XCD_BAR_WORDS; i += 512) ((unsigned*)a.ws)[i] = 0u;
  __syncthreads();
  XcdBarrier xbar; xbar.bar = (unsigned*)a.ws; xbar.x = 0; xbar.st = (volatile LAS unsigned*)(lds + 131072 + 256);
#define INP(i) ((const float*)ldptr(lds, (i)))

  if (a.ph_lo == 0) {
    const int gtid0 = bx * 512 + threadIdx.x;
    float* cos64 = (float*)(a.ws + WS_COS64); float* sin64 = (float*)(a.ws + WS_SIN64); float* cos32 = (float*)(a.ws + WS_COS32); float* sin32 = (float*)(a.ws + WS_SIN32);
    for (int i = gtid0; i < SEQ * 32; i += gsz) { const int pos = i >> 5, kk = i & 31; float sn, cs; sincos_acc((float)pos * INV64[kk], sn, cs); cos64[i] = cs; sin64[i] = sn; }
    for (int i = gtid0; i < SEQ * 16; i += gsz) { const int pos = i >> 4, kk = i & 15; float sn, cs; sincos_acc((float)pos * INV64[2 * kk], sn, cs); cos32[i] = cs; sin32[i] = sn; }
  }
#ifdef ONE_LAUNCH
  for (int ph = a.ph_lo; ph < a.ph_hi; ++ph) {
#else
  { const int ph = a.ph_lo;
#endif
    int tid = threadIdx.x; asm volatile("" : "+v"(tid));
    const int lane = tid & 63, wave = __builtin_amdgcn_readfirstlane(tid >> 6), gtid = bx * 512 + tid, gw = bx * 8 + wave;
    unsigned char* ws = a.ws;
    float* X = a.out;
    unsigned char* big = ws + WS_BIG;
    bf16_t* XN = (bf16_t*)(ws + WS_XN); bf16_t* ATT = (bf16_t*)(ws + WS_ATT);
    const float* cos64 = (const float*)(ws + WS_COS64); const float* sin64 = (const float*)(ws + WS_SIN64);
    const float* cos32 = (const float*)(ws + WS_COS32); const float* sin32 = (const float*)(ws + WS_SIN32);
    if (ph == NPH - 1) {
      for (int m = gw; m < M; m += NGW) rms_row_f32(X + (size_t)m * DM, INP(3), X + (size_t)m * DM, lane);
    } else {
      const int pp = ph >= 15 ? ph - 15 : ph, L = (ph >= 15 ? 2 : 0) + (pp >= 7 ? 1 : 0), idx = pp >= 7 ? pp - 7 : pp, e = L >> 1; const bool even = !(L & 1);
      const int k = even ? idx + (idx >= 2 ? 1 : 0) + (idx >= 5 ? 1 : 0) : idx + (idx >= 6 ? 1 : 0);
      const float* xsrc = (L == 0) ? INP(0) : X;
      float* ss_mix = (float*)(ws + WS_SS_MIX); float* ss_mlp = (float*)(ws + WS_SS_MLP);
      if (k == 0) {
        LAS float* scr = (LAS float*)(lds + wave * 16384);
        const float* w1 = INP(13) + (size_t)L * DM * FF; const float* w2 = INP(14) + (size_t)L * FF * DM;
        const float* wo = even ? INP(10) + (size_t)e * DM * DM : INP(12) + (size_t)e * DM * DM;
        const float* gmix = INP(1) + L * DM; const float* gmlp = INP(2) + L * DM;
        const int nin = even ? EV_N : 2 * OD_NC;
        const int I_IN = 16 * (nin / 32), I_O = 16 * 32, I_1 = 16 * 128, I_2 = 64 * 32, I_UQ = even ? 4 * 24 : 0, I_UKV = even ? 2 * 32 : 0;
        const int NIT = I_IN + I_O + I_1 + I_2 + I_UQ + I_UKV;
        for (int it = gw; it < NIT; it += NGW) {
          int r = it;
          if (r < I_IN) { if (even) transpose_item(INP(4) + (size_t)e * DM * 1952, DM, 1952, EV_N, (bf16_t*)(ws + WS_W + W_IN), CM_EVIN, scr, r, lane, gmix);
                          else transpose_item(INP(11) + (size_t)e * DM * 9216, DM, 9216, 2 * OD_NC, (bf16_t*)(ws + WS_W + W_IN), CM_ODIN, scr, r, lane, gmix); continue; } r -= I_IN;
          if (r < I_O) { transpose_item(wo, DM, DM, DM, (bf16_t*)(ws + WS_W + W_O), CM_ID, scr, r, lane, nullptr); continue; } r -= I_O;
          if (r < I_1) { transpose_item(w1, DM, FF, FF, (bf16_t*)(ws + WS_W + W_1), CM_ID, scr, r, lane, gmlp); continue; } r -= I_1;
          if (r < I_2) { transpose_item(w2, FF, DM, DM, (bf16_t*)(ws + WS_W + W_2), CM_ID, scr, r, lane, nullptr); continue; } r -= I_2;
          if (r < I_UQ) { transpose_item(INP(7) + (size_t)e * 256 * 768, 256, 768, 768, (bf16_t*)(ws + WS_W + W_UQ), CM_UQ, scr, r, lane, INP(6) + e * 256); continue; } r -= I_UQ;
          transpose_item(INP(9) + (size_t)e * 128 * 1024, 128, 1024, 1024, (bf16_t*)(ws + WS_W + W_UKV), CM_UKV, scr, r, lane, INP(8) + e * 128);
        }
        if (L == 0) {
          for (int m = gw; m < M; m += NGW) {
            const f32x4* xr = (const f32x4*)(xsrc + (size_t)m * DM) + lane; u32x2* o8 = (u32x2*)(XN + (size_t)m * DM) + lane; float s = 0.f;
#pragma unroll
            for (int j = 0; j < 4; ++j) { const f32x4 v = xr[64 * j]; s += (v.x * v.x + v.y * v.y) + (v.z * v.z + v.w * v.w); u32x2 w; w.x = cvt_pk_bf16(v.x, v.y); w.y = cvt_pk_bf16(v.z, v.w); o8[64 * j] = w; }
            s = wave_sum(s); if (lane < 16) ss_mix[m * 16 + lane] = (lane == 0) ? s : 0.f;
          }
        }
      } else if (even && k == 4) {
        na_attn_phase(big, (unsigned char*)ATT, INP(5) + (size_t)e * 8 * 15 * 31, gw, NGW, lane);
        mla_attn_phase(big, (unsigned char*)ATT, lds, bx, G, wave, lane);
      } else if (!even && (k == 2 || k == 4)) {
        dil_attn_phase(big, (unsigned char*)ATT, (k == 2) ? 0 : 1, bx, G, wave, lane, tid);
      } else {
        const int nsub = (even && k == 3) ? 2 : 1;
        for (int sub = 0; sub < nsub; ++sub) {
          pg8::Gemm g; pg8::StaticOrder S; EpiB E; E.ws = ws;
          g.M = M;
          E.base = (k == 5) ? xsrc : X; E.outf = X;
          E.ss_in = (k == 7) ? ss_mlp : ss_mix; E.ss_out = (k == 5) ? ss_mlp : ss_mix;
          if (k == 5) { g.A = ATT; g.Bt = (const bf16_t*)(ws + WS_W + W_O); g.N = DM; g.K = DM; E.kind = K_RESID; }
          else if (k == 8) { g.A = (const bf16_t*)big; g.Bt = (const bf16_t*)(ws + WS_W + W_2); g.N = DM; g.K = FF; E.kind = K_RESID; }
          else if (k == 7) { g.A = XN; g.Bt = (const bf16_t*)(ws + WS_W + W_1); g.N = FF; g.K = DM; E.kind = K_RELU2; }
          else if (even && k == 1) { g.A = XN; g.Bt = (const bf16_t*)(ws + WS_W + W_IN); g.N = EV_N; g.K = DM; E.kind = K_EVIN; }
          else if (even) {
            if (sub == 0) { g.A = (const bf16_t*)(big + B_CQN); g.Bt = (const bf16_t*)(ws + WS_W + W_UQ); g.N = 768; g.K = 256; E.kind = K_UQ; }
            else { g.A = (const bf16_t*)(big + B_CKVN); g.Bt = (const bf16_t*)(ws + WS_W + W_UKV); g.N = 1024; g.K = 128; E.kind = K_UKV; }
          } else { const int ch = (k == 1) ? 0 : 1; g.A = XN; g.Bt = (const bf16_t*)(ws + WS_W + W_IN) + (size_t)ch * OD_NC * DM; g.N = OD_NC; g.K = DM; E.kind = K_ODIN; }
          S.init(M, g.N, G, bx);
          pg8::gemm_phase<EpiB>(lds, g, S, E);
        }
      }
    }
#ifdef ONE_LAUNCH
    if (ph + 1 < a.ph_hi) {
      if (ph == a.ph_lo) { grid.sync(); xbar = xcd_barrier_post((unsigned*)a.ws, (volatile LAS unsigned*)(lds + 131072 + 256)); }
      else xcd_barrier(xbar);
    }
#endif
  }
}

extern "C" void kernel_launch(void* const* d_in, const int* in_sizes, int n_in, void* d_out, int out_size, void* d_ws, size_t ws_size, hipStream_t stream) {
  static int grid = 0;
  if (!grid) {
    if (n_in != 15 || out_size != M * DM || ws_size < WS_END) { fprintf(stderr, "kernel_launch: unexpected sizes n_in %d out %d ws %zu (need %zu)\n", n_in, out_size, ws_size, (size_t)WS_END); grid = -1; return; }
    int dev = 0, cus = 0, per_cu = 0;
    (void)hipGetDevice(&dev);
    (void)hipDeviceGetAttribute(&cus, hipDeviceAttributeMultiprocessorCount, dev);
    (void)hipFuncSetAttribute((const void*)fwd, hipFuncAttributeMaxDynamicSharedMemorySize, LDS_BYTES);
    (void)hipOccupancyMaxActiveBlocksPerMultiprocessor(&per_cu, (const void*)fwd, 512, LDS_BYTES);
    if (per_cu < 1) per_cu = 1;
    grid = cus * per_cu;
  }
  if (grid < 0) return;
  Args a{};
  for (int i = 0; i < 15; ++i) a.in[i] = (const float*)d_in[i];
  a.out = (float*)d_out; a.ws = (unsigned char*)d_ws;
#ifndef ONE_LAUNCH
  for (int ph = 0; ph < NPH; ++ph) {
    a.ph_lo = ph; a.ph_hi = ph + 1;
    hipLaunchKernelGGL(fwd, dim3(grid), dim3(512), LDS_BYTES, stream, a);
  }
#else
  a.ph_lo = 0; a.ph_hi = NPH;
  void* args[] = {&a};
  hipError_t er = hipLaunchCooperativeKernel((const void*)fwd, dim3(grid), dim3(512), args, LDS_BYTES, stream);
  if (er != hipSuccess) fprintf(stderr, "cooperative launch failed: %s (grid %d)\n", hipGetErrorString(er), grid);
#endif
}
```

```cpp
#include <hip/hip_runtime.h>
#include <hip/hip_cooperative_groups.h>
#include <cstdio>
#include <cstdint>
namespace cg = cooperative_groups;
#define ONE_LAUNCH 1

#define LAS __attribute__((address_space(3)))
typedef unsigned short bf16_t;
typedef short bf16x8 __attribute__((ext_vector_type(8)));
typedef float f32x4 __attribute__((ext_vector_type(4)));
typedef float f32x2 __attribute__((ext_vector_type(2)));
typedef float f32x16 __attribute__((ext_vector_type(16)));
typedef unsigned u32x4 __attribute__((ext_vector_type(4)));
typedef unsigned u32x2 __attribute__((ext_vector_type(2)));

constexpr int M = 16384, SEQ = 8192, DM = 1024, FF = 4096;
constexpr int EV_N = 2048;
constexpr int OD_NC = 4608;
constexpr float LOG2E = 1.4426950408889634f;
constexpr float C_NA = 0.125f * LOG2E;
constexpr float C_MLA = 0.10206207261596575f * LOG2E;
constexpr float RMS_EPS = 1e-6f;
constexpr float NEG_BIG = -1e30f;

constexpr size_t MiB = 1u << 20;
constexpr size_t WS_COS64 = 1 * MiB, WS_SIN64 = 2 * MiB, WS_COS32 = 3 * MiB, WS_SIN32 = 3 * MiB + 512 * 1024;
constexpr size_t WS_W = 4 * MiB;
constexpr size_t W_IN = 0, W_O = 18 * MiB, W_1 = 20 * MiB, W_2 = 28 * MiB, W_UQ = 36 * MiB, W_UKV = 36 * MiB + 512 * 1024;
constexpr size_t WS_XN = 41 * MiB;
constexpr size_t WS_ATT = 73 * MiB;
constexpr size_t WS_BIG = 105 * MiB;
constexpr size_t B_QKNA = 0, B_VTNA = 32 * MiB, B_CQN = 60 * MiB, B_CKVN = 68 * MiB, B_KPE = 72 * MiB,
                 B_QMLA = 73 * MiB, B_KN = 97 * MiB, B_VTMLA = 113 * MiB;
constexpr size_t B_QK = 0, B_VT = 96 * MiB, B_LSE = 144 * MiB;
constexpr size_t WS_END = 255 * MiB;

constexpr int LDS_BYTES = 151552;
constexpr int LDS_VT_OFF = 131072 + 1024, LDS_VT_WAVE = 2304;
constexpr int NPH = 31;
constexpr size_t WS_SS_MIX = 252 * MiB, WS_SS_MLP = 253 * MiB, WS_SS_Q = 254 * MiB, WS_SS_KV = 254 * MiB + 512 * 1024;

__device__ const float INV64[32] = {
  1.000000000e+00f, 7.498942018e-01f, 5.623413324e-01f, 4.216965139e-01f, 3.162277639e-01f, 2.371373922e-01f, 1.778279394e-01f, 1.333521456e-01f,
  1.000000015e-01f, 7.498941571e-02f, 5.623412877e-02f, 4.216964915e-02f, 3.162277862e-02f, 2.371373586e-02f, 1.778279431e-02f, 1.333521493e-02f,
  9.999999776e-03f, 7.498942316e-03f, 5.623413250e-03f, 4.216964822e-03f, 3.162277862e-03f, 2.371373819e-03f, 1.778279431e-03f, 1.333521446e-03f,
  1.000000047e-03f, 7.498941850e-04f, 5.623413017e-04f, 4.216965463e-04f, 3.162277862e-04f, 2.371373848e-04f, 1.778279402e-04f, 1.333521504e-04f};

typedef __bf16 bf16x2_t __attribute__((ext_vector_type(2)));
__device__ __forceinline__ unsigned cvt_pk_bf16(float lo, float hi) { const f32x2 v = {lo, hi}; const bf16x2_t b = __builtin_convertvector(v, bf16x2_t); return __builtin_bit_cast(unsigned, b); }
__device__ __forceinline__ bf16_t f2bf(float f) { return (bf16_t)(cvt_pk_bf16(f, 0.f) & 0xffffu); }
__device__ __forceinline__ float bf2f(unsigned short h) { return __uint_as_float(((unsigned)h) << 16); }
__device__ __forceinline__ float bflo(unsigned w) { return __uint_as_float(w << 16); }
__device__ __forceinline__ float bfhi(unsigned w) { return __uint_as_float(w & 0xffff0000u); }
__device__ __forceinline__ int vtidx(int p) { return (p & ~12) | ((p & 4) << 1) | ((p & 8) >> 1); }
__device__ __forceinline__ float wave_sum(float v) {
#pragma unroll
  for (int o = 1; o < 64; o <<= 1) v += __shfl_xor(v, o);
  return v;
}
__device__ __forceinline__ void unpack8(const u32x4 w, float* f) {
  f[0] = bflo(w.x); f[1] = bfhi(w.x); f[2] = bflo(w.y); f[3] = bfhi(w.y); f[4] = bflo(w.z); f[5] = bfhi(w.z); f[6] = bflo(w.w); f[7] = bfhi(w.w);
}

namespace pg8 {
constexpr int BM = 256, BK = 64, HALF = 128, HTB = HALF * BK * 2, STAGE_BYTES = 8 * HTB, NXCD = 8, WGM = 4;
__host__ __device__ __forceinline__ int lds_byte(int r, int c) { const int st = (r >> 4) * 2 + (c >> 5), rr = r & 15, cc = c & 31, ob = rr * 64 + cc * 2; return st * 1024 + (ob ^ (((ob >> 9) & 1) << 5)); }
__host__ __device__ __forceinline__ void stage_rc(int b, int& R, int& C) { const int st = b / 1024, sb = b % 1024, swz = sb ^ (((sb >> 9) & 1) << 5); R = (st >> 1) * 16 + swz / 64; C = (st & 1) * 32 + (swz % 64) / 2; }
__host__ __device__ __forceinline__ int perm32(int rho) { const int n = rho >> 4, i = rho & 15; return 8 * (i >> 2) + 4 * n + (i & 3); }

struct Unit { int pm, pn; };
struct Gemm { const bf16_t* A; const bf16_t* Bt; int M, N, K; };
struct StaticOrder {
  int nM, nN, nwg, G, c;
  __device__ void init(int M_, int N_, int G_, int c_) { nM = M_ / BM; nN = N_ / BM; nwg = nM * nN; G = G_; c = c_; }
  __device__ bool next(int i, Unit& u) const {
    const long L = (long)i * G + c; if (L >= nwg) return false;
    int wgid = (int)L; { const int q = nwg / NXCD, r = nwg % NXCD, xcd = wgid % NXCD, off = wgid / NXCD; wgid = (xcd < r ? xcd * (q + 1) : r * (q + 1) + (xcd - r) * q) + off; }
    const int nig = WGM * nN, gid = wgid / nig, fm = gid * WGM, gsz = (nM - fm) < WGM ? (nM - fm) : WGM;
    u.pm = fm + ((wgid % nig) % gsz); u.pn = (wgid % nig) / gsz; return true;
  }
};

template <class Epi>
__device__ __forceinline__ void gemm_phase(LAS unsigned char* lds, const Gemm g, const StaticOrder& S, const Epi& E) {
  int tid = threadIdx.x; asm volatile("" : "+v"(tid));
  const int wid = __builtin_amdgcn_readfirstlane(tid >> 6), lane = tid & 63, wr = wid >> 2, wc = wid & 3, fr = lane & 15, fq = lane >> 4;
  constexpr bool PERM = true; const int K = g.K, nt = K / BK;
  unsigned voffA[2], voffB[2];
#pragma unroll
  for (int i = 0; i < 2; ++i) { int R, C; stage_rc(tid * 16 + i * 8192, R, C); const int Rb = PERM ? ((R & ~31) + perm32(R & 31)) : R;
    voffA[i] = (unsigned)(R * K + C) * 2u; voffB[i] = (unsigned)(Rb * K + C) * 2u; }
  const size_t kstep = (size_t)(BK * 2);
  const size_t hstep = (size_t)HALF * K * 2;
  const size_t tstep = 2 * hstep;
  const unsigned ldsw = (unsigned)wid * 1024u;
  const int aoff = lds_byte(wr * 64 + fr, fq * 8), boff = lds_byte(wc * 32 + fr, fq * 8);
#define PG8_SA(b, h) (((b) * 2 + (h)) * HTB)
#define PG8_SB(b, h) ((4 + (b) * 2 + (h)) * HTB)
#define PG8_STAGE(bufoff, gbase, voff) do { _Pragma("unroll") for (int _i = 0; _i < 2; ++_i) \
    __builtin_amdgcn_global_load_lds((const unsigned*)((const char*)(gbase) + (voff)[_i]), (LAS unsigned*)(lds + (bufoff) + ldsw + _i * 8192), 16, 0, 0); } while (0)
#define PG8_LDA(dst, b, h) do { _Pragma("unroll") for (int m = 0; m < 4; ++m) _Pragma("unroll") for (int k = 0; k < 2; ++k) dst[m][k] = *(const LAS bf16x8*)(lds + PG8_SA(b, h) + aoff + m * 2048 + k * 1024); } while (0)
#define PG8_LDB(dst, b, h) do { _Pragma("unroll") for (int n = 0; n < 2; ++n) _Pragma("unroll") for (int k = 0; k < 2; ++k) dst[n][k] = *(const LAS bf16x8*)(lds + PG8_SB(b, h) + boff + n * 2048 + k * 1024); } while (0)
#define PG8_MMA(ai, bj, At, Bt) do { __builtin_amdgcn_s_setprio(1); _Pragma("unroll") for (int m = 0; m < 4; ++m) _Pragma("unroll") for (int n = 0; n < 2; ++n) _Pragma("unroll") for (int k = 0; k < 2; ++k) \
    acc[ai][bj][m][n] = __builtin_amdgcn_mfma_f32_16x16x32_bf16(Bt[n][k], At[m][k], acc[ai][bj][m][n], 0, 0, 0); __builtin_amdgcn_s_setprio(0); } while (0)
#define PG8_WAIT_V(n) asm volatile("s_waitcnt vmcnt(" #n ")" ::: "memory")
#define PG8_WAIT_L(n) asm volatile("s_waitcnt lgkmcnt(" #n ")" ::: "memory")
#define PG8_BAR __builtin_amdgcn_s_barrier()
#define PG8_SCHED __builtin_amdgcn_sched_barrier(0)
  Unit cur, nxt; int ui = 0;
  if (!S.next(0, cur)) return;
  f32x4 acc[2][2][4][2];
#pragma unroll
  for (int a = 0; a < 2; ++a)
#pragma unroll
    for (int b = 0; b < 2; ++b)
#pragma unroll
      for (int m = 0; m < 4; ++m)
#pragma unroll
        for (int n = 0; n < 2; ++n) acc[a][b][m][n] = (f32x4){0.f, 0.f, 0.f, 0.f};
  bf16x8 At[4][2], B0[2][2], B1[2][2];
  const char* cA = (const char*)g.A + (size_t)cur.pm * tstep; const char* cB = (const char*)g.Bt + (size_t)cur.pn * tstep;
  PG8_STAGE(PG8_SB(0, 0), cB, voffB); PG8_STAGE(PG8_SB(0, 1), cB + hstep, voffB); PG8_STAGE(PG8_SA(0, 0), cA, voffA); PG8_STAGE(PG8_SA(0, 1), cA + hstep, voffA);
  if (wr == 1) PG8_BAR;
  PG8_WAIT_V(2); PG8_BAR;
  PG8_STAGE(PG8_SB(1, 0), cB + kstep, voffB); PG8_STAGE(PG8_SA(1, 0), cA + kstep, voffA); PG8_STAGE(PG8_SB(1, 1), cB + hstep + kstep, voffB);
  PG8_WAIT_V(6); PG8_BAR;
  for (;;) {
    const bool has_next = S.next(ui + 1, nxt);
    const char* nA = has_next ? (const char*)g.A + (size_t)nxt.pm * tstep : cA; const char* nB = has_next ? (const char*)g.Bt + (size_t)nxt.pn * tstep : cB;
    for (int t = 0; t < nt; t += 2) {
      const bool last = (t == nt - 2);
      const char* a1 = cA + (size_t)(t + 1) * kstep;
      const char* a2 = last ? nA : cA + (size_t)(t + 2) * kstep; const char* b2 = last ? nB : cB + (size_t)(t + 2) * kstep;
      const char* a3 = a2 + kstep; const char* b3 = b2 + kstep;
      PG8_LDB(B0, 0, 0); PG8_LDB(B1, 0, 1); PG8_SCHED; PG8_LDA(At, 0, 0); PG8_STAGE(PG8_SA(1, 1), a1 + hstep, voffA);
      PG8_WAIT_V(8); PG8_WAIT_L(0); PG8_BAR; PG8_MMA(0, 0, At, B0); PG8_MMA(0, 1, At, B1); PG8_BAR; PG8_SCHED;
      PG8_LDA(At, 0, 1); PG8_STAGE(PG8_SB(0, 0), b2, voffB); PG8_STAGE(PG8_SB(0, 1), b2 + hstep, voffB); PG8_STAGE(PG8_SA(0, 0), a2, voffA);
      PG8_WAIT_V(8); PG8_WAIT_L(0); PG8_BAR; PG8_MMA(1, 0, At, B0); PG8_MMA(1, 1, At, B1); PG8_BAR; PG8_SCHED;
      PG8_LDB(B0, 1, 0); PG8_LDB(B1, 1, 1); PG8_SCHED; PG8_LDA(At, 1, 0); PG8_STAGE(PG8_SA(0, 1), a2 + hstep, voffA);
      PG8_WAIT_V(8); PG8_WAIT_L(0); PG8_BAR; PG8_MMA(0, 0, At, B0); PG8_MMA(0, 1, At, B1); PG8_BAR; PG8_SCHED;
      PG8_LDA(At, 1, 1); PG8_STAGE(PG8_SB(1, 0), b3, voffB); PG8_STAGE(PG8_SB(1, 1), b3 + hstep, voffB); PG8_STAGE(PG8_SA(1, 0), a3, voffA);
      PG8_WAIT_V(8); PG8_WAIT_L(0); PG8_BAR; PG8_MMA(1, 0, At, B0); PG8_MMA(1, 1, At, B1); PG8_BAR; PG8_SCHED;
    }
    if (wr == 0) PG8_BAR;
    E(acc, cur, wr, wc, fr, fq);
    if (!has_next) break;
#pragma unroll
    for (int a = 0; a < 2; ++a)
#pragma unroll
      for (int b = 0; b < 2; ++b)
#pragma unroll
        for (int m = 0; m < 4; ++m)
#pragma unroll
          for (int n = 0; n < 2; ++n) acc[a][b][m][n] = (f32x4){0.f, 0.f, 0.f, 0.f};
    cur = nxt; cA = nA; cB = nB; ++ui;
    if (wr == 1) PG8_BAR;
  }
  PG8_WAIT_V(0);
  PG8_BAR;
#undef PG8_SA
#undef PG8_SB
#undef PG8_STAGE
#undef PG8_LDA
#undef PG8_LDB
#undef PG8_MMA
#undef PG8_WAIT_V
#undef PG8_WAIT_L
#undef PG8_BAR
#undef PG8_SCHED
}
}

enum EpiKind { K_EVIN = 0, K_UQ = 1, K_UKV = 2, K_ODIN = 3, K_RELU2 = 4, K_RESID = 5 };
struct EpiB {
  int kind;
  unsigned char* ws;
  const float* base; float* outf;
  int rsub;
  LAS unsigned char* lds;
  __device__ __forceinline__ void store8(unsigned char* b, unsigned off, f32x4 v0, f32x4 v1) const {
    u32x4 w; w.x = cvt_pk_bf16(v0[0], v0[1]); w.y = cvt_pk_bf16(v0[2], v0[3]); w.z = cvt_pk_bf16(v1[0], v1[1]); w.w = cvt_pk_bf16(v1[2], v1[3]);
    *(u32x4*)(b + off) = w;
  }
  __device__ __forceinline__ void rope8(f32x4& v0, f32x4& v1, const f32x4 c, const f32x4 s) const {
    f32x4 a0, a1;
    a0[0] = v0[0] * c[0] - v0[1] * s[0]; a0[1] = v0[1] * c[0] + v0[0] * s[0];
    a0[2] = v0[2] * c[1] - v0[3] * s[1]; a0[3] = v0[3] * c[1] + v0[2] * s[1];
    a1[0] = v1[0] * c[2] - v1[1] * s[2]; a1[1] = v1[1] * c[2] + v1[0] * s[2];
    a1[2] = v1[2] * c[3] - v1[3] * s[3]; a1[3] = v1[3] * c[3] + v1[2] * s[3];
    v0 = a0; v1 = a1;
  }
  __device__ __forceinline__ void vt8(unsigned char* vt, unsigned off, f32x4 v0, f32x4 v1) const {
    *(bf16_t*)(vt + off + 0 * SEQ * 2) = f2bf(v0[0]); *(bf16_t*)(vt + off + 1 * SEQ * 2) = f2bf(v0[1]); *(bf16_t*)(vt + off + 2 * SEQ * 2) = f2bf(v0[2]); *(bf16_t*)(vt + off + 3 * SEQ * 2) = f2bf(v0[3]);
    *(bf16_t*)(vt + off + 4 * SEQ * 2) = f2bf(v1[0]); *(bf16_t*)(vt + off + 5 * SEQ * 2) = f2bf(v1[1]); *(bf16_t*)(vt + off + 6 * SEQ * 2) = f2bf(v1[2]); *(bf16_t*)(vt + off + 7 * SEQ * 2) = f2bf(v1[3]);
  }
  __device__ __forceinline__ void operator()(const f32x4 (&acc)[2][2][4][2], const pg8::Unit& u, int wr, int wc, int, int) const {
    const int ln_ = (int)__builtin_amdgcn_mbcnt_hi(~0u, __builtin_amdgcn_mbcnt_lo(~0u, 0u)), fr = ln_ & 15, fq = ln_ >> 4;
    const int pn = u.pn;
    unsigned char* const big = ws + WS_BIG;
    const float* const ss_in = (const float*)(ws + (kind == K_RELU2 ? WS_SS_MLP : WS_SS_MIX)); float* const ss_out = (float*)(ws + (rsub == 0 ? WS_SS_MLP : WS_SS_MIX));
    const float* const cos64 = (const float*)(ws + WS_COS64); const float* const sin64 = (const float*)(ws + WS_SIN64);
    const float* const cos32 = (const float*)(ws + WS_COS32); const float* const sin32 = (const float*)(ws + WS_SIN32);
    float rsv[2][4];
    {
      const unsigned row0 = u.pm * 256 + wr * 64 + fr;
      if (kind == K_EVIN || kind == K_ODIN || kind == K_RELU2) {
        f32x4 pq4[2][4];
#pragma unroll
        for (int ai = 0; ai < 2; ++ai)
#pragma unroll
          for (int m = 0; m < 4; ++m) pq4[ai][m] = *(const f32x4*)((const char*)ss_in + (row0 + ai * 128 + m * 16) * 16u);
#pragma unroll
        for (int ai = 0; ai < 2; ++ai)
#pragma unroll
          for (int m = 0; m < 4; ++m) { const f32x4 p = pq4[ai][m]; rsv[ai][m] = __builtin_amdgcn_rsqf(((p[0] + p[1]) + (p[2] + p[3])) * (1.f / DM) + RMS_EPS); }
      } else if (kind == K_UQ || kind == K_UKV) {
        const unsigned char* sb = ws + (kind == K_UQ ? WS_SS_Q : WS_SS_KV); const float inv = (kind == K_UQ) ? (1.f / 256.f) : (1.f / 128.f);
        f32x4 pq[2][4];
#pragma unroll
        for (int ai = 0; ai < 2; ++ai)
#pragma unroll
          for (int m = 0; m < 4; ++m) pq[ai][m] = *(const f32x4*)(sb + (row0 + ai * 128 + m * 16) * 16u);
#pragma unroll
        for (int ai = 0; ai < 2; ++ai)
#pragma unroll
          for (int m = 0; m < 4; ++m) { const f32x4 p = pq[ai][m]; rsv[ai][m] = __builtin_amdgcn_rsqf(((p[0] + p[1]) + (p[2] + p[3])) * inv + RMS_EPS); }
      } else {
#pragma unroll
        for (int ai = 0; ai < 2; ++ai)
#pragma unroll
          for (int m = 0; m < 4; ++m) rsv[ai][m] = 1.f;
      }
    }
    {
      int vkind = -1; unsigned vrow0 = 0; unsigned char* vbase = big;
      const unsigned bt = (unsigned)u.pm >> 5;
      if (kind == K_EVIN && (pn == 4 || pn == 5)) { vkind = 0; vbase = big + B_VTNA; vrow0 = bt * 512 + (pn - 4) * 256 + wc * 32; }
      else if (kind == K_UKV && pn >= 2) { vkind = 0; vbase = big + B_VTMLA; vrow0 = bt * 512 + (pn - 2) * 256 + wc * 32; }
      else if (kind == K_ODIN && pn >= 12) { const int gq = (pn - 12) >> 1; vkind = gq; vbase = big + B_VT; vrow0 = (bt * 3 + gq) * 512 + (pn & 1) * 256 + wc * 32; }
      if (vkind >= 0) {
        LAS unsigned char* scr = lds + LDS_VT_OFF + (wr * 4 + wc) * LDS_VT_WAVE;
        const int lane = fq * 16 + fr;
#pragma unroll
        for (int ai = 0; ai < 2; ++ai)
#pragma unroll
          for (int bj = 0; bj < 2; ++bj) {
            const unsigned P = ((unsigned)u.pm * 256 + ai * 128 + wr * 64) & (SEQ - 1);
#pragma unroll
            for (int h = 0; h < 2; ++h) {
              if ((fq >> 1) == h) {
#pragma unroll
                for (int m = 0; m < 4; ++m) {
                  const float rs = rsv[ai][m];
                  int fr_ = fr; asm volatile("" : "+v"(fr_));
                  const int rlm = (vkind == 0) ? 16 * m + vtidx(fr_) : (vkind == 1) ? 16 * (fr_ & 3) + vtidx(4 * m + (fr_ >> 2)) : 4 * fr_ + m;
                  LAS unsigned char* wp = scr + (8 * (fq & 1)) * 144 + rlm * 2;
#pragma unroll
                  for (int e = 0; e < 8; ++e) *(LAS bf16_t*)(wp + e * 144) = f2bf(acc[ai][bj][m][e >> 2][e & 3] * rs);
                }
              }
              asm volatile("s_waitcnt lgkmcnt(0)" ::: "memory");
              const unsigned vr = vrow0 + bj * 128 + 16 * h;
              if (vkind == 2) {
                const unsigned swc = ((P >> 6) & 3), sw = ((swc & 1) << 1) | (swc >> 1);
#pragma unroll
                for (int t = 0; t < 4; ++t) { const int q = lane + 64 * t, cl = q >> 4, r = q & 15;
                  const u32x2 w = *(const LAS u32x2*)(scr + cl * 144 + r * 8);
                  *(u32x2*)(vbase + ((vr + cl) * SEQ + r * 512 + ((P >> 4) & ~15u) + 4 * sw) * 2u) = w; }
              } else {
#pragma unroll
                for (int t = 0; t < 2; ++t) { const int q = lane + 64 * t, cl = q >> 3, pc = q & 7;
                  const u32x4 w = *(const LAS u32x4*)(scr + cl * 144 + pc * 16);
                  const unsigned lidx = (vkind == 0) ? P + 8 * pc : (pc >> 1) * 2048 + (P >> 2) + 8 * (pc & 1);
                  *(u32x4*)(vbase + ((vr + cl) * SEQ + lidx) * 2u) = w; }
              }
              asm volatile("s_waitcnt lgkmcnt(0)" ::: "memory");
            }
          }
        return;
      }
    }
#pragma unroll
    for (int ai = 0; ai < 2; ++ai) {
      f32x4 bpre[2][2][2];
      const bool rope64 = (kind == K_ODIN) && (pn < 12), rope32 = (kind == K_UQ && pn == 2) || (kind == K_EVIN && pn == 7 && wc == 0);
      if (rope64 || rope32) {
#pragma unroll
        for (int m = 0; m < 4; ++m) { const unsigned pos_ = ((unsigned)u.pm * 256 + ai * 128 + wr * 64 + m * 16 + fr) & (SEQ - 1);
          const unsigned toff = rope64 ? (pos_ * 32 + (wc & 1) * 16 + 4 * fq) * 4u : (pos_ * 16 + 4 * fq) * 4u;
          bpre[m >> 1][m & 1][0] = *(const f32x4*)((const char*)(rope64 ? cos64 : cos32) + toff); bpre[m >> 1][m & 1][1] = *(const f32x4*)((const char*)(rope64 ? sin64 : sin32) + toff); }
      }
#pragma unroll
      for (int m = 0; m < 4; ++m) {
        if (m == 0) asm volatile("" ::: "memory");
        if (kind == K_RESID && (m & 1) == 0) {
#pragma unroll
          for (int mm = 0; mm < 2; ++mm)
#pragma unroll
            for (int bj = 0; bj < 2; ++bj) { const unsigned o = ((u.pm * 256 + ai * 128 + wr * 64 + (m + mm) * 16 + fr) * DM + pn * 256 + bj * 128 + wc * 32 + 8 * fq) * 4u;
              bpre[mm][bj][0] = *(const f32x4*)((const char*)base + o); bpre[mm][bj][1] = *(const f32x4*)((const char*)base + o + 16); }
        }
        const unsigned row = u.pm * 256 + ai * 128 + wr * 64 + m * 16 + fr;
        const unsigned b = row >> 13, pos = row & (SEQ - 1);
        const float rs = rsv[ai][m];
        float part = 0.f;
#pragma unroll
        for (int bj = 0; bj < 2; ++bj) {
          const unsigned col = pn * 256 + bj * 128 + wc * 32 + 8 * fq;
          f32x4 v0 = acc[ai][bj][m][0] * rs, v1 = acc[ai][bj][m][1] * rs;
          if (kind == K_RESID) {
            const unsigned o = (row * DM + col) * 4u;
            v0 += bpre[m & 1][bj][0]; v1 += bpre[m & 1][bj][1];
            *(f32x4*)((char*)outf + o) = v0; *(f32x4*)((char*)outf + o + 16) = v1;
            store8(ws + WS_XN, (row * DM + col) * 2u, v0, v1);
            part += (v0[0] * v0[0] + v0[1] * v0[1]) + (v0[2] * v0[2] + v0[3] * v0[3]) + (v1[0] * v1[0] + v1[1] * v1[1]) + (v1[2] * v1[2] + v1[3] * v1[3]);
          } else if (kind == K_RELU2) {
#pragma unroll
            for (int e = 0; e < 4; ++e) { float a = fmaxf(v0[e], 0.f), c = fmaxf(v1[e], 0.f); v0[e] = a * a; v1[e] = c * c; }
            store8(big, (row * FF + col) * 2u, v0, v1);
          } else if (kind == K_EVIN) {
            if (pn < 4) { const float sc = pn < 2 ? C_NA : 1.f; store8(big + B_QKNA, (row * 1024 + col) * 2u, v0 * sc, v1 * sc); }
            else if (pn < 6) { vt8(big + B_VTNA, ((b * 512 + (col - 1024)) * SEQ + vtidx(pos)) * 2u, v0, v1); }
            else if (pn == 6) { store8(big + B_CQN, (row * 256 + (col - 1536)) * 2u, v0, v1);
              part += (v0[0] * v0[0] + v0[1] * v0[1]) + (v0[2] * v0[2] + v0[3] * v0[3]) + (v1[0] * v1[0] + v1[1] * v1[1]) + (v1[2] * v1[2] + v1[3] * v1[3]); }
            else {
              if (bj == 0) { store8(big + B_CKVN, (row * 128 + (col - 1792)) * 2u, v0, v1);
                part += (v0[0] * v0[0] + v0[1] * v0[1]) + (v0[2] * v0[2] + v0[3] * v0[3]) + (v1[0] * v1[0] + v1[1] * v1[1]) + (v1[2] * v1[2] + v1[3] * v1[3]); }
              else if (wc == 0) { rope8(v0, v1, bpre[m >> 1][m & 1][0], bpre[m >> 1][m & 1][1]); store8(big + B_KPE, (row * 32 + 8 * fq) * 2u, v0, v1); }
            }
          } else if (kind == K_UQ) {
            if (pn == 2) rope8(v0, v1, bpre[m >> 1][m & 1][0], bpre[m >> 1][m & 1][1]);
            store8(big + B_QMLA, (row * 768 + col) * 2u, v0 * C_MLA, v1 * C_MLA);
          } else if (kind == K_UKV) {
            if (pn < 2) store8(big + B_KN, (row * 512 + col) * 2u, v0, v1);
            else vt8(big + B_VTMLA, ((b * 512 + (col - 512)) * SEQ + vtidx(pos)) * 2u, v0, v1);
          } else {
            const int s = pn >> 1;
            if (s < 6) {
              rope8(v0, v1, bpre[m >> 1][m & 1][0], bpre[m >> 1][m & 1][1]);
              const float sc = (s & 1) ? 1.f : C_NA;
              store8(big + B_QK, (row * 3072 + col) * 2u, v0 * sc, v1 * sc);
            } else {
              const int gq = s - 6, sh = 2 * gq;
              const unsigned lidx = ((pos & ((1u << sh) - 1)) << (13 - sh)) | (pos >> sh);
              vt8(big + B_VT, (((b * 3 + gq) * 512 + (col - s * 512)) * SEQ + vtidx(lidx)) * 2u, v0, v1);
            }
          }
        }
        if (kind == K_RESID || (kind == K_EVIN && pn >= 6)) {
          part += __shfl_xor(part, 16); part += __shfl_xor(part, 32);
          if (fq == 0) {
            if (kind == K_RESID) *(LAS float*)(lds + LDS_VT_OFF + ((ai * 128 + wr * 64 + m * 16 + fr) * 4 + wc) * 4) = part;
            else ((float*)(ws + (pn == 6 ? WS_SS_Q : WS_SS_KV)))[row * 4 + wc] = part;
          }
        }
      }
    }
    if (kind == K_RESID) {
      asm volatile("s_waitcnt lgkmcnt(0)" ::: "memory"); __builtin_amdgcn_s_barrier(); asm volatile("" ::: "memory");
      const int t_ = (wr * 4 + wc) * 64 + ln_;
      if (t_ < 256) { const f32x4 p = *(const LAS f32x4*)(lds + LDS_VT_OFF + t_ * 16); ss_out[(u.pm * 256 + t_) * 4 + pn] = (p[0] + p[1]) + (p[2] + p[3]); }
      asm volatile("s_waitcnt lgkmcnt(0)" ::: "memory"); __builtin_amdgcn_s_barrier(); asm volatile("" ::: "memory");
    }
  }
};

enum ColMap { CM_ID = 0, CM_EVIN = 1, CM_UQ = 2, CM_UKV = 3, CM_ODIN = 4 };
__device__ __forceinline__ int colmap(int kind, int n) {
  switch (kind) {
    case CM_EVIN: { if (n < 1920) return n; if (n >= 1952) return -1; const int j = n - 1920, k = j >> 1; return 1920 + ((j & 1) ? k + 16 : k); }
    case CM_UQ: { if (n < 512) return (n >> 6) * 96 + (n & 63); const int h = (n - 512) >> 5, j = (n - 512) & 31, k = j >> 1; return h * 96 + 64 + ((j & 1) ? k + 16 : k); }
    case CM_UKV: { if (n < 512) return (n >> 6) * 128 + (n & 63); const int n2 = n - 512; return (n2 >> 6) * 128 + 64 + (n2 & 63); }
    case CM_ODIN: { const int ch = n / OD_NC, n1 = n - ch * OD_NC, s = n1 >> 9, hl = (n1 & 511) >> 6, j = n1 & 63;
      int gq, t, js; if (s < 6) { gq = s >> 1; t = s & 1; const int k = j >> 1; js = (j & 1) ? k + 32 : k; } else { gq = s - 6; t = 2; js = j; }
      return ((gq * 3 + t) * 16 + (8 * ch + hl)) * 64 + js; }
    default: return n;
  }
}
__device__ __forceinline__ void transpose_item(const float* W, int K, int Nsrc, int Nout, bf16_t* WT, int cm, LAS float* scr, int item, int lane, const float* gain) {
  const int nblk = Nout / 32, kb = item / nblk, nb = item % nblk, k0 = 64 * kb, n0 = 32 * nb;
  const int sc = colmap(cm, n0 + (lane & 31));
  float wv[32];
#pragma unroll
  for (int i = 0; i < 32; ++i) { const int kk = 2 * i + (lane >> 5); wv[i] = sc >= 0 ? W[(size_t)(k0 + kk) * Nsrc + sc] : 0.f; }
#pragma unroll
  for (int i = 0; i < 32; ++i) { const int kk = 2 * i + (lane >> 5); const float gk = gain ? gain[k0 + kk] : 1.f; scr[kk * 33 + (lane & 31)] = wv[i] * gk; }
  asm volatile("s_waitcnt lgkmcnt(0)" ::: "memory");
  const int c = lane & 7;
#pragma unroll
  for (int j = 0; j < 4; ++j) { const int n = (lane >> 3) + 8 * j; const LAS float* s = scr + (8 * c) * 33 + n;
    u32x4 o; o.x = cvt_pk_bf16(s[0 * 33], s[1 * 33]); o.y = cvt_pk_bf16(s[2 * 33], s[3 * 33]); o.z = cvt_pk_bf16(s[4 * 33], s[5 * 33]); o.w = cvt_pk_bf16(s[6 * 33], s[7 * 33]);
    *(u32x4*)(WT + (size_t)(n0 + n) * K + k0 + 8 * c) = o; }
  asm volatile("s_waitcnt lgkmcnt(0)" ::: "memory");
}
__device__ __forceinline__ void rms_row_bf16(const float* xrow, const float* g, bf16_t* orow, int lane) {
  const f32x4* xr = (const f32x4*)xrow + lane; const f32x4* gr = (const f32x4*)g + lane;
  f32x4 v[4]; float s = 0.f;
#pragma unroll
  for (int j = 0; j < 4; ++j) { v[j] = xr[64 * j]; s += (v[j].x * v[j].x + v[j].y * v[j].y) + (v[j].z * v[j].z + v[j].w * v[j].w); }
  const float rstd = 1.f / sqrtf(wave_sum(s) * (1.f / DM) + RMS_EPS);
  u32x2* o8 = (u32x2*)orow + lane;
#pragma unroll
  for (int j = 0; j < 4; ++j) { const f32x4 gg = gr[64 * j]; u32x2 w; w.x = cvt_pk_bf16(v[j].x * rstd * gg.x, v[j].y * rstd * gg.y); w.y = cvt_pk_bf16(v[j].z * rstd * gg.z, v[j].w * rstd * gg.w); o8[64 * j] = w; }
}
__device__ __forceinline__ void rms_row_f32(const float* xrow, const float* g, float* orow, int lane) {
  const f32x4* xr = (const f32x4*)xrow + lane; const f32x4* gr = (const f32x4*)g + lane;
  f32x4 v[4]; float s = 0.f;
#pragma unroll
  for (int j = 0; j < 4; ++j) { v[j] = xr[64 * j]; s += (v[j].x * v[j].x + v[j].y * v[j].y) + (v[j].z * v[j].z + v[j].w * v[j].w); }
  const float rstd = 1.f / sqrtf(wave_sum(s) * (1.f / DM) + RMS_EPS);
  f32x4* o = (f32x4*)orow + lane;
#pragma unroll
  for (int j = 0; j < 4; ++j) { const f32x4 gg = gr[64 * j]; o[64 * j] = v[j] * rstd * gg; }
}
__device__ __forceinline__ void sincos_acc(float angf, float& sn, float& cs) {
  const double x = (double)angf;
  const double n = __builtin_rint(x * 0.63661977236758134308);
  double r = __builtin_fma(-n, 1.57079632679489655800e+00, x); r = __builtin_fma(-n, 6.12323399573676603587e-17, r);
  const double r2 = r * r;
  double sp = 1.0 / 6227020800.0; sp = sp * r2 - 1.0 / 39916800.0; sp = sp * r2 + 1.0 / 362880.0; sp = sp * r2 - 1.0 / 5040.0; sp = sp * r2 + 1.0 / 120.0; sp = sp * r2 - 1.0 / 6.0; sp = sp * r2 + 1.0; sp *= r;
  double cp = -1.0 / 87178291200.0; cp = cp * r2 + 1.0 / 479001600.0; cp = cp * r2 - 1.0 / 3628800.0; cp = cp * r2 + 1.0 / 40320.0; cp = cp * r2 - 1.0 / 720.0; cp = cp * r2 + 1.0 / 24.0; cp = cp * r2 - 0.5; cp = cp * r2 + 1.0;
  const int q = ((int)(long long)n) & 3;
  const double s_ = (q & 1) ? cp : sp, c_ = (q & 1) ? sp : cp;
  sn = (float)((q & 2) ? -s_ : s_);
  cs = (float)(((q + 1) & 2) ? -c_ : c_);
}

__device__ __forceinline__ int crow(int r, int hi) { return (r & 3) + 8 * (r >> 2) + 4 * hi; }
__device__ __forceinline__ float half_max(float m) { auto rr = __builtin_amdgcn_permlane32_swap(__float_as_uint(m), __float_as_uint(m), false, false); return fmaxf(__uint_as_float(rr[0]), __uint_as_float(rr[1])); }
__device__ __forceinline__ float half_sum(float m) { auto rr = __builtin_amdgcn_permlane32_swap(__float_as_uint(m), __float_as_uint(m), false, false); return __uint_as_float(rr[0]) + __uint_as_float(rr[1]); }
__device__ __forceinline__ bf16x8 ldg8(const unsigned char* base, unsigned off) { return *(const bf16x8*)(base + off); }
__device__ __forceinline__ void softmax_pv(f32x16& s, const bf16x8 (&vf)[4], f32x16& o0, f32x16& o1, float& mrun, float& lrun) {
  float mx = fmaxf(s[0], s[1]);
#pragma unroll
  for (int r = 2; r < 16; ++r) mx = fmaxf(mx, s[r]);
  mx = half_max(mx);
  const float mnew = fmaxf(mrun, mx), alpha = __builtin_amdgcn_exp2f(mrun - mnew); mrun = mnew;
#pragma unroll
  for (int r = 0; r < 16; ++r) s[r] = __builtin_amdgcn_exp2f(s[r] - mnew);
  const float ls = (((s[0] + s[1]) + (s[2] + s[3])) + ((s[4] + s[5]) + (s[6] + s[7]))) + (((s[8] + s[9]) + (s[10] + s[11])) + ((s[12] + s[13]) + (s[14] + s[15])));
  lrun = lrun * alpha + ls;
  if (__builtin_amdgcn_ballot_w64(alpha != 1.f) != 0ull) {
#pragma unroll
    for (int r = 0; r < 16; ++r) { o0[r] *= alpha; o1[r] *= alpha; }
  }
  u32x4 w0, w1;
  w0.x = cvt_pk_bf16(s[0], s[1]); w0.y = cvt_pk_bf16(s[2], s[3]); w0.z = cvt_pk_bf16(s[4], s[5]); w0.w = cvt_pk_bf16(s[6], s[7]);
  w1.x = cvt_pk_bf16(s[8], s[9]); w1.y = cvt_pk_bf16(s[10], s[11]); w1.z = cvt_pk_bf16(s[12], s[13]); w1.w = cvt_pk_bf16(s[14], s[15]);
  const bf16x8 p0 = __builtin_bit_cast(bf16x8, w0), p1 = __builtin_bit_cast(bf16x8, w1);
  o0 = __builtin_amdgcn_mfma_f32_32x32x16_bf16(vf[0], p0, o0, 0, 0, 0); o0 = __builtin_amdgcn_mfma_f32_32x32x16_bf16(vf[1], p1, o0, 0, 0, 0);
  o1 = __builtin_amdgcn_mfma_f32_32x32x16_bf16(vf[2], p0, o1, 0, 0, 0); o1 = __builtin_amdgcn_mfma_f32_32x32x16_bf16(vf[3], p1, o1, 0, 0, 0);
}
__device__ __forceinline__ void store_ot(unsigned char* base, unsigned rowoff, const f32x16& o0, const f32x16& o1, float il, int hi) {
#pragma unroll
  for (int a = 0; a < 4; ++a) {
    u32x2 w; w.x = cvt_pk_bf16(o0[4 * a] * il, o0[4 * a + 1] * il); w.y = cvt_pk_bf16(o0[4 * a + 2] * il, o0[4 * a + 3] * il);
    *(u32x2*)(base + rowoff + (8 * a + 4 * hi) * 2) = w;
    u32x2 v; v.x = cvt_pk_bf16(o1[4 * a] * il, o1[4 * a + 1] * il); v.y = cvt_pk_bf16(o1[4 * a + 2] * il, o1[4 * a + 3] * il);
    *(u32x2*)(base + rowoff + (32 + 8 * a + 4 * hi) * 2) = v;
  }
}

constexpr int LDS_OST_OFF = 77824, LDS_OST_WAVE = 4608;
__device__ __forceinline__ void store_ot_rows(LAS unsigned char* ol, unsigned char* base, unsigned rowoff0, unsigned rowstride, const f32x16& o0, const f32x16& o1, float il, int r32, int hi, int lane) {
#pragma unroll
  for (int a = 0; a < 4; ++a) {
    u32x2 w; w.x = cvt_pk_bf16(o0[4 * a] * il, o0[4 * a + 1] * il); w.y = cvt_pk_bf16(o0[4 * a + 2] * il, o0[4 * a + 3] * il);
    *(LAS u32x2*)(ol + r32 * 144 + (8 * a + 4 * hi) * 2) = w;
    u32x2 v; v.x = cvt_pk_bf16(o1[4 * a] * il, o1[4 * a + 1] * il); v.y = cvt_pk_bf16(o1[4 * a + 2] * il, o1[4 * a + 3] * il);
    *(LAS u32x2*)(ol + r32 * 144 + (32 + 8 * a + 4 * hi) * 2) = v;
  }
#pragma unroll
  for (int t = 0; t < 4; ++t) { const int p = lane + 64 * t, row = p >> 3, c = p & 7;
    const u32x4 w = *(const LAS u32x4*)(ol + row * 144 + c * 16);
    *(u32x4*)(base + rowoff0 + (unsigned)row * rowstride + c * 16) = w; }
}

constexpr int MLA_STEP_BYTES = 40960, MLA_NSTEP = SEQ / 128;
#define MLA_QBLOCK(S, O0, O1, NEGM, MREF, LRUN, FIRST) do { \
    S = S - MREF; \
    float mx_ = fmaxf(fmaxf(S[0], S[1]), fmaxf(S[2], S[3])); \
    _Pragma("unroll") for (int r = 4; r < 16; r += 4) mx_ = fmaxf(mx_, fmaxf(fmaxf(S[r], S[r + 1]), fmaxf(S[r + 2], S[r + 3]))); \
    mx_ = half_max(mx_); \
    if ((FIRST) || __builtin_amdgcn_ballot_w64(mx_ > 8.f) != 0ull) { \
      const float delta_ = (FIRST) ? mx_ : fmaxf(mx_, 0.f); MREF += delta_; \
      S = S - delta_; \
      if (!(FIRST)) { const float alpha_ = __builtin_amdgcn_exp2f(-delta_); LRUN *= alpha_; O0 = O0 * alpha_; O1 = O1 * alpha_; } } \
    _Pragma("unroll") for (int r = 0; r < 16; ++r) S[r] = __builtin_amdgcn_exp2f(S[r]); \
    LRUN += (((S[0] + S[1]) + (S[2] + S[3])) + ((S[4] + S[5]) + (S[6] + S[7]))) + (((S[8] + S[9]) + (S[10] + S[11])) + ((S[12] + S[13]) + (S[14] + S[15]))); } while (0)
__device__ __forceinline__ void mla_attn_phase(unsigned char* big, unsigned char* att, LAS unsigned char* lds, int bx, int G, int wave, int lane) {
  const int r32 = lane & 31, hi = lane >> 5;
  for (int u = bx; u < 256; u += G) {
    const int ux = u & 7, ui = u >> 3, bh = ((ux << 1) + (ui >> 4)) & 15, qb = ui & 15, b = bh >> 3, h = bh & 7;
    const unsigned m0 = b * SEQ + qb * 512 + wave * 64 + r32;
    bf16x8 qa[6], qb2[6];
#pragma unroll
    for (int c = 0; c < 4; ++c) { qa[c] = ldg8(big + B_QMLA, (m0 * 768 + h * 64 + 16 * c + 8 * hi) * 2u); qb2[c] = ldg8(big + B_QMLA, ((m0 + 32) * 768 + h * 64 + 16 * c + 8 * hi) * 2u); }
#pragma unroll
    for (int c = 0; c < 2; ++c) { qa[4 + c] = ldg8(big + B_QMLA, (m0 * 768 + 512 + h * 32 + 16 * c + 8 * hi) * 2u); qb2[4 + c] = ldg8(big + B_QMLA, ((m0 + 32) * 768 + 512 + h * 32 + 16 * c + 8 * hi) * 2u); }
    const unsigned char* kn = big + B_KN + ((size_t)b * SEQ * 512 + h * 64) * 2;
    const unsigned char* kp = big + B_KPE + ((size_t)b * SEQ * 32) * 2;
    const unsigned char* vt = big + B_VTMLA + ((size_t)(b * 8 + h) * 64 * SEQ) * 2;
    const unsigned char* sbase[5]; unsigned sstride[5], loff[5];
#pragma unroll
    for (int i = 0; i < 5; ++i) {
      const int sl = wave * 5 + i, tt = sl / 10, f = sl % 10;
      if (f < 4) { sbase[i] = kn + (size_t)tt * (32 * 512 * 2); loff[i] = (r32 * 512 + 16 * f + 8 * hi) * 2u; sstride[i] = 128 * 512 * 2; }
      else if (f < 6) { sbase[i] = kp + (size_t)tt * (32 * 32 * 2); loff[i] = (r32 * 32 + 16 * (f - 4) + 8 * hi) * 2u; sstride[i] = 128 * 32 * 2; }
      else { const int d0 = (f - 6) >> 1, j = (f - 6) & 1; sbase[i] = vt + (size_t)tt * 64; loff[i] = ((d0 * 32 + r32) * SEQ + 16 * j + 8 * hi) * 2u; sstride[i] = 256; }
    }
#define MLA_ISSUE(st, rs) do { _Pragma("unroll") for (int i = 0; i < 5; ++i) \
      __builtin_amdgcn_global_load_lds((const unsigned*)(sbase[i] + (size_t)(st) * sstride[i] + loff[i]), (LAS unsigned*)(lds + (rs) * MLA_STEP_BYTES + (wave * 5 + i) * 1024), 16, 0, 0); } while (0)
#define MLA_LD(base, idx) (*(const LAS bf16x8*)(lds + (base) + (idx) * 1024 + lane * 16))
    const f32x16 z16 = {0.f, 0.f, 0.f, 0.f, 0.f, 0.f, 0.f, 0.f, 0.f, 0.f, 0.f, 0.f, 0.f, 0.f, 0.f, 0.f};
    f32x16 oA0 = z16, oA1 = z16, oB0 = z16, oB1 = z16;
    float mrefA = 0.f, mrefB = 0.f, lA = 0.f, lB = 0.f;
    MLA_ISSUE(0, 0); MLA_ISSUE(1, 1);
    int rs = 0;
    for (int st = 0; st < MLA_NSTEP; ++st) {
      if (st + 1 < MLA_NSTEP) asm volatile("s_waitcnt vmcnt(5)" ::: "memory"); else asm volatile("s_waitcnt vmcnt(0)" ::: "memory");
      __builtin_amdgcn_s_barrier();
      asm volatile("" ::: "memory");
      if (st + 2 < MLA_NSTEP) { const int rn = (rs >= 1) ? rs - 1 : 2; MLA_ISSUE(st + 2, rn); }
      const int sb = rs * MLA_STEP_BYTES;
#pragma unroll 1
      for (int tt = 0; tt < 4; ++tt) {
        const int tb = sb + tt * 10240;
        bf16x8 kf[6], vf[4];
#pragma unroll
        for (int c = 0; c < 6; ++c) kf[c] = MLA_LD(tb, c);
        f32x16 sA = __builtin_amdgcn_mfma_f32_32x32x16_bf16(kf[0], qa[0], z16, 0, 0, 0), sB = __builtin_amdgcn_mfma_f32_32x32x16_bf16(kf[0], qb2[0], z16, 0, 0, 0);
#pragma unroll
        for (int c = 1; c < 6; ++c) { sA = __builtin_amdgcn_mfma_f32_32x32x16_bf16(kf[c], qa[c], sA, 0, 0, 0); sB = __builtin_amdgcn_mfma_f32_32x32x16_bf16(kf[c], qb2[c], sB, 0, 0, 0); }
#pragma unroll
        for (int c = 0; c < 4; ++c) vf[c] = MLA_LD(tb, 6 + c);
        const bool first = (st == 0) && (tt == 0);
        MLA_QBLOCK(sA, oA0, oA1, 0, mrefA, lA, first);
        MLA_QBLOCK(sB, oB0, oB1, 0, mrefB, lB, first);
        u32x4 w0, w1, w2, w3;
        w0.x = cvt_pk_bf16(sA[0], sA[1]); w0.y = cvt_pk_bf16(sA[2], sA[3]); w0.z = cvt_pk_bf16(sA[4], sA[5]); w0.w = cvt_pk_bf16(sA[6], sA[7]);
        w1.x = cvt_pk_bf16(sA[8], sA[9]); w1.y = cvt_pk_bf16(sA[10], sA[11]); w1.z = cvt_pk_bf16(sA[12], sA[13]); w1.w = cvt_pk_bf16(sA[14], sA[15]);
        w2.x = cvt_pk_bf16(sB[0], sB[1]); w2.y = cvt_pk_bf16(sB[2], sB[3]); w2.z = cvt_pk_bf16(sB[4], sB[5]); w2.w = cvt_pk_bf16(sB[6], sB[7]);
        w3.x = cvt_pk_bf16(sB[8], sB[9]); w3.y = cvt_pk_bf16(sB[10], sB[11]); w3.z = cvt_pk_bf16(sB[12], sB[13]); w3.w = cvt_pk_bf16(sB[14], sB[15]);
        const bf16x8 pA0 = __builtin_bit_cast(bf16x8, w0), pA1 = __builtin_bit_cast(bf16x8, w1), pB0 = __builtin_bit_cast(bf16x8, w2), pB1 = __builtin_bit_cast(bf16x8, w3);
        oA0 = __builtin_amdgcn_mfma_f32_32x32x16_bf16(vf[0], pA0, oA0, 0, 0, 0); oB0 = __builtin_amdgcn_mfma_f32_32x32x16_bf16(vf[0], pB0, oB0, 0, 0, 0);
        oA1 = __builtin_amdgcn_mfma_f32_32x32x16_bf16(vf[2], pA0, oA1, 0, 0, 0); oB1 = __builtin_amdgcn_mfma_f32_32x32x16_bf16(vf[2], pB0, oB1, 0, 0, 0);
        oA0 = __builtin_amdgcn_mfma_f32_32x32x16_bf16(vf[1], pA1, oA0, 0, 0, 0); oB0 = __builtin_amdgcn_mfma_f32_32x32x16_bf16(vf[1], pB1, oB0, 0, 0, 0);
        oA1 = __builtin_amdgcn_mfma_f32_32x32x16_bf16(vf[3], pA1, oA1, 0, 0, 0); oB1 = __builtin_amdgcn_mfma_f32_32x32x16_bf16(vf[3], pB1, oB1, 0, 0, 0);
      }
      asm volatile("s_waitcnt lgkmcnt(0)" ::: "memory");
      rs = (rs == 2) ? 0 : rs + 1;
    }
#undef MLA_LD
#undef MLA_ISSUE
    const float ilA = 1.f / half_sum(lA), ilB = 1.f / half_sum(lB);
    store_ot(att, (m0 * 1024 + 512 + h * 64) * 2u, oA0, oA1, ilA, hi);
    store_ot(att, ((m0 + 32) * 1024 + 512 + h * 64) * 2u, oB0, oB1, ilB, hi);
    __builtin_amdgcn_s_barrier();
  }
}
#undef MLA_QBLOCK

constexpr int ATL_K = 0, ATL_V = 4608, ATL_WAVE = 9728;
#define ATL_LOAD(SK, SV, kbase, kpitch, vbase) do { \
    _Pragma("unroll") for (int i_ = 0; i_ < 4; ++i_) SK[i_] = *(const u32x4*)((kbase) + (size_t)(8 * i_ + (lane >> 3)) * (kpitch) + (lane & 7) * 16); \
    _Pragma("unroll") for (int i_ = 0; i_ < 4; ++i_) SV[i_] = *(const u32x4*)((vbase) + (size_t)(16 * i_ + (lane >> 2)) * (SEQ * 2) + (lane & 3) * 16); } while (0)
#define ATL_COMMIT(SK, SV, wl) do { \
    _Pragma("unroll") for (int i_ = 0; i_ < 4; ++i_) *(LAS u32x4*)((wl) + ATL_K + (8 * i_ + (lane >> 3)) * 144 + (lane & 7) * 16) = SK[i_]; \
    _Pragma("unroll") for (int i_ = 0; i_ < 4; ++i_) *(LAS u32x4*)((wl) + ATL_V + (16 * i_ + (lane >> 2)) * 80 + (lane & 3) * 16) = SV[i_]; } while (0)
#define ATL_FRAGS(KF, VF, wl) do { \
    _Pragma("unroll") for (int c_ = 0; c_ < 4; ++c_) KF[c_] = *(const LAS bf16x8*)((wl) + ATL_K + r32 * 144 + (2 * c_ + hi) * 16); \
    _Pragma("unroll") for (int d_ = 0; d_ < 2; ++d_) _Pragma("unroll") for (int j_ = 0; j_ < 2; ++j_) VF[2 * d_ + j_] = *(const LAS bf16x8*)((wl) + ATL_V + (32 * d_ + r32) * 80 + (2 * j_ + hi) * 16); } while (0)

__device__ __forceinline__ void na_attn_phase(unsigned char* big, unsigned char* att, const float* rpb, int gw, int NGW, int lane, LAS unsigned char* wl, LAS unsigned char* ol) {
  const int r32 = lane & 31, hi = lane >> 5;
  for (int wt = gw; wt < 4096; wt += NGW) {
    const int w = wt & 1, h = (wt >> 1) & 7, r = (wt >> 4) & 127, b = wt >> 11;
    const int rs = min(max(r - 4, 0), 120), c = 32 * w + r32, cs = min(max(c - 8, 0), 48);
    const unsigned m0 = b * SEQ + r * 64 + c;
    bf16x8 qf[4];
#pragma unroll
    for (int cc = 0; cc < 4; ++cc) qf[cc] = ldg8(big + B_QKNA, (m0 * 1024 + h * 64 + 16 * cc + 8 * hi) * 2u);
    const unsigned char* kb = big + B_QKNA + ((size_t)(b * SEQ + rs * 64) * 1024 + 512 + h * 64) * 2;
    const unsigned char* vt = big + B_VTNA + ((size_t)(b * 8 + h) * 64 * SEQ + rs * 64) * 2;
    const unsigned ko = (r32 * 1024 + 8 * hi) * 2u, vto = (r32 * SEQ + 8 * hi) * 2u;
    const float* bias_h = rpb + h * 15 * 31;
    f32x16 o0 = {0.f, 0.f, 0.f, 0.f, 0.f, 0.f, 0.f, 0.f, 0.f, 0.f, 0.f, 0.f, 0.f, 0.f, 0.f, 0.f}, o1 = o0;
    float mrun = NEG_BIG, lrun = 0.f;
    u32x4 sk[4], sv[4]; bf16x8 kf[4], vf[4];
#define NA_LOAD(t) ATL_LOAD(sk, sv, kb + (size_t)(t) * (32 * 1024 * 2), 2048, vt + (size_t)(t) * 64)
#define NA_COMP(KF, VF, i, half) do { \
      f32x16 s = {0.f, 0.f, 0.f, 0.f, 0.f, 0.f, 0.f, 0.f, 0.f, 0.f, 0.f, 0.f, 0.f, 0.f, 0.f, 0.f}; \
      _Pragma("unroll") for (int cc = 0; cc < 4; ++cc) s = __builtin_amdgcn_mfma_f32_32x32x16_bf16(KF[cc], qf[cc], s, 0, 0, 0); \
      const float* brow = bias_h + (rs + (i) - r + 7) * 31; \
      int c_ = c, cs_ = cs; asm volatile("" : "+v"(c_), "+v"(cs_));     \
      float bvv[16]; \
      _Pragma("unroll") for (int rr = 0; rr < 16; ++rr) { const int rel = 32 * (half) + crow(rr, hi) - c_ + 15; bvv[rr] = brow[min(max(rel, 0), 30)]; } \
      _Pragma("unroll") for (int rr = 0; rr < 16; ++rr) asm volatile("" : "+v"(bvv[rr]));     \
      _Pragma("unroll") for (int rr = 0; rr < 16; ++rr) { \
        const int kc = 32 * (half) + crow(rr, hi); \
        const bool ok = (kc >= cs_) && (kc < cs_ + 16); \
        s[rr] = ok ? s[rr] + bvv[rr] * LOG2E : NEG_BIG; } \
      softmax_pv(s, VF, o0, o1, mrun, lrun); } while (0)
    NA_LOAD(0); ATL_COMMIT(sk, sv, wl); NA_LOAD(1);
    for (int i = 0; i < 8; ++i) {
      ATL_FRAGS(kf, vf, wl); ATL_COMMIT(sk, sv, wl); if (i < 7) NA_LOAD(2 * i + 2);
      NA_COMP(kf, vf, i, 0);
      ATL_FRAGS(kf, vf, wl); if (i < 7) { ATL_COMMIT(sk, sv, wl); NA_LOAD(2 * i + 3); }
      NA_COMP(kf, vf, i, 1);
    }
#undef NA_LOAD
#undef NA_COMP
    const float il = 1.f / half_sum(lrun);
    store_ot(att, (m0 * 1024 + h * 64) * 2u, o0, o1, il, hi);
  }
}

struct DilWT { unsigned mq; int gq, sh, rho, i0, nseq; const unsigned char* vt; };
__device__ __forceinline__ DilWT dil_wt(int wt, int b, int hl, int P0, int r32, const unsigned char* big) {
  DilWT w; w.gq = wt >> 4; const int j = wt & 15; w.sh = 2 * w.gq;
  w.rho = (w.gq == 0) ? 0 : (w.gq == 1) ? (j >> 2) : j; const int it = (w.gq == 0) ? j : (w.gq == 1) ? (j & 3) : 0;
  w.i0 = (P0 >> w.sh) + 32 * it; w.nseq = SEQ >> w.sh;
  w.mq = b * SEQ + ((w.i0 + r32) << w.sh) + w.rho;
  w.vt = big + B_VT + ((size_t)((b * 3 + w.gq) * 8 + hl) * 64 * SEQ + w.rho * w.nseq) * 2;
  return w;
}
__device__ __forceinline__ void dil_attn_phase(unsigned char* big, unsigned char* att, int ch, int bx, int G, int wave, int lane, int tid, LAS unsigned char* wl, LAS unsigned char* ol) {
  const int r32 = lane & 31, hi = lane >> 5;
  float* lse = (float*)(big + B_LSE);
  for (int u = bx; u < 256; u += G) {
    const int ux = u & 7, ui = u >> 3, bhl = ((ux << 1) + (ui >> 4)) & 15, b = bhl >> 3, hl = bhl & 7, P0 = (ui & 15) * 512;
    f32x16 o0, o1; float mrun, lrun;
    bf16x8 qx[4], qy[4], kf[4], vf[4]; u32x4 sk[4], sv[4];
#define DIL_LOADQ(Q, W) do { _Pragma("unroll") for (int cc = 0; cc < 4; ++cc) Q[cc] = ldg8(big + B_QK, (W.mq * 3072 + W.gq * 1024 + hl * 64 + 16 * cc + 8 * hi) * 2u); } while (0)
#define DIL_LOAD(W, T) do { const int k0_ = W.i0 - 64 + 32 * (T), k0c_ = min(max(k0_, 0), W.nseq - 32); \
      ATL_LOAD(sk, sv, big + B_QK + ((size_t)(b * SEQ + (k0c_ << W.sh) + W.rho) * 3072 + W.gq * 1024 + 512 + hl * 64) * 2, ((size_t)6144 << W.sh), W.vt + (size_t)k0c_ * 2); } while (0)
#define DIL_COMP(KF, VF, Q, W, T) do { \
      if ((T) == 0) { _Pragma("unroll") for (int rr = 0; rr < 16; ++rr) { o0[rr] = 0.f; o1[rr] = 0.f; } mrun = NEG_BIG; lrun = 0.f; } \
      const int k0_ = W.i0 - 64 + 32 * (T); const bool tv_ = (k0_ >= 0) && (k0_ < W.nseq); \
      if (tv_) { \
      f32x16 s = {0.f, 0.f, 0.f, 0.f, 0.f, 0.f, 0.f, 0.f, 0.f, 0.f, 0.f, 0.f, 0.f, 0.f, 0.f, 0.f}; \
      _Pragma("unroll") for (int cc = 0; cc < 4; ++cc) s = __builtin_amdgcn_mfma_f32_32x32x16_bf16(KF[cc], Q[cc], s, 0, 0, 0); \
      _Pragma("unroll") for (int rr = 0; rr < 16; ++rr) { \
        const bool ok_ = ((T) == 0 ? (crow(rr, hi) >= r32) : (T) == 4 ? (crow(rr, hi) <= r32) : true); \
        s[rr] = ok_ ? s[rr] : NEG_BIG; } \
      softmax_pv(s, VF, o0, o1, mrun, lrun); } \
      if ((T) == 4) { const float lt_ = half_sum(lrun), il_ = 1.f / lt_; \
        store_ot_rows(ol, big + B_QK, ((unsigned)(b * SEQ + (W.i0 << W.sh) + W.rho) * 3072 + W.gq * 1024 + hl * 64) * 2u, 6144u << W.sh, o0, o1, il_, r32, hi, lane); \
        if (hi == 0) lse[(W.mq * 8 + hl) * 3 + W.gq] = mrun + __builtin_amdgcn_logf(lt_); } } while (0)
    DilWT WX = dil_wt(wave, b, hl, P0, r32, big), WY = WX;
    DIL_LOADQ(qx, WX); DIL_LOAD(WX, 0); ATL_COMMIT(sk, sv, wl); DIL_LOAD(WX, 1);
    for (int pair = 0; pair < 3; ++pair) {
      WY = dil_wt(wave + 8 * (2 * pair + 1), b, hl, P0, r32, big);
      ATL_FRAGS(kf, vf, wl); ATL_COMMIT(sk, sv, wl); DIL_LOAD(WX, 2); DIL_COMP(kf, vf, qx, WX, 0);
      ATL_FRAGS(kf, vf, wl); ATL_COMMIT(sk, sv, wl); DIL_LOAD(WX, 3); DIL_COMP(kf, vf, qx, WX, 1);
      ATL_FRAGS(kf, vf, wl); ATL_COMMIT(sk, sv, wl); DIL_LOAD(WX, 4); DIL_COMP(kf, vf, qx, WX, 2);
      ATL_FRAGS(kf, vf, wl); ATL_COMMIT(sk, sv, wl); DIL_LOADQ(qy, WY); DIL_LOAD(WY, 0); DIL_COMP(kf, vf, qx, WX, 3);
      ATL_FRAGS(kf, vf, wl); ATL_COMMIT(sk, sv, wl); DIL_LOAD(WY, 1); DIL_COMP(kf, vf, qx, WX, 4);
      ATL_FRAGS(kf, vf, wl); ATL_COMMIT(sk, sv, wl); DIL_LOAD(WY, 2); DIL_COMP(kf, vf, qy, WY, 0);
      ATL_FRAGS(kf, vf, wl); ATL_COMMIT(sk, sv, wl); DIL_LOAD(WY, 3); DIL_COMP(kf, vf, qy, WY, 1);
      ATL_FRAGS(kf, vf, wl); ATL_COMMIT(sk, sv, wl); DIL_LOAD(WY, 4); DIL_COMP(kf, vf, qy, WY, 2);
      ATL_FRAGS(kf, vf, wl); ATL_COMMIT(sk, sv, wl);
      if (pair < 2) { WX = dil_wt(wave + 8 * (2 * pair + 2), b, hl, P0, r32, big); DIL_LOADQ(qx, WX); DIL_LOAD(WX, 0); }
      DIL_COMP(kf, vf, qy, WY, 3);
      ATL_FRAGS(kf, vf, wl);
      if (pair < 2) { ATL_COMMIT(sk, sv, wl); DIL_LOAD(WX, 1); }
      DIL_COMP(kf, vf, qy, WY, 4);
    }
#undef DIL_LOADQ
#undef DIL_LOAD
#undef DIL_COMP
    __syncthreads();
    {
#pragma unroll 2
      for (int i = 0; i < 8; ++i) {
        const unsigned m = b * SEQ + P0 + 64 * i + (tid >> 3); const unsigned pc = (tid & 7) * 16;
        const float l0 = lse[(m * 8 + hl) * 3 + 0], l1 = lse[(m * 8 + hl) * 3 + 1], l2 = lse[(m * 8 + hl) * 3 + 2];
        float a0[8], a1[8], a2[8];
        unpack8(*(const u32x4*)(big + B_QK + ((size_t)m * 3072 + 0 * 1024 + hl * 64) * 2 + pc), a0);
        unpack8(*(const u32x4*)(big + B_QK + ((size_t)m * 3072 + 1 * 1024 + hl * 64) * 2 + pc), a1);
        unpack8(*(const u32x4*)(big + B_QK + ((size_t)m * 3072 + 2 * 1024 + hl * 64) * 2 + pc), a2);
        const float lm = fmaxf(l0, fmaxf(l1, l2));
        float w0 = __builtin_amdgcn_exp2f(l0 - lm), w1 = __builtin_amdgcn_exp2f(l1 - lm), w2 = __builtin_amdgcn_exp2f(l2 - lm);
        const float iw = 1.f / (w0 + w1 + w2); w0 *= iw; w1 *= iw; w2 *= iw;
        float f[8];
#pragma unroll
        for (int e = 0; e < 8; ++e) f[e] = w0 * a0[e] + w1 * a1[e] + w2 * a2[e];
        u32x4 wv; wv.x = cvt_pk_bf16(f[0], f[1]); wv.y = cvt_pk_bf16(f[2], f[3]); wv.z = cvt_pk_bf16(f[4], f[5]); wv.w = cvt_pk_bf16(f[6], f[7]);
        *(u32x4*)(att + ((size_t)m * 1024 + (8 * ch + hl) * 64) * 2 + pc) = wv;
      }
    }
    __syncthreads();
  }
}

#define XB_TMO      128
#define XB_XCNT(j)  (256  + 64 * (j))
#define XB_XSUB(j)  (1280 + 64 * (j))
#define XB_XGEN(j)  (2304 + 64 * (j))
#define XB_TOP      3328
#define XB_TOPGEN   3392
#define XCD_BAR_WORDS 3456
#define XB_SPIN_CAP (1u << 18)
__device__ __forceinline__ unsigned xb_ld(unsigned* p)              { return __hip_atomic_load(p, __ATOMIC_RELAXED, __HIP_MEMORY_SCOPE_AGENT); }
__device__ __forceinline__ unsigned xb_add(unsigned* p, unsigned v) { return __hip_atomic_fetch_add(p, v, __ATOMIC_RELAXED, __HIP_MEMORY_SCOPE_AGENT); }
__device__ __forceinline__ unsigned xb_xcc_id() { return (unsigned)__builtin_amdgcn_s_getreg((3 << 11) | 20) & 0xFu; }
#define XB_SPIN(cond, bar) do { unsigned _sp = 0; while (cond) { __builtin_amdgcn_s_sleep(1); \
    if ((++_sp & 255u) == 0u) { if (xb_ld(&(bar)[XB_TMO])) break; if (_sp > XB_SPIN_CAP) { atomicAdd(&(bar)[XB_TMO], 1u); break; } } } } while (0)
struct XcdBarrier { unsigned* bar; unsigned x; volatile LAS unsigned* st; };
__device__ __forceinline__ XcdBarrier xcd_barrier_post(unsigned* bar, volatile LAS unsigned* st) {
  XcdBarrier b; b.bar = bar; b.x = xb_xcc_id(); b.st = st;
  if (threadIdx.x == 0) (void)xb_add(&bar[XB_XCNT(b.x)], 1u);
  return b;
}
__device__ __forceinline__ void xcd_barrier_complete(unsigned* bar, unsigned x, unsigned& nloc, unsigned& nx) {
  const unsigned G = gridDim.x * gridDim.y * gridDim.z;
  unsigned sum, cnt, mine, sp = 0u;
  for (;;) {
    sum = 0u; cnt = 0u; mine = 0u;
#pragma unroll
    for (unsigned j = 0; j < 16; ++j) { const unsigned c = xb_ld(&bar[XB_XCNT(j)]); sum += c; cnt += (c > 0u) ? 1u : 0u; mine = (j == x) ? c : mine; }
    if (sum == G) break;
    __builtin_amdgcn_s_sleep(1);
    if ((++sp & 255u) == 0u) { if (xb_ld(&bar[XB_TMO])) break; if (sp > XB_SPIN_CAP) { atomicAdd(&bar[XB_TMO], 1u); break; } }
  }
  nloc = mine > 0u ? mine : 1u; nx = cnt > 0u ? cnt : 1u;
}
__device__ __forceinline__ void xcd_barrier(const XcdBarrier& b) {
  asm volatile("s_waitcnt vmcnt(0)" ::: "memory");
  __syncthreads();
  if (threadIdx.x == 0) {
    unsigned* bar = b.bar;
    __builtin_amdgcn_s_waitcnt(0);
    unsigned nloc = b.st[0], nx = b.st[1];
    if (nloc == 0u) { xcd_barrier_complete(bar, b.x, nloc, nx); b.st[0] = nloc; b.st[1] = nx; }
    const unsigned old = xb_add(&bar[XB_XSUB(b.x)], 1u);
    const unsigned gen = old / nloc;
    if (old + 1u == (gen + 1u) * nloc) {
      __builtin_amdgcn_fence(__ATOMIC_RELEASE, "agent");
      asm volatile("s_waitcnt vmcnt(0)" ::: "memory");
      const unsigned og = xb_add(&bar[XB_TOP], 1u);
      const unsigned tg = og / nx;
      if (og + 1u == (tg + 1u) * nx) xb_add(&bar[XB_TOPGEN], 1u);
      else XB_SPIN(xb_ld(&bar[XB_TOPGEN]) == tg, bar);
      __builtin_amdgcn_fence(__ATOMIC_ACQUIRE, "agent");
      xb_add(&bar[XB_XGEN(b.x)], 1u);
      asm volatile("s_waitcnt vmcnt(0)" ::: "memory");
    } else {
      XB_SPIN(xb_ld(&bar[XB_XGEN(b.x)]) == gen, bar);
      __builtin_amdgcn_fence(__ATOMIC_ACQUIRE, "agent");
      asm volatile("s_waitcnt vmcnt(0)" ::: "memory");
    }
  }
  __syncthreads();
}

__device__ __forceinline__ const void* ldptr(LAS unsigned char* lds, int i) {
  const volatile LAS unsigned* p = (const volatile LAS unsigned*)(lds + 131072) + 2 * i;
  const unsigned lo = __builtin_amdgcn_readfirstlane(p[0]), hi = __builtin_amdgcn_readfirstlane(p[1]);
  return (const void*)(((unsigned long long)hi << 32) | lo);
}
struct Args { const float* in[15]; float* out; unsigned char* ws; int ph_lo, ph_hi; };

__global__ void __launch_bounds__(512, 2) fwd(Args a) {
  extern __shared__ __attribute__((aligned(16))) unsigned char lds_raw[];
  LAS unsigned char* lds = (LAS unsigned char*)lds_raw;
  cg::grid_group grid = cg::this_grid();
  const int G = gridDim.x, bx = blockIdx.x;
  const int gsz = G * 512, NGW = G * 8;
  if (threadIdx.x < 15) ((LAS unsigned long long*)(lds + 131072))[threadIdx.x] = (unsigned long long)a.in[threadIdx.x];
  if (threadIdx.x == 15) ((LAS unsigned long long*)(lds + 131072))[15] = (unsigned long long)a.out;
  if (threadIdx.x == 16) ((LAS unsigned long long*)(lds + 131072))[16] = (unsigned long long)a.ws;
  if (threadIdx.x == 17) { ((LAS unsigned*)(lds + 131072 + 256))[0] = 0u; ((LAS unsigned*)(lds + 131072 + 256))[1] = 0u; }
  if (bx == 0) for (int i = threadIdx.x; i < XCD_BAR_WORDS; i += 512) ((unsigned*)a.ws)[i] = 0u;
  __syncthreads();
  XcdBarrier xbar; xbar.bar = (unsigned*)a.ws; xbar.x = 0; xbar.st = (volatile LAS unsigned*)(lds + 131072 + 256);
#define INP(i) ((const float*)ldptr(lds, (i)))

  if (a.ph_lo == 0) {
    const int gtid0 = bx * 512 + threadIdx.x;
    float* cos64 = (float*)(a.ws + WS_COS64); float* sin64 = (float*)(a.ws + WS_SIN64); float* cos32 = (float*)(a.ws + WS_COS32); float* sin32 = (float*)(a.ws + WS_SIN32);
    for (int i = gtid0; i < SEQ * 32; i += gsz) { const int pos = i >> 5, kk = i & 31; float sn, cs; sincos_acc((float)pos * INV64[kk], sn, cs); cos64[i] = cs; sin64[i] = sn; }
    for (int i = gtid0; i < SEQ * 16; i += gsz) { const int pos = i >> 4, kk = i & 15; float sn, cs; sincos_acc((float)pos * INV64[2 * kk], sn, cs); cos32[i] = cs; sin32[i] = sn; }
  }
#ifdef ONE_LAUNCH
  for (int ph = a.ph_lo; ph < a.ph_hi; ++ph) {
#else
  { const int ph = a.ph_lo;
#endif
    int tid = threadIdx.x; asm volatile("" : "+v"(tid));
    const int lane = tid & 63, wave = __builtin_amdgcn_readfirstlane(tid >> 6), gtid = bx * 512 + tid, gw = bx * 8 + wave;
    unsigned char* ws = a.ws;
    float* X = a.out;
    unsigned char* big = ws + WS_BIG;
    bf16_t* XN = (bf16_t*)(ws + WS_XN); bf16_t* ATT = (bf16_t*)(ws + WS_ATT);
    const float* cos64 = (const float*)(ws + WS_COS64); const float* sin64 = (const float*)(ws + WS_SIN64);
    const float* cos32 = (const float*)(ws + WS_COS32); const float* sin32 = (const float*)(ws + WS_SIN32);
    if (ph == NPH - 1) {
      for (int m = gw; m < M; m += NGW) rms_row_f32(X + (size_t)m * DM, INP(3), X + (size_t)m * DM, lane);
    } else {
      const int pp = ph >= 15 ? ph - 15 : ph, L = (ph >= 15 ? 2 : 0) + (pp >= 7 ? 1 : 0), idx = pp >= 7 ? pp - 7 : pp, e = L >> 1; const bool even = !(L & 1);
      const int k = even ? idx + (idx >= 2 ? 1 : 0) + (idx >= 5 ? 1 : 0) : idx + (idx >= 6 ? 1 : 0);
      const float* xsrc = (L == 0) ? INP(0) : X;
      float* ss_mix = (float*)(ws + WS_SS_MIX); float* ss_mlp = (float*)(ws + WS_SS_MLP);
      if (k == 0) {
        LAS float* scr = (LAS float*)(lds + wave * 16384);
        const float* w1 = INP(13) + (size_t)L * DM * FF; const float* w2 = INP(14) + (size_t)L * FF * DM;
        const float* wo = even ? INP(10) + (size_t)e * DM * DM : INP(12) + (size_t)e * DM * DM;
        const float* gmix = INP(1) + L * DM; const float* gmlp = INP(2) + L * DM;
        const int nin = even ? EV_N : 2 * OD_NC;
        const int I_IN = 16 * (nin / 32), I_O = 16 * 32, I_1 = 16 * 128, I_2 = 64 * 32, I_UQ = even ? 4 * 24 : 0, I_UKV = even ? 2 * 32 : 0;
        const int NIT = I_IN + I_O + I_1 + I_2 + I_UQ + I_UKV;
        for (int it = gw; it < NIT; it += NGW) {
          int r = it;
          if (r < I_IN) { if (even) transpose_item(INP(4) + (size_t)e * DM * 1952, DM, 1952, EV_N, (bf16_t*)(ws + WS_W + W_IN), CM_EVIN, scr, r, lane, gmix);
                          else transpose_item(INP(11) + (size_t)e * DM * 9216, DM, 9216, 2 * OD_NC, (bf16_t*)(ws + WS_W + W_IN), CM_ODIN, scr, r, lane, gmix); continue; } r -= I_IN;
          if (r < I_O) { transpose_item(wo, DM, DM, DM, (bf16_t*)(ws + WS_W + W_O), CM_ID, scr, r, lane, nullptr); continue; } r -= I_O;
          if (r < I_1) { transpose_item(w1, DM, FF, FF, (bf16_t*)(ws + WS_W + W_1), CM_ID, scr, r, lane, gmlp); continue; } r -= I_1;
          if (r < I_2) { transpose_item(w2, FF, DM, DM, (bf16_t*)(ws + WS_W + W_2), CM_ID, scr, r, lane, nullptr); continue; } r -= I_2;
          if (r < I_UQ) { transpose_item(INP(7) + (size_t)e * 256 * 768, 256, 768, 768, (bf16_t*)(ws + WS_W + W_UQ), CM_UQ, scr, r, lane, INP(6) + e * 256); continue; } r -= I_UQ;
          transpose_item(INP(9) + (size_t)e * 128 * 1024, 128, 1024, 1024, (bf16_t*)(ws + WS_W + W_UKV), CM_UKV, scr, r, lane, INP(8) + e * 128);
        }
        if (L == 0) {
          for (int m = gw; m < M; m += NGW) {
            const f32x4* xr = (const f32x4*)(xsrc + (size_t)m * DM) + lane; u32x2* o8 = (u32x2*)(XN + (size_t)m * DM) + lane; float s = 0.f;
#pragma unroll
            for (int j = 0; j < 4; ++j) { const f32x4 v = xr[64 * j]; s += (v.x * v.x + v.y * v.y) + (v.z * v.z + v.w * v.w); u32x2 w; w.x = cvt_pk_bf16(v.x, v.y); w.y = cvt_pk_bf16(v.z, v.w); o8[64 * j] = w; }
            s = wave_sum(s); if (lane < 4) ss_mix[m * 4 + lane] = (lane == 0) ? s : 0.f;
          }
        }
      } else if (even && k == 4) {
        na_attn_phase(big, (unsigned char*)ATT, INP(5) + (size_t)e * 8 * 15 * 31, gw, NGW, lane, lds + wave * ATL_WAVE, lds + LDS_OST_OFF + wave * LDS_OST_WAVE);
        __syncthreads();
        mla_attn_phase(big, (unsigned char*)ATT, lds, bx, G, wave, lane);
      } else if (!even && (k == 2 || k == 4)) {
        dil_attn_phase(big, (unsigned char*)ATT, (k == 2) ? 0 : 1, bx, G, wave, lane, tid, lds + wave * ATL_WAVE, lds + LDS_OST_OFF + wave * LDS_OST_WAVE);
      } else {
        const int nsub = (even && k == 3) ? 2 : 1;
        for (int sub = 0; sub < nsub; ++sub) {
          pg8::Gemm g; pg8::StaticOrder S; EpiB E; E.ws = ws; E.lds = lds;
          g.M = M;
          E.base = (k == 5) ? xsrc : X; E.outf = X;
          E.rsub = (k == 5) ? 0 : 1;
          if (k == 5) { g.A = ATT; g.Bt = (const bf16_t*)(ws + WS_W + W_O); g.N = DM; g.K = DM; E.kind = K_RESID; }
          else if (k == 8) { g.A = (const bf16_t*)big; g.Bt = (const bf16_t*)(ws + WS_W + W_2); g.N = DM; g.K = FF; E.kind = K_RESID; }
          else if (k == 7) { g.A = XN; g.Bt = (const bf16_t*)(ws + WS_W + W_1); g.N = FF; g.K = DM; E.kind = K_RELU2; }
          else if (even && k == 1) { g.A = XN; g.Bt = (const bf16_t*)(ws + WS_W + W_IN); g.N = EV_N; g.K = DM; E.kind = K_EVIN; }
          else if (even) {
            if (sub == 0) { g.A = (const bf16_t*)(big + B_CQN); g.Bt = (const bf16_t*)(ws + WS_W + W_UQ); g.N = 768; g.K = 256; E.kind = K_UQ; }
            else { g.A = (const bf16_t*)(big + B_CKVN); g.Bt = (const bf16_t*)(ws + WS_W + W_UKV); g.N = 1024; g.K = 128; E.kind = K_UKV; }
          } else { const int ch = (k == 1) ? 0 : 1; g.A = XN; g.Bt = (const bf16_t*)(ws + WS_W + W_IN) + (size_t)ch * OD_NC * DM; g.N = OD_NC; g.K = DM; E.kind = K_ODIN; }
          S.init(M, g.N, G, bx);
          pg8::gemm_phase<EpiB>(lds, g, S, E);
        }
      }
    }
#ifdef ONE_LAUNCH
    if (ph + 1 < a.ph_hi) {
      if (ph == a.ph_lo) { grid.sync(); xbar = xcd_barrier_post((unsigned*)a.ws, (volatile LAS unsigned*)(lds + 131072 + 256)); }
      else xcd_barrier(xbar);
    }
#endif
  }
}

extern "C" void kernel_launch(void* const* d_in, const int* in_sizes, int n_in, void* d_out, int out_size, void* d_ws, size_t ws_size, hipStream_t stream) {
  static int grid = 0;
  if (!grid) {
    if (n_in != 15 || out_size != M * DM || ws_size < WS_END) { fprintf(stderr, "kernel_launch: unexpected sizes n_in %d out %d ws %zu (need %zu)\n", n_in, out_size, ws_size, (size_t)WS_END); grid = -1; return; }
    int dev = 0, cus = 0, per_cu = 0;
    (void)hipGetDevice(&dev);
    (void)hipDeviceGetAttribute(&cus, hipDeviceAttributeMultiprocessorCount, dev);
    (void)hipFuncSetAttribute((const void*)fwd, hipFuncAttributeMaxDynamicSharedMemorySize, LDS_BYTES);
    (void)hipOccupancyMaxActiveBlocksPerMultiprocessor(&per_cu, (const void*)fwd, 512, LDS_BYTES);
    if (per_cu < 1) per_cu = 1;
    grid = cus * per_cu;
  }
  if (grid < 0) return;
  Args a{};
  for (int i = 0; i < 15; ++i) a.in[i] = (const float*)d_in[i];
  a.out = (float*)d_out; a.ws = (unsigned char*)d_ws;
#ifndef ONE_LAUNCH
  for (int ph = 0; ph < NPH; ++ph) {
    a.ph_lo = ph; a.ph_hi = ph + 1;
    hipLaunchKernelGGL(fwd, dim3(grid), dim3(512), LDS_BYTES, stream, a);
  }
#else
  a.ph_lo = 0; a.ph_hi = NPH;
  void* args[] = {&a};
  hipError_t er = hipLaunchCooperativeKernel((const void*)fwd, dim3(grid), dim3(512), args, LDS_BYTES, stream);
  if (er != hipSuccess) fprintf(stderr, "cooperative launch failed: %s (grid %d)\n", hipGetErrorString(er), grid);
#endif
}
```

```cpp
#include <hip/hip_runtime.h>
#include <hip/hip_cooperative_groups.h>
#include <cstdio>
#include <cstdint>
namespace cg = cooperative_groups;
#define ONE_LAUNCH 1

#define LAS __attribute__((address_space(3)))
typedef unsigned short bf16_t;
typedef short bf16x8 __attribute__((ext_vector_type(8)));
typedef float f32x4 __attribute__((ext_vector_type(4)));
typedef float f32x2 __attribute__((ext_vector_type(2)));
typedef float f32x16 __attribute__((ext_vector_type(16)));
typedef unsigned u32x4 __attribute__((ext_vector_type(4)));
typedef unsigned u32x2 __attribute__((ext_vector_type(2)));

constexpr int M = 16384, SEQ = 8192, DM = 1024, FF = 4096;
constexpr int EV_N = 2048;
constexpr int OD_NC = 4608;
constexpr float LOG2E = 1.4426950408889634f;
constexpr float C_NA = 0.125f * LOG2E;
constexpr float C_MLA = 0.10206207261596575f * LOG2E;
constexpr float RMS_EPS = 1e-6f;
constexpr float NEG_BIG = -1e30f;

constexpr size_t MiB = 1u << 20;
constexpr size_t WS_COS64 = 1 * MiB, WS_SIN64 = 2 * MiB, WS_COS32 = 3 * MiB, WS_SIN32 = 3 * MiB + 512 * 1024;
constexpr size_t WS_W = 4 * MiB;
constexpr size_t W_IN = 0, W_O = 18 * MiB, W_1 = 20 * MiB, W_2 = 28 * MiB, W_UQ = 36 * MiB, W_UKV = 36 * MiB + 512 * 1024;
constexpr size_t WS_XN = 41 * MiB;
constexpr size_t WS_ATT = 73 * MiB;
constexpr size_t WS_BIG = 105 * MiB;
constexpr size_t B_QKNA = 0, B_VTNA = 32 * MiB, B_CQN = 60 * MiB, B_CKVN = 68 * MiB, B_KPE = 72 * MiB,
                 B_QMLA = 73 * MiB, B_KN = 97 * MiB, B_VTMLA = 113 * MiB;
constexpr size_t B_QK = 0, B_VT = 96 * MiB, B_LSE = 144 * MiB;
constexpr size_t WS_END = 255 * MiB;

constexpr int LDS_BYTES = 151552;
constexpr int LDS_VT_OFF = 131072 + 1024, LDS_VT_WAVE = 2304;
constexpr int NPH = 31;
constexpr size_t WS_SS_MIX = 252 * MiB, WS_SS_MLP = 253 * MiB, WS_SS_Q = 254 * MiB, WS_SS_KV = 254 * MiB + 512 * 1024;

__device__ const float INV64[32] = {
  1.000000000e+00f, 7.498942018e-01f, 5.623413324e-01f, 4.216965139e-01f, 3.162277639e-01f, 2.371373922e-01f, 1.778279394e-01f, 1.333521456e-01f,
  1.000000015e-01f, 7.498941571e-02f, 5.623412877e-02f, 4.216964915e-02f, 3.162277862e-02f, 2.371373586e-02f, 1.778279431e-02f, 1.333521493e-02f,
  9.999999776e-03f, 7.498942316e-03f, 5.623413250e-03f, 4.216964822e-03f, 3.162277862e-03f, 2.371373819e-03f, 1.778279431e-03f, 1.333521446e-03f,
  1.000000047e-03f, 7.498941850e-04f, 5.623413017e-04f, 4.216965463e-04f, 3.162277862e-04f, 2.371373848e-04f, 1.778279402e-04f, 1.333521504e-04f};

typedef __bf16 bf16x2_t __attribute__((ext_vector_type(2)));
__device__ __forceinline__ unsigned cvt_pk_bf16(float lo, float hi) { const f32x2 v = {lo, hi}; const bf16x2_t b = __builtin_convertvector(v, bf16x2_t); return __builtin_bit_cast(unsigned, b); }
__device__ __forceinline__ bf16_t f2bf(float f) { return (bf16_t)(cvt_pk_bf16(f, 0.f) & 0xffffu); }
__device__ __forceinline__ float bf2f(unsigned short h) { return __uint_as_float(((unsigned)h) << 16); }
__device__ __forceinline__ float bflo(unsigned w) { return __uint_as_float(w << 16); }
__device__ __forceinline__ float bfhi(unsigned w) { return __uint_as_float(w & 0xffff0000u); }
__device__ __forceinline__ int vtidx(int p) { return (p & ~12) | ((p & 4) << 1) | ((p & 8) >> 1); }
__device__ __forceinline__ float wave_sum(float v) {
#pragma unroll
  for (int o = 1; o < 64; o <<= 1) v += __shfl_xor(v, o);
  return v;
}
__device__ __forceinline__ void unpack8(const u32x4 w, float* f) {
  f[0] = bflo(w.x); f[1] = bfhi(w.x); f[2] = bflo(w.y); f[3] = bfhi(w.y); f[4] = bflo(w.z); f[5] = bfhi(w.z); f[6] = bflo(w.w); f[7] = bfhi(w.w);
}

namespace pg8 {
constexpr int BM = 256, BK = 64, HALF = 128, HTB = HALF * BK * 2, STAGE_BYTES = 8 * HTB, NXCD = 8, WGM = 4;
__host__ __device__ __forceinline__ int lds_byte(int r, int c) { const int st = (r >> 4) * 2 + (c >> 5), rr = r & 15, cc = c & 31, ob = rr * 64 + cc * 2; return st * 1024 + (ob ^ (((ob >> 9) & 1) << 5)); }
__host__ __device__ __forceinline__ void stage_rc(int b, int& R, int& C) { const int st = b / 1024, sb = b % 1024, swz = sb ^ (((sb >> 9) & 1) << 5); R = (st >> 1) * 16 + swz / 64; C = (st & 1) * 32 + (swz % 64) / 2; }
__host__ __device__ __forceinline__ int perm32(int rho) { const int n = rho >> 4, i = rho & 15; return 8 * (i >> 2) + 4 * n + (i & 3); }

struct Unit { int pm, pn; };
struct Gemm { const bf16_t* A; const bf16_t* Bt; int M, N, K; };
struct StaticOrder {
  int nM, nN, nwg, G, c;
  __device__ void init(int M_, int N_, int G_, int c_) { nM = M_ / BM; nN = N_ / BM; nwg = nM * nN; G = G_; c = c_; }
  __device__ bool next(int i, Unit& u) const {
    const long L = (long)i * G + c; if (L >= nwg) return false;
    int wgid = (int)L; { const int q = nwg / NXCD, r = nwg % NXCD, xcd = wgid % NXCD, off = wgid / NXCD; wgid = (xcd < r ? xcd * (q + 1) : r * (q + 1) + (xcd - r) * q) + off; }
    const int nig = WGM * nN, gid = wgid / nig, fm = gid * WGM, gsz = (nM - fm) < WGM ? (nM - fm) : WGM;
    u.pm = fm + ((wgid % nig) % gsz); u.pn = (wgid % nig) / gsz; return true;
  }
};

template <class Epi>
__device__ __forceinline__ void gemm_phase(LAS unsigned char* lds, const Gemm g, const StaticOrder& S, const Epi& E) {
  int tid = threadIdx.x; asm volatile("" : "+v"(tid));
  const int wid = __builtin_amdgcn_readfirstlane(tid >> 6), lane = tid & 63, wr = wid >> 2, wc = wid & 3, fr = lane & 15, fq = lane >> 4;
  constexpr bool PERM = true; const int K = g.K, nt = K / BK;
  unsigned voffA[2], voffB[2];
#pragma unroll
  for (int i = 0; i < 2; ++i) { int R, C; stage_rc(tid * 16 + i * 8192, R, C); const int Rb = PERM ? ((R & ~31) + perm32(R & 31)) : R;
    voffA[i] = (unsigned)(R * K + C) * 2u; voffB[i] = (unsigned)(Rb * K + C) * 2u; }
  const size_t kstep = (size_t)(BK * 2);
  const size_t hstep = (size_t)HALF * K * 2;
  const size_t tstep = 2 * hstep;
  const unsigned ldsw = (unsigned)wid * 1024u;
  const int aoff = lds_byte(wr * 64 + fr, fq * 8), boff = lds_byte(wc * 32 + fr, fq * 8);
#define PG8_SA(b, h) (((b) * 2 + (h)) * HTB)
#define PG8_SB(b, h) ((4 + (b) * 2 + (h)) * HTB)
#define PG8_STAGE(bufoff, gbase, voff) do { _Pragma("unroll") for (int _i = 0; _i < 2; ++_i) \
    __builtin_amdgcn_global_load_lds((const unsigned*)((const char*)(gbase) + (voff)[_i]), (LAS unsigned*)(lds + (bufoff) + ldsw + _i * 8192), 16, 0, 0); } while (0)
#define PG8_LDA(dst, b, h) do { _Pragma("unroll") for (int m = 0; m < 4; ++m) _Pragma("unroll") for (int k = 0; k < 2; ++k) dst[m][k] = *(const LAS bf16x8*)(lds + PG8_SA(b, h) + aoff + m * 2048 + k * 1024); } while (0)
#define PG8_LDB(dst, b, h) do { _Pragma("unroll") for (int n = 0; n < 2; ++n) _Pragma("unroll") for (int k = 0; k < 2; ++k) dst[n][k] = *(const LAS bf16x8*)(lds + PG8_SB(b, h) + boff + n * 2048 + k * 1024); } while (0)
#define PG8_MMA(ai, bj, At, Bt) do { __builtin_amdgcn_s_setprio(1); _Pragma("unroll") for (int m = 0; m < 4; ++m) _Pragma("unroll") for (int n = 0; n < 2; ++n) _Pragma("unroll") for (int k = 0; k < 2; ++k) \
    acc[ai][bj][m][n] = __builtin_amdgcn_mfma_f32_16x16x32_bf16(Bt[n][k], At[m][k], acc[ai][bj][m][n], 0, 0, 0); __builtin_amdgcn_s_setprio(0); } while (0)
#define PG8_WAIT_V(n) asm volatile("s_waitcnt vmcnt(" #n ")" ::: "memory")
#define PG8_WAIT_L(n) asm volatile("s_waitcnt lgkmcnt(" #n ")" ::: "memory")
#define PG8_BAR __builtin_amdgcn_s_barrier()
#define PG8_SCHED __builtin_amdgcn_sched_barrier(0)
  Unit cur, nxt; int ui = 0;
  if (!S.next(0, cur)) return;
  f32x4 acc[2][2][4][2];
#pragma unroll
  for (int a = 0; a < 2; ++a)
#pragma unroll
    for (int b = 0; b < 2; ++b)
#pragma unroll
      for (int m = 0; m < 4; ++m)
#pragma unroll
        for (int n = 0; n < 2; ++n) acc[a][b][m][n] = (f32x4){0.f, 0.f, 0.f, 0.f};
  bf16x8 At[4][2], B0[2][2], B1[2][2];
  const char* cA = (const char*)g.A + (size_t)cur.pm * tstep; const char* cB = (const char*)g.Bt + (size_t)cur.pn * tstep;
  PG8_STAGE(PG8_SB(0, 0), cB, voffB); PG8_STAGE(PG8_SB(0, 1), cB + hstep, voffB); PG8_STAGE(PG8_SA(0, 0), cA, voffA); PG8_STAGE(PG8_SA(0, 1), cA + hstep, voffA);
  if (wr == 1) PG8_BAR;
  PG8_WAIT_V(2); PG8_BAR;
  PG8_STAGE(PG8_SB(1, 0), cB + kstep, voffB); PG8_STAGE(PG8_SA(1, 0), cA + kstep, voffA); PG8_STAGE(PG8_SB(1, 1), cB + hstep + kstep, voffB);
  PG8_WAIT_V(6); PG8_BAR;
  for (;;) {
    const bool has_next = S.next(ui + 1, nxt);
    const char* nA = has_next ? (const char*)g.A + (size_t)nxt.pm * tstep : cA; const char* nB = has_next ? (const char*)g.Bt + (size_t)nxt.pn * tstep : cB;
    for (int t = 0; t < nt; t += 2) {
      const bool last = (t == nt - 2);
      const char* a1 = cA + (size_t)(t + 1) * kstep;
      const char* a2 = last ? nA : cA + (size_t)(t + 2) * kstep; const char* b2 = last ? nB : cB + (size_t)(t + 2) * kstep;
      const char* a3 = a2 + kstep; const char* b3 = b2 + kstep;
      PG8_LDB(B0, 0, 0); PG8_LDB(B1, 0, 1); PG8_SCHED; PG8_LDA(At, 0, 0); PG8_STAGE(PG8_SA(1, 1), a1 + hstep, voffA);
      PG8_WAIT_V(8); PG8_WAIT_L(0); PG8_BAR; PG8_MMA(0, 0, At, B0); PG8_MMA(0, 1, At, B1); PG8_BAR; PG8_SCHED;
      PG8_LDA(At, 0, 1); PG8_STAGE(PG8_SB(0, 0), b2, voffB); PG8_STAGE(PG8_SB(0, 1), b2 + hstep, voffB); PG8_STAGE(PG8_SA(0, 0), a2, voffA);
      PG8_WAIT_V(8); PG8_WAIT_L(0); PG8_BAR; PG8_MMA(1, 0, At, B0); PG8_MMA(1, 1, At, B1); PG8_BAR; PG8_SCHED;
      PG8_LDB(B0, 1, 0); PG8_LDB(B1, 1, 1); PG8_SCHED; PG8_LDA(At, 1, 0); PG8_STAGE(PG8_SA(0, 1), a2 + hstep, voffA);
      PG8_WAIT_V(8); PG8_WAIT_L(0); PG8_BAR; PG8_MMA(0, 0, At, B0); PG8_MMA(0, 1, At, B1); PG8_BAR; PG8_SCHED;
      PG8_LDA(At, 1, 1); PG8_STAGE(PG8_SB(1, 0), b3, voffB); PG8_STAGE(PG8_SB(1, 1), b3 + hstep, voffB); PG8_STAGE(PG8_SA(1, 0), a3, voffA);
      PG8_WAIT_V(8); PG8_WAIT_L(0); PG8_BAR; PG8_MMA(1, 0, At, B0); PG8_MMA(1, 1, At, B1); PG8_BAR; PG8_SCHED;
    }
    if (wr == 0) PG8_BAR;
    E(acc, cur, wr, wc, fr, fq);
    if (!has_next) break;
#pragma unroll
    for (int a = 0; a < 2; ++a)
#pragma unroll
      for (int b = 0; b < 2; ++b)
#pragma unroll
        for (int m = 0; m < 4; ++m)
#pragma unroll
          for (int n = 0; n < 2; ++n) acc[a][b][m][n] = (f32x4){0.f, 0.f, 0.f, 0.f};
    cur = nxt; cA = nA; cB = nB; ++ui;
    if (wr == 1) PG8_BAR;
  }
  PG8_WAIT_V(0);
  PG8_BAR;
#undef PG8_SA
#undef PG8_SB
#undef PG8_STAGE
#undef PG8_LDA
#undef PG8_LDB
#undef PG8_MMA
#undef PG8_WAIT_V
#undef PG8_WAIT_L
#undef PG8_BAR
#undef PG8_SCHED
}
}

enum EpiKind { K_EVIN = 0, K_UQ = 1, K_UKV = 2, K_ODIN = 3, K_RELU2 = 4, K_RESID = 5 };
struct EpiB {
  int kind;
  unsigned char* ws;
  const float* base; float* outf;
  int rsub;
  LAS unsigned char* lds;
  __device__ __forceinline__ void store8(unsigned char* b, unsigned off, f32x4 v0, f32x4 v1) const {
    u32x4 w; w.x = cvt_pk_bf16(v0[0], v0[1]); w.y = cvt_pk_bf16(v0[2], v0[3]); w.z = cvt_pk_bf16(v1[0], v1[1]); w.w = cvt_pk_bf16(v1[2], v1[3]);
    *(u32x4*)(b + off) = w;
  }
  __device__ __forceinline__ void rope8(f32x4& v0, f32x4& v1, const f32x4 c, const f32x4 s) const {
    f32x4 a0, a1;
    a0[0] = v0[0] * c[0] - v0[1] * s[0]; a0[1] = v0[1] * c[0] + v0[0] * s[0];
    a0[2] = v0[2] * c[1] - v0[3] * s[1]; a0[3] = v0[3] * c[1] + v0[2] * s[1];
    a1[0] = v1[0] * c[2] - v1[1] * s[2]; a1[1] = v1[1] * c[2] + v1[0] * s[2];
    a1[2] = v1[2] * c[3] - v1[3] * s[3]; a1[3] = v1[3] * c[3] + v1[2] * s[3];
    v0 = a0; v1 = a1;
  }
  __device__ __forceinline__ void vt8(unsigned char* vt, unsigned off, f32x4 v0, f32x4 v1) const {
    *(bf16_t*)(vt + off + 0 * SEQ * 2) = f2bf(v0[0]); *(bf16_t*)(vt + off + 1 * SEQ * 2) = f2bf(v0[1]); *(bf16_t*)(vt + off + 2 * SEQ * 2) = f2bf(v0[2]); *(bf16_t*)(vt + off + 3 * SEQ * 2) = f2bf(v0[3]);
    *(bf16_t*)(vt + off + 4 * SEQ * 2) = f2bf(v1[0]); *(bf16_t*)(vt + off + 5 * SEQ * 2) = f2bf(v1[1]); *(bf16_t*)(vt + off + 6 * SEQ * 2) = f2bf(v1[2]); *(bf16_t*)(vt + off + 7 * SEQ * 2) = f2bf(v1[3]);
  }
  __device__ __forceinline__ void operator()(const f32x4 (&acc)[2][2][4][2], const pg8::Unit& u, int wr, int wc, int, int) const {
    const int ln_ = (int)__builtin_amdgcn_mbcnt_hi(~0u, __builtin_amdgcn_mbcnt_lo(~0u, 0u)), fr = ln_ & 15, fq = ln_ >> 4;
    const int pn = u.pn;
    unsigned char* const big = ws + WS_BIG;
    const float* const ss_in = (const float*)(ws + (kind == K_RELU2 ? WS_SS_MLP : WS_SS_MIX)); float* const ss_out = (float*)(ws + (rsub == 0 ? WS_SS_MLP : WS_SS_MIX));
    const float* const cos64 = (const float*)(ws + WS_COS64); const float* const sin64 = (const float*)(ws + WS_SIN64);
    const float* const cos32 = (const float*)(ws + WS_COS32); const float* const sin32 = (const float*)(ws + WS_SIN32);
    float rsv[2][4];
    {
      const unsigned row0 = u.pm * 256 + wr * 64 + fr;
      if (kind == K_EVIN || kind == K_ODIN || kind == K_RELU2) {
        f32x4 pq4[2][4];
#pragma unroll
        for (int ai = 0; ai < 2; ++ai)
#pragma unroll
          for (int m = 0; m < 4; ++m) pq4[ai][m] = *(const f32x4*)((const char*)ss_in + (row0 + ai * 128 + m * 16) * 16u);
#pragma unroll
        for (int ai = 0; ai < 2; ++ai)
#pragma unroll
          for (int m = 0; m < 4; ++m) { const f32x4 p = pq4[ai][m]; rsv[ai][m] = __builtin_amdgcn_rsqf(((p[0] + p[1]) + (p[2] + p[3])) * (1.f / DM) + RMS_EPS); }
      } else if (kind == K_UQ || kind == K_UKV) {
        const unsigned char* sb = ws + (kind == K_UQ ? WS_SS_Q : WS_SS_KV); const float inv = (kind == K_UQ) ? (1.f / 256.f) : (1.f / 128.f);
        f32x4 pq[2][4];
#pragma unroll
        for (int ai = 0; ai < 2; ++ai)
#pragma unroll
          for (int m = 0; m < 4; ++m) pq[ai][m] = *(const f32x4*)(sb + (row0 + ai * 128 + m * 16) * 16u);
#pragma unroll
        for (int ai = 0; ai < 2; ++ai)
#pragma unroll
          for (int m = 0; m < 4; ++m) { const f32x4 p = pq[ai][m]; rsv[ai][m] = __builtin_amdgcn_rsqf(((p[0] + p[1]) + (p[2] + p[3])) * inv + RMS_EPS); }
      } else {
#pragma unroll
        for (int ai = 0; ai < 2; ++ai)
#pragma unroll
          for (int m = 0; m < 4; ++m) rsv[ai][m] = 1.f;
      }
    }
    {
      int vkind = -1; unsigned vrow0 = 0; unsigned char* vbase = big;
      const unsigned bt = (unsigned)u.pm >> 5;
      if (kind == K_EVIN && (pn == 4 || pn == 5)) { vkind = 0; vbase = big + B_VTNA; vrow0 = bt * 512 + (pn - 4) * 256 + wc * 32; }
      else if (kind == K_UKV && pn >= 2) { vkind = 0; vbase = big + B_VTMLA; vrow0 = bt * 512 + (pn - 2) * 256 + wc * 32; }
      else if (kind == K_ODIN && pn >= 12) { const int gq = (pn - 12) >> 1; vkind = gq; vbase = big + B_VT; vrow0 = (bt * 3 + gq) * 512 + (pn & 1) * 256 + wc * 32; }
      if (vkind >= 0) {
        LAS unsigned char* scr = lds + LDS_VT_OFF + (wr * 4 + wc) * LDS_VT_WAVE;
        const int lane = fq * 16 + fr;
#pragma unroll
        for (int ai = 0; ai < 2; ++ai)
#pragma unroll
          for (int bj = 0; bj < 2; ++bj) {
            const unsigned P = ((unsigned)u.pm * 256 + ai * 128 + wr * 64) & (SEQ - 1);
#pragma unroll
            for (int h = 0; h < 2; ++h) {
              if ((fq >> 1) == h) {
#pragma unroll
                for (int m = 0; m < 4; ++m) {
                  const float rs = rsv[ai][m];
                  int fr_ = fr; asm volatile("" : "+v"(fr_));
                  const int rlm = (vkind == 0) ? 16 * m + vtidx(fr_) : (vkind == 1) ? 16 * (fr_ & 3) + vtidx(4 * m + (fr_ >> 2)) : 4 * fr_ + m;
                  LAS unsigned char* wp = scr + (8 * (fq & 1)) * 144 + rlm * 2;
#pragma unroll
                  for (int e = 0; e < 8; ++e) *(LAS bf16_t*)(wp + e * 144) = f2bf(acc[ai][bj][m][e >> 2][e & 3] * rs);
                }
              }
              asm volatile("s_waitcnt lgkmcnt(0)" ::: "memory");
              const unsigned vr = vrow0 + bj * 128 + 16 * h;
              if (vkind == 2) {
                const unsigned swc = ((P >> 6) & 3), sw = ((swc & 1) << 1) | (swc >> 1);
#pragma unroll
                for (int t = 0; t < 4; ++t) { const int q = lane + 64 * t, cl = q >> 4, r = q & 15;
                  const u32x2 w = *(const LAS u32x2*)(scr + cl * 144 + r * 8);
                  *(u32x2*)(vbase + ((vr + cl) * SEQ + r * 512 + ((P >> 4) & ~15u) + 4 * sw) * 2u) = w; }
              } else {
#pragma unroll
                for (int t = 0; t < 2; ++t) { const int q = lane + 64 * t, cl = q >> 3, pc = q & 7;
                  const u32x4 w = *(const LAS u32x4*)(scr + cl * 144 + pc * 16);
                  const unsigned lidx = (vkind == 0) ? P + 8 * pc : (pc >> 1) * 2048 + (P >> 2) + 8 * (pc & 1);
                  *(u32x4*)(vbase + ((vr + cl) * SEQ + lidx) * 2u) = w; }
              }
              asm volatile("s_waitcnt lgkmcnt(0)" ::: "memory");
            }
          }
        return;
      }
    }
#pragma unroll
    for (int ai = 0; ai < 2; ++ai) {
      f32x4 bpre[2][2][2];
      const bool rope64 = (kind == K_ODIN) && (pn < 12), rope32 = (kind == K_UQ && pn == 2) || (kind == K_EVIN && pn == 7 && wc == 0);
      if (rope64 || rope32) {
#pragma unroll
        for (int m = 0; m < 4; ++m) { const unsigned pos_ = ((unsigned)u.pm * 256 + ai * 128 + wr * 64 + m * 16 + fr) & (SEQ - 1);
          const unsigned toff = rope64 ? (pos_ * 32 + (wc & 1) * 16 + 4 * fq) * 4u : (pos_ * 16 + 4 * fq) * 4u;
          bpre[m >> 1][m & 1][0] = *(const f32x4*)((const char*)(rope64 ? cos64 : cos32) + toff); bpre[m >> 1][m & 1][1] = *(const f32x4*)((const char*)(rope64 ? sin64 : sin32) + toff); }
      }
#pragma unroll
      for (int m = 0; m < 4; ++m) {
        if (kind == K_RESID && (m & 1) == 0) {
#pragma unroll
          for (int mm = 0; mm < 2; ++mm)
#pragma unroll
            for (int bj = 0; bj < 2; ++bj) { const unsigned o = ((u.pm * 256 + ai * 128 + wr * 64 + (m + mm) * 16 + fr) * DM + pn * 256 + bj * 128 + wc * 32 + 8 * fq) * 4u;
              bpre[mm][bj][0] = *(const f32x4*)((const char*)base + o); bpre[mm][bj][1] = *(const f32x4*)((const char*)base + o + 16); }
        }
        const unsigned row = u.pm * 256 + ai * 128 + wr * 64 + m * 16 + fr;
        const unsigned b = row >> 13, pos = row & (SEQ - 1);
        const float rs = rsv[ai][m];
        float part = 0.f;
#pragma unroll
        for (int bj = 0; bj < 2; ++bj) {
          const unsigned col = pn * 256 + bj * 128 + wc * 32 + 8 * fq;
          f32x4 v0 = acc[ai][bj][m][0] * rs, v1 = acc[ai][bj][m][1] * rs;
          if (kind == K_RESID) {
            const unsigned o = (row * DM + col) * 4u;
            v0 += bpre[m & 1][bj][0]; v1 += bpre[m & 1][bj][1];
            *(f32x4*)((char*)outf + o) = v0; *(f32x4*)((char*)outf + o + 16) = v1;
            store8(ws + WS_XN, (row * DM + col) * 2u, v0, v1);
            part += (v0[0] * v0[0] + v0[1] * v0[1]) + (v0[2] * v0[2] + v0[3] * v0[3]) + (v1[0] * v1[0] + v1[1] * v1[1]) + (v1[2] * v1[2] + v1[3] * v1[3]);
          } else if (kind == K_RELU2) {
#pragma unroll
            for (int e = 0; e < 4; ++e) { float a = fmaxf(v0[e], 0.f), c = fmaxf(v1[e], 0.f); v0[e] = a * a; v1[e] = c * c; }
            store8(big, (row * FF + col) * 2u, v0, v1);
          } else if (kind == K_EVIN) {
            if (pn < 4) { const float sc = pn < 2 ? C_NA : 1.f; store8(big + B_QKNA, (row * 1024 + col) * 2u, v0 * sc, v1 * sc); }
            else if (pn < 6) { vt8(big + B_VTNA, ((b * 512 + (col - 1024)) * SEQ + vtidx(pos)) * 2u, v0, v1); }
            else if (pn == 6) { store8(big + B_CQN, (row * 256 + (col - 1536)) * 2u, v0, v1);
              part += (v0[0] * v0[0] + v0[1] * v0[1]) + (v0[2] * v0[2] + v0[3] * v0[3]) + (v1[0] * v1[0] + v1[1] * v1[1]) + (v1[2] * v1[2] + v1[3] * v1[3]); }
            else {
              if (bj == 0) { store8(big + B_CKVN, (row * 128 + (col - 1792)) * 2u, v0, v1);
                part += (v0[0] * v0[0] + v0[1] * v0[1]) + (v0[2] * v0[2] + v0[3] * v0[3]) + (v1[0] * v1[0] + v1[1] * v1[1]) + (v1[2] * v1[2] + v1[3] * v1[3]); }
              else if (wc == 0) { rope8(v0, v1, bpre[m >> 1][m & 1][0], bpre[m >> 1][m & 1][1]); store8(big + B_KPE, (row * 32 + 8 * fq) * 2u, v0, v1); }
            }
          } else if (kind == K_UQ) {
            if (pn == 2) rope8(v0, v1, bpre[m >> 1][m & 1][0], bpre[m >> 1][m & 1][1]);
            store8(big + B_QMLA, (row * 768 + col) * 2u, v0 * C_MLA, v1 * C_MLA);
          } else if (kind == K_UKV) {
            if (pn < 2) store8(big + B_KN, (row * 512 + col) * 2u, v0, v1);
            else vt8(big + B_VTMLA, ((b * 512 + (col - 512)) * SEQ + vtidx(pos)) * 2u, v0, v1);
          } else {
            const int s = pn >> 1;
            if (s < 6) {
              rope8(v0, v1, bpre[m >> 1][m & 1][0], bpre[m >> 1][m & 1][1]);
              const float sc = (s & 1) ? 1.f : C_NA;
              store8(big + B_QK, (row * 3072 + col) * 2u, v0 * sc, v1 * sc);
            } else {
              const int gq = s - 6, sh = 2 * gq;
              const unsigned lidx = ((pos & ((1u << sh) - 1)) << (13 - sh)) | (pos >> sh);
              vt8(big + B_VT, (((b * 3 + gq) * 512 + (col - s * 512)) * SEQ + vtidx(lidx)) * 2u, v0, v1);
            }
          }
        }
        if (kind == K_RESID || (kind == K_EVIN && pn >= 6)) {
          part += __shfl_xor(part, 16); part += __shfl_xor(part, 32);
          if (fq == 0) {
            if (kind == K_RESID) *(LAS float*)(lds + LDS_VT_OFF + ((ai * 128 + wr * 64 + m * 16 + fr) * 4 + wc) * 4) = part;
            else ((float*)(ws + (pn == 6 ? WS_SS_Q : WS_SS_KV)))[row * 4 + wc] = part;
          }
        }
      }
    }
    if (kind == K_RESID) {
      asm volatile("s_waitcnt lgkmcnt(0)" ::: "memory"); __builtin_amdgcn_s_barrier(); asm volatile("" ::: "memory");
      const int t_ = (wr * 4 + wc) * 64 + ln_;
      if (t_ < 256) { const f32x4 p = *(const LAS f32x4*)(lds + LDS_VT_OFF + t_ * 16); ss_out[(u.pm * 256 + t_) * 4 + pn] = (p[0] + p[1]) + (p[2] + p[3]); }
      asm volatile("s_waitcnt lgkmcnt(0)" ::: "memory"); __builtin_amdgcn_s_barrier(); asm volatile("" ::: "memory");
    }
  }
};

enum ColMap { CM_ID = 0, CM_EVIN = 1, CM_UQ = 2, CM_UKV = 3, CM_ODIN = 4 };
__device__ __forceinline__ int colmap(int kind, int n) {
  switch (kind) {
    case CM_EVIN: { if (n < 1920) return n; if (n >= 1952) return -1; const int j = n - 1920, k = j >> 1; return 1920 + ((j & 1) ? k + 16 : k); }
    case CM_UQ: { if (n < 512) return (n >> 6) * 96 + (n & 63); const int h = (n - 512) >> 5, j = (n - 512) & 31, k = j >> 1; return h * 96 + 64 + ((j & 1) ? k + 16 : k); }
    case CM_UKV: { if (n < 512) return (n >> 6) * 128 + (n & 63); const int n2 = n - 512; return (n2 >> 6) * 128 + 64 + (n2 & 63); }
    case CM_ODIN: { const int ch = n / OD_NC, n1 = n - ch * OD_NC, s = n1 >> 9, hl = (n1 & 511) >> 6, j = n1 & 63;
      int gq, t, js; if (s < 6) { gq = s >> 1; t = s & 1; const int k = j >> 1; js = (j & 1) ? k + 32 : k; } else { gq = s - 6; t = 2; js = j; }
      return ((gq * 3 + t) * 16 + (8 * ch + hl)) * 64 + js; }
    default: return n;
  }
}
__device__ __forceinline__ void transpose_item(const float* W, int K, int Nsrc, int Nout, bf16_t* WT, int cm, LAS float* scr, int item, int lane, const float* gain) {
  const int nblk = Nout / 32, kb = item / nblk, nb = item % nblk, k0 = 64 * kb, n0 = 32 * nb;
  const int sc = colmap(cm, n0 + (lane & 31));
  float wv[32];
#pragma unroll
  for (int i = 0; i < 32; ++i) { const int kk = 2 * i + (lane >> 5); wv[i] = sc >= 0 ? W[(size_t)(k0 + kk) * Nsrc + sc] : 0.f; }
#pragma unroll
  for (int i = 0; i < 32; ++i) { const int kk = 2 * i + (lane >> 5); const float gk = gain ? gain[k0 + kk] : 1.f; scr[kk * 33 + (lane & 31)] = wv[i] * gk; }
  asm volatile("s_waitcnt lgkmcnt(0)" ::: "memory");
  const int c = lane & 7;
#pragma unroll
  for (int j = 0; j < 4; ++j) { const int n = (lane >> 3) + 8 * j; const LAS float* s = scr + (8 * c) * 33 + n;
    u32x4 o; o.x = cvt_pk_bf16(s[0 * 33], s[1 * 33]); o.y = cvt_pk_bf16(s[2 * 33], s[3 * 33]); o.z = cvt_pk_bf16(s[4 * 33], s[5 * 33]); o.w = cvt_pk_bf16(s[6 * 33], s[7 * 33]);
    *(u32x4*)(WT + (size_t)(n0 + n) * K + k0 + 8 * c) = o; }
  asm volatile("s_waitcnt lgkmcnt(0)" ::: "memory");
}
__device__ __forceinline__ void rms_row_bf16(const float* xrow, const float* g, bf16_t* orow, int lane) {
  const f32x4* xr = (const f32x4*)xrow + lane; const f32x4* gr = (const f32x4*)g + lane;
  f32x4 v[4]; float s = 0.f;
#pragma unroll
  for (int j = 0; j < 4; ++j) { v[j] = xr[64 * j]; s += (v[j].x * v[j].x + v[j].y * v[j].y) + (v[j].z * v[j].z + v[j].w * v[j].w); }
  const float rstd = 1.f / sqrtf(wave_sum(s) * (1.f / DM) + RMS_EPS);
  u32x2* o8 = (u32x2*)orow + lane;
#pragma unroll
  for (int j = 0; j < 4; ++j) { const f32x4 gg = gr[64 * j]; u32x2 w; w.x = cvt_pk_bf16(v[j].x * rstd * gg.x, v[j].y * rstd * gg.y); w.y = cvt_pk_bf16(v[j].z * rstd * gg.z, v[j].w * rstd * gg.w); o8[64 * j] = w; }
}
__device__ __forceinline__ void rms_row_f32(const float* xrow, const float* g, float* orow, int lane) {
  const f32x4* xr = (const f32x4*)xrow + lane; const f32x4* gr = (const f32x4*)g + lane;
  f32x4 v[4]; float s = 0.f;
#pragma unroll
  for (int j = 0; j < 4; ++j) { v[j] = xr[64 * j]; s += (v[j].x * v[j].x + v[j].y * v[j].y) + (v[j].z * v[j].z + v[j].w * v[j].w); }
  const float rstd = 1.f / sqrtf(wave_sum(s) * (1.f / DM) + RMS_EPS);
  f32x4* o = (f32x4*)orow + lane;
#pragma unroll
  for (int j = 0; j < 4; ++j) { const f32x4 gg = gr[64 * j]; o[64 * j] = v[j] * rstd * gg; }
}
__device__ __forceinline__ void sincos_acc(float angf, float& sn, float& cs) {
  const double x = (double)angf;
  const double n = __builtin_rint(x * 0.63661977236758134308);
  double r = __builtin_fma(-n, 1.57079632679489655800e+00, x); r = __builtin_fma(-n, 6.12323399573676603587e-17, r);
  const double r2 = r * r;
  double sp = 1.0 / 6227020800.0; sp = sp * r2 - 1.0 / 39916800.0; sp = sp * r2 + 1.0 / 362880.0; sp = sp * r2 - 1.0 / 5040.0; sp = sp * r2 + 1.0 / 120.0; sp = sp * r2 - 1.0 / 6.0; sp = sp * r2 + 1.0; sp *= r;
  double cp = -1.0 / 87178291200.0; cp = cp * r2 + 1.0 / 479001600.0; cp = cp * r2 - 1.0 / 3628800.0; cp = cp * r2 + 1.0 / 40320.0; cp = cp * r2 - 1.0 / 720.0; cp = cp * r2 + 1.0 / 24.0; cp = cp * r2 - 0.5; cp = cp * r2 + 1.0;
  const int q = ((int)(long long)n) & 3;
  const double s_ = (q & 1) ? cp : sp, c_ = (q & 1) ? sp : cp;
  sn = (float)((q & 2) ? -s_ : s_);
  cs = (float)(((q + 1) & 2) ? -c_ : c_);
}

__device__ __forceinline__ int crow(int r, int hi) { return (r & 3) + 8 * (r >> 2) + 4 * hi; }
__device__ __forceinline__ float half_max(float m) { auto rr = __builtin_amdgcn_permlane32_swap(__float_as_uint(m), __float_as_uint(m), false, false); return fmaxf(__uint_as_float(rr[0]), __uint_as_float(rr[1])); }
__device__ __forceinline__ float half_sum(float m) { auto rr = __builtin_amdgcn_permlane32_swap(__float_as_uint(m), __float_as_uint(m), false, false); return __uint_as_float(rr[0]) + __uint_as_float(rr[1]); }
__device__ __forceinline__ bf16x8 ldg8(const unsigned char* base, unsigned off) { return *(const bf16x8*)(base + off); }
__device__ __forceinline__ void softmax_pv(f32x16& s, const bf16x8 (&vf)[4], f32x16& o0, f32x16& o1, float& mrun, float& lrun) {
  float mx = fmaxf(s[0], s[1]);
#pragma unroll
  for (int r = 2; r < 16; ++r) mx = fmaxf(mx, s[r]);
  mx = half_max(mx);
  const float mnew = fmaxf(mrun, mx), alpha = __builtin_amdgcn_exp2f(mrun - mnew); mrun = mnew;
#pragma unroll
  for (int r = 0; r < 16; ++r) s[r] = __builtin_amdgcn_exp2f(s[r] - mnew);
  const float ls = (((s[0] + s[1]) + (s[2] + s[3])) + ((s[4] + s[5]) + (s[6] + s[7]))) + (((s[8] + s[9]) + (s[10] + s[11])) + ((s[12] + s[13]) + (s[14] + s[15])));
  lrun = lrun * alpha + ls;
  if (__builtin_amdgcn_ballot_w64(alpha != 1.f) != 0ull) {
#pragma unroll
    for (int r = 0; r < 16; ++r) { o0[r] *= alpha; o1[r] *= alpha; }
  }
  u32x4 w0, w1;
  w0.x = cvt_pk_bf16(s[0], s[1]); w0.y = cvt_pk_bf16(s[2], s[3]); w0.z = cvt_pk_bf16(s[4], s[5]); w0.w = cvt_pk_bf16(s[6], s[7]);
  w1.x = cvt_pk_bf16(s[8], s[9]); w1.y = cvt_pk_bf16(s[10], s[11]); w1.z = cvt_pk_bf16(s[12], s[13]); w1.w = cvt_pk_bf16(s[14], s[15]);
  const bf16x8 p0 = __builtin_bit_cast(bf16x8, w0), p1 = __builtin_bit_cast(bf16x8, w1);
  o0 = __builtin_amdgcn_mfma_f32_32x32x16_bf16(vf[0], p0, o0, 0, 0, 0); o0 = __builtin_amdgcn_mfma_f32_32x32x16_bf16(vf[1], p1, o0, 0, 0, 0);
  o1 = __builtin_amdgcn_mfma_f32_32x32x16_bf16(vf[2], p0, o1, 0, 0, 0); o1 = __builtin_amdgcn_mfma_f32_32x32x16_bf16(vf[3], p1, o1, 0, 0, 0);
}
__device__ __forceinline__ void store_ot(unsigned char* base, unsigned rowoff, const f32x16& o0, const f32x16& o1, float il, int hi) {
#pragma unroll
  for (int a = 0; a < 4; ++a) {
    u32x2 w; w.x = cvt_pk_bf16(o0[4 * a] * il, o0[4 * a + 1] * il); w.y = cvt_pk_bf16(o0[4 * a + 2] * il, o0[4 * a + 3] * il);
    *(u32x2*)(base + rowoff + (8 * a + 4 * hi) * 2) = w;
    u32x2 v; v.x = cvt_pk_bf16(o1[4 * a] * il, o1[4 * a + 1] * il); v.y = cvt_pk_bf16(o1[4 * a + 2] * il, o1[4 * a + 3] * il);
    *(u32x2*)(base + rowoff + (32 + 8 * a + 4 * hi) * 2) = v;
  }
}

constexpr int LDS_OST_OFF = 77824, LDS_OST_WAVE = 4608;
__device__ __forceinline__ void store_ot_rows(LAS unsigned char* ol, unsigned char* base, unsigned rowoff0, unsigned rowstride, const f32x16& o0, const f32x16& o1, float il, int r32, int hi, int lane) {
#pragma unroll
  for (int a = 0; a < 4; ++a) {
    u32x2 w; w.x = cvt_pk_bf16(o0[4 * a] * il, o0[4 * a + 1] * il); w.y = cvt_pk_bf16(o0[4 * a + 2] * il, o0[4 * a + 3] * il);
    *(LAS u32x2*)(ol + r32 * 144 + (8 * a + 4 * hi) * 2) = w;
    u32x2 v; v.x = cvt_pk_bf16(o1[4 * a] * il, o1[4 * a + 1] * il); v.y = cvt_pk_bf16(o1[4 * a + 2] * il, o1[4 * a + 3] * il);
    *(LAS u32x2*)(ol + r32 * 144 + (32 + 8 * a + 4 * hi) * 2) = v;
  }
#pragma unroll
  for (int t = 0; t < 4; ++t) { const int p = lane + 64 * t, row = p >> 3, c = p & 7;
    const u32x4 w = *(const LAS u32x4*)(ol + row * 144 + c * 16);
    *(u32x4*)(base + rowoff0 + (unsigned)row * rowstride + c * 16) = w; }
}

constexpr int MLA_STEP_BYTES = 40960, MLA_NSTEP = SEQ / 128;
#define MLA_QBLOCK(S, O0, O1, NEGM, MREF, LRUN, FIRST) do { \
    S = S - MREF; \
    float mx_ = fmaxf(fmaxf(S[0], S[1]), fmaxf(S[2], S[3])); \
    _Pragma("unroll") for (int r = 4; r < 16; r += 4) mx_ = fmaxf(mx_, fmaxf(fmaxf(S[r], S[r + 1]), fmaxf(S[r + 2], S[r + 3]))); \
    mx_ = half_max(mx_); \
    if ((FIRST) || __builtin_amdgcn_ballot_w64(mx_ > 8.f) != 0ull) { \
      const float delta_ = (FIRST) ? mx_ : fmaxf(mx_, 0.f); MREF += delta_; \
      S = S - delta_; \
      if (!(FIRST)) { const float alpha_ = __builtin_amdgcn_exp2f(-delta_); LRUN *= alpha_; O0 = O0 * alpha_; O1 = O1 * alpha_; } } \
    _Pragma("unroll") for (int r = 0; r < 16; ++r) S[r] = __builtin_amdgcn_exp2f(S[r]); \
    LRUN += (((S[0] + S[1]) + (S[2] + S[3])) + ((S[4] + S[5]) + (S[6] + S[7]))) + (((S[8] + S[9]) + (S[10] + S[11])) + ((S[12] + S[13]) + (S[14] + S[15]))); } while (0)
__device__ __forceinline__ void mla_attn_phase(unsigned char* big, unsigned char* att, LAS unsigned char* lds, int bx, int G, int wave, int lane) {
  const int r32 = lane & 31, hi = lane >> 5;
  for (int u = bx; u < 256; u += G) {
    const int ux = u & 7, ui = u >> 3, bh = ((ux << 1) + (ui >> 4)) & 15, qb = ui & 15, b = bh >> 3, h = bh & 7;
    const unsigned m0 = b * SEQ + qb * 512 + wave * 64 + r32;
    bf16x8 qa[6], qb2[6];
#pragma unroll
    for (int c = 0; c < 4; ++c) { qa[c] = ldg8(big + B_QMLA, (m0 * 768 + h * 64 + 16 * c + 8 * hi) * 2u); qb2[c] = ldg8(big + B_QMLA, ((m0 + 32) * 768 + h * 64 + 16 * c + 8 * hi) * 2u); }
#pragma unroll
    for (int c = 0; c < 2; ++c) { qa[4 + c] = ldg8(big + B_QMLA, (m0 * 768 + 512 + h * 32 + 16 * c + 8 * hi) * 2u); qb2[4 + c] = ldg8(big + B_QMLA, ((m0 + 32) * 768 + 512 + h * 32 + 16 * c + 8 * hi) * 2u); }
    const unsigned char* kn = big + B_KN + ((size_t)b * SEQ * 512 + h * 64) * 2;
    const unsigned char* kp = big + B_KPE + ((size_t)b * SEQ * 32) * 2;
    const unsigned char* vt = big + B_VTMLA + ((size_t)(b * 8 + h) * 64 * SEQ) * 2;
    const unsigned char* sbase[5]; unsigned sstride[5], loff[5];
#pragma unroll
    for (int i = 0; i < 5; ++i) {
      const int sl = wave * 5 + i, tt = sl / 10, f = sl % 10;
      if (f < 4) { sbase[i] = kn + (size_t)tt * (32 * 512 * 2); loff[i] = (r32 * 512 + 16 * f + 8 * hi) * 2u; sstride[i] = 128 * 512 * 2; }
      else if (f < 6) { sbase[i] = kp + (size_t)tt * (32 * 32 * 2); loff[i] = (r32 * 32 + 16 * (f - 4) + 8 * hi) * 2u; sstride[i] = 128 * 32 * 2; }
      else { const int d0 = (f - 6) >> 1, j = (f - 6) & 1; sbase[i] = vt + (size_t)tt * 64; loff[i] = ((d0 * 32 + r32) * SEQ + 16 * j + 8 * hi) * 2u; sstride[i] = 256; }
    }
#define MLA_ISSUE(st, rs) do { _Pragma("unroll") for (int i = 0; i < 5; ++i) \
      __builtin_amdgcn_global_load_lds((const unsigned*)(sbase[i] + (size_t)(st) * sstride[i] + loff[i]), (LAS unsigned*)(lds + (rs) * MLA_STEP_BYTES + (wave * 5 + i) * 1024), 16, 0, 0); } while (0)
#define MLA_LD(base, idx) (*(const LAS bf16x8*)(lds + (base) + (idx) * 1024 + lane * 16))
    const f32x16 z16 = {0.f, 0.f, 0.f, 0.f, 0.f, 0.f, 0.f, 0.f, 0.f, 0.f, 0.f, 0.f, 0.f, 0.f, 0.f, 0.f};
    f32x16 oA0 = z16, oA1 = z16, oB0 = z16, oB1 = z16;
    float mrefA = 0.f, mrefB = 0.f, lA = 0.f, lB = 0.f;
    MLA_ISSUE(0, 0); MLA_ISSUE(1, 1);
    int rs = 0;
    for (int st = 0; st < MLA_NSTEP; ++st) {
      if (st + 1 < MLA_NSTEP) asm volatile("s_waitcnt vmcnt(5)" ::: "memory"); else asm volatile("s_waitcnt vmcnt(0)" ::: "memory");
      __builtin_amdgcn_s_barrier();
      asm volatile("" ::: "memory");
      if (st + 2 < MLA_NSTEP) { const int rn = (rs >= 1) ? rs - 1 : 2; MLA_ISSUE(st + 2, rn); }
      const int sb = rs * MLA_STEP_BYTES;
#pragma unroll 1
      for (int tt = 0; tt < 4; ++tt) {
        const int tb = sb + tt * 10240;
        bf16x8 kf[6], vf[4];
#pragma unroll
        for (int c = 0; c < 6; ++c) kf[c] = MLA_LD(tb, c);
        f32x16 sA = __builtin_amdgcn_mfma_f32_32x32x16_bf16(kf[0], qa[0], z16, 0, 0, 0), sB = __builtin_amdgcn_mfma_f32_32x32x16_bf16(kf[0], qb2[0], z16, 0, 0, 0);
#pragma unroll
        for (int c = 1; c < 6; ++c) { sA = __builtin_amdgcn_mfma_f32_32x32x16_bf16(kf[c], qa[c], sA, 0, 0, 0); sB = __builtin_amdgcn_mfma_f32_32x32x16_bf16(kf[c], qb2[c], sB, 0, 0, 0); }
#pragma unroll
        for (int c = 0; c < 4; ++c) vf[c] = MLA_LD(tb, 6 + c);
        const bool first = (st == 0) && (tt == 0);
        MLA_QBLOCK(sA, oA0, oA1, 0, mrefA, lA, first);
        MLA_QBLOCK(sB, oB0, oB1, 0, mrefB, lB, first);
        u32x4 w0, w1, w2, w3;
        w0.x = cvt_pk_bf16(sA[0], sA[1]); w0.y = cvt_pk_bf16(sA[2], sA[3]); w0.z = cvt_pk_bf16(sA[4], sA[5]); w0.w = cvt_pk_bf16(sA[6], sA[7]);
        w1.x = cvt_pk_bf16(sA[8], sA[9]); w1.y = cvt_pk_bf16(sA[10], sA[11]); w1.z = cvt_pk_bf16(sA[12], sA[13]); w1.w = cvt_pk_bf16(sA[14], sA[15]);
        w2.x = cvt_pk_bf16(sB[0], sB[1]); w2.y = cvt_pk_bf16(sB[2], sB[3]); w2.z = cvt_pk_bf16(sB[4], sB[5]); w2.w = cvt_pk_bf16(sB[6], sB[7]);
        w3.x = cvt_pk_bf16(sB[8], sB[9]); w3.y = cvt_pk_bf16(sB[10], sB[11]); w3.z = cvt_pk_bf16(sB[12], sB[13]); w3.w = cvt_pk_bf16(sB[14], sB[15]);
        const bf16x8 pA0 = __builtin_bit_cast(bf16x8, w0), pA1 = __builtin_bit_cast(bf16x8, w1), pB0 = __builtin_bit_cast(bf16x8, w2), pB1 = __builtin_bit_cast(bf16x8, w3);
        oA0 = __builtin_amdgcn_mfma_f32_32x32x16_bf16(vf[0], pA0, oA0, 0, 0, 0); oB0 = __builtin_amdgcn_mfma_f32_32x32x16_bf16(vf[0], pB0, oB0, 0, 0, 0);
        oA1 = __builtin_amdgcn_mfma_f32_32x32x16_bf16(vf[2], pA0, oA1, 0, 0, 0); oB1 = __builtin_amdgcn_mfma_f32_32x32x16_bf16(vf[2], pB0, oB1, 0, 0, 0);
        oA0 = __builtin_amdgcn_mfma_f32_32x32x16_bf16(vf[1], pA1, oA0, 0, 0, 0); oB0 = __builtin_amdgcn_mfma_f32_32x32x16_bf16(vf[1], pB1, oB0, 0, 0, 0);
        oA1 = __builtin_amdgcn_mfma_f32_32x32x16_bf16(vf[3], pA1, oA1, 0, 0, 0); oB1 = __builtin_amdgcn_mfma_f32_32x32x16_bf16(vf[3], pB1, oB1, 0, 0, 0);
      }
      asm volatile("s_waitcnt lgkmcnt(0)" ::: "memory");
      rs = (rs == 2) ? 0 : rs + 1;
    }
#undef MLA_LD
#undef MLA_ISSUE
    const float ilA = 1.f / half_sum(lA), ilB = 1.f / half_sum(lB);
    store_ot(att, (m0 * 1024 + 512 + h * 64) * 2u, oA0, oA1, ilA, hi);
    store_ot(att, ((m0 + 32) * 1024 + 512 + h * 64) * 2u, oB0, oB1, ilB, hi);
    __builtin_amdgcn_s_barrier();
  }
}
#undef MLA_QBLOCK

constexpr int ATL_K = 0, ATL_V = 4608, ATL_WAVE = 9728;
#define ATL_LOAD(SK, SV, kbase, kpitch, vbase) do { \
    _Pragma("unroll") for (int i_ = 0; i_ < 4; ++i_) SK[i_] = *(const u32x4*)((kbase) + (size_t)(8 * i_ + (lane >> 3)) * (kpitch) + (lane & 7) * 16); \
    _Pragma("unroll") for (int i_ = 0; i_ < 4; ++i_) SV[i_] = *(const u32x4*)((vbase) + (size_t)(16 * i_ + (lane >> 2)) * (SEQ * 2) + (lane & 3) * 16); } while (0)
#define ATL_COMMIT(SK, SV, wl) do { \
    _Pragma("unroll") for (int i_ = 0; i_ < 4; ++i_) *(LAS u32x4*)((wl) + ATL_K + (8 * i_ + (lane >> 3)) * 144 + (lane & 7) * 16) = SK[i_]; \
    _Pragma("unroll") for (int i_ = 0; i_ < 4; ++i_) *(LAS u32x4*)((wl) + ATL_V + (16 * i_ + (lane >> 2)) * 80 + (lane & 3) * 16) = SV[i_]; } while (0)
#define ATL_FRAGS(KF, VF, wl) do { \
    _Pragma("unroll") for (int c_ = 0; c_ < 4; ++c_) KF[c_] = *(const LAS bf16x8*)((wl) + ATL_K + r32 * 144 + (2 * c_ + hi) * 16); \
    _Pragma("unroll") for (int d_ = 0; d_ < 2; ++d_) _Pragma("unroll") for (int j_ = 0; j_ < 2; ++j_) VF[2 * d_ + j_] = *(const LAS bf16x8*)((wl) + ATL_V + (32 * d_ + r32) * 80 + (2 * j_ + hi) * 16); } while (0)

__device__ __forceinline__ void na_attn_phase(unsigned char* big, unsigned char* att, const float* rpb, int gw, int NGW, int lane, LAS unsigned char* wl, LAS unsigned char* ol) {
  const int r32 = lane & 31, hi = lane >> 5;
  for (int wt = gw; wt < 4096; wt += NGW) {
    const int w = wt & 1, h = (wt >> 1) & 7, r = (wt >> 4) & 127, b = wt >> 11;
    const int rs = min(max(r - 4, 0), 120), c = 32 * w + r32, cs = min(max(c - 8, 0), 48);
    const unsigned m0 = b * SEQ + r * 64 + c;
    bf16x8 qf[4];
#pragma unroll
    for (int cc = 0; cc < 4; ++cc) qf[cc] = ldg8(big + B_QKNA, (m0 * 1024 + h * 64 + 16 * cc + 8 * hi) * 2u);
    const unsigned char* kb = big + B_QKNA + ((size_t)(b * SEQ + rs * 64) * 1024 + 512 + h * 64) * 2;
    const unsigned char* vt = big + B_VTNA + ((size_t)(b * 8 + h) * 64 * SEQ + rs * 64) * 2;
    const unsigned ko = (r32 * 1024 + 8 * hi) * 2u, vto = (r32 * SEQ + 8 * hi) * 2u;
    const float* bias_h = rpb + h * 15 * 31;
    f32x16 o0 = {0.f, 0.f, 0.f, 0.f, 0.f, 0.f, 0.f, 0.f, 0.f, 0.f, 0.f, 0.f, 0.f, 0.f, 0.f, 0.f}, o1 = o0;
    float mrun = NEG_BIG, lrun = 0.f;
    u32x4 sk[4], sv[4]; bf16x8 kf[4], vf[4];
#define NA_LOAD(t) ATL_LOAD(sk, sv, kb + (size_t)(t) * (32 * 1024 * 2), 2048, vt + (size_t)(t) * 64)
#define NA_COMP(KF, VF, i, half) do { \
      f32x16 s = {0.f, 0.f, 0.f, 0.f, 0.f, 0.f, 0.f, 0.f, 0.f, 0.f, 0.f, 0.f, 0.f, 0.f, 0.f, 0.f}; \
      _Pragma("unroll") for (int cc = 0; cc < 4; ++cc) s = __builtin_amdgcn_mfma_f32_32x32x16_bf16(KF[cc], qf[cc], s, 0, 0, 0); \
      const float* brow = bias_h + (rs + (i) - r + 7) * 31; \
      int c_ = c, cs_ = cs; asm volatile("" : "+v"(c_), "+v"(cs_));     \
      float bvv[16]; \
      _Pragma("unroll") for (int rr = 0; rr < 16; ++rr) { const int rel = 32 * (half) + crow(rr, hi) - c_ + 15; bvv[rr] = brow[min(max(rel, 0), 30)]; } \
      _Pragma("unroll") for (int rr = 0; rr < 16; ++rr) asm volatile("" : "+v"(bvv[rr]));     \
      _Pragma("unroll") for (int rr = 0; rr < 16; ++rr) { \
        const int kc = 32 * (half) + crow(rr, hi); \
        const bool ok = (kc >= cs_) && (kc < cs_ + 16); \
        s[rr] = ok ? s[rr] + bvv[rr] * LOG2E : NEG_BIG; } \
      softmax_pv(s, VF, o0, o1, mrun, lrun); } while (0)
    NA_LOAD(0); ATL_COMMIT(sk, sv, wl); NA_LOAD(1);
    for (int i = 0; i < 8; ++i) {
      ATL_FRAGS(kf, vf, wl); ATL_COMMIT(sk, sv, wl); if (i < 7) NA_LOAD(2 * i + 2);
      NA_COMP(kf, vf, i, 0);
      ATL_FRAGS(kf, vf, wl); if (i < 7) { ATL_COMMIT(sk, sv, wl); NA_LOAD(2 * i + 3); }
      NA_COMP(kf, vf, i, 1);
    }
#undef NA_LOAD
#undef NA_COMP
    const float il = 1.f / half_sum(lrun);
    store_ot(att, (m0 * 1024 + h * 64) * 2u, o0, o1, il, hi);
  }
}

struct DilWT { unsigned mq; int gq, sh, rho, i0, nseq; const unsigned char* vt; };
__device__ __forceinline__ DilWT dil_wt(int wt, int b, int hl, int P0, int r32, const unsigned char* big) {
  DilWT w; w.gq = wt >> 4; const int j = wt & 15; w.sh = 2 * w.gq;
  w.rho = (w.gq == 0) ? 0 : (w.gq == 1) ? (j >> 2) : j; const int it = (w.gq == 0) ? j : (w.gq == 1) ? (j & 3) : 0;
  w.i0 = (P0 >> w.sh) + 32 * it; w.nseq = SEQ >> w.sh;
  w.mq = b * SEQ + ((w.i0 + r32) << w.sh) + w.rho;
  w.vt = big + B_VT + ((size_t)((b * 3 + w.gq) * 8 + hl) * 64 * SEQ + w.rho * w.nseq) * 2;
  return w;
}
__device__ __forceinline__ void dil_attn_phase(unsigned char* big, unsigned char* att, int ch, int bx, int G, int wave, int lane, int tid, LAS unsigned char* wl, LAS unsigned char* ol) {
  const int r32 = lane & 31, hi = lane >> 5;
  float* lse = (float*)(big + B_LSE);
  for (int u = bx; u < 256; u += G) {
    const int ux = u & 7, ui = u >> 3, bhl = ((ux << 1) + (ui >> 4)) & 15, b = bhl >> 3, hl = bhl & 7, P0 = (ui & 15) * 512;
    f32x16 o0, o1; float mrun, lrun;
    bf16x8 qx[4], qy[4], kf[4], vf[4]; u32x4 sk[4], sv[4];
#define DIL_LOADQ(Q, W) do { _Pragma("unroll") for (int cc = 0; cc < 4; ++cc) Q[cc] = ldg8(big + B_QK, (W.mq * 3072 + W.gq * 1024 + hl * 64 + 16 * cc + 8 * hi) * 2u); } while (0)
#define DIL_LOAD(W, T) do { const int k0_ = W.i0 - 64 + 32 * (T), k0c_ = min(max(k0_, 0), W.nseq - 32); \
      ATL_LOAD(sk, sv, big + B_QK + ((size_t)(b * SEQ + (k0c_ << W.sh) + W.rho) * 3072 + W.gq * 1024 + 512 + hl * 64) * 2, ((size_t)6144 << W.sh), W.vt + (size_t)k0c_ * 2); } while (0)
#define DIL_COMP(KF, VF, Q, W, T) do { \
      if ((T) == 0) { _Pragma("unroll") for (int rr = 0; rr < 16; ++rr) { o0[rr] = 0.f; o1[rr] = 0.f; } mrun = NEG_BIG; lrun = 0.f; } \
      const int k0_ = W.i0 - 64 + 32 * (T); const bool tv_ = (k0_ >= 0) && (k0_ < W.nseq); \
      if (tv_) { \
      f32x16 s = {0.f, 0.f, 0.f, 0.f, 0.f, 0.f, 0.f, 0.f, 0.f, 0.f, 0.f, 0.f, 0.f, 0.f, 0.f, 0.f}; \
      _Pragma("unroll") for (int cc = 0; cc < 4; ++cc) s = __builtin_amdgcn_mfma_f32_32x32x16_bf16(KF[cc], Q[cc], s, 0, 0, 0); \
      _Pragma("unroll") for (int rr = 0; rr < 16; ++rr) { \
        const bool ok_ = ((T) == 0 ? (crow(rr, hi) >= r32) : (T) == 4 ? (crow(rr, hi) <= r32) : true); \
        s[rr] = ok_ ? s[rr] : NEG_BIG; } \
      softmax_pv(s, VF, o0, o1, mrun, lrun); } \
      if ((T) == 4) { const float lt_ = half_sum(lrun), il_ = 1.f / lt_; \
        store_ot_rows(ol, big + B_QK, ((unsigned)(b * SEQ + (W.i0 << W.sh) + W.rho) * 3072 + W.gq * 1024 + hl * 64) * 2u, 6144u << W.sh, o0, o1, il_, r32, hi, lane); \
        if (hi == 0) lse[(W.mq * 8 + hl) * 3 + W.gq] = mrun + __builtin_amdgcn_logf(lt_); } } while (0)
    DilWT WX = dil_wt(wave, b, hl, P0, r32, big), WY = WX;
    DIL_LOADQ(qx, WX); DIL_LOAD(WX, 0); ATL_COMMIT(sk, sv, wl); DIL_LOAD(WX, 1);
    for (int pair = 0; pair < 3; ++pair) {
      WY = dil_wt(wave + 8 * (2 * pair + 1), b, hl, P0, r32, big);
      ATL_FRAGS(kf, vf, wl); ATL_COMMIT(sk, sv, wl); DIL_LOAD(WX, 2); DIL_COMP(kf, vf, qx, WX, 0);
      ATL_FRAGS(kf, vf, wl); ATL_COMMIT(sk, sv, wl); DIL_LOAD(WX, 3); DIL_COMP(kf, vf, qx, WX, 1);
      ATL_FRAGS(kf, vf, wl); ATL_COMMIT(sk, sv, wl); DIL_LOAD(WX, 4); DIL_COMP(kf, vf, qx, WX, 2);
      ATL_FRAGS(kf, vf, wl); ATL_COMMIT(sk, sv, wl); DIL_LOADQ(qy, WY); DIL_LOAD(WY, 0); DIL_COMP(kf, vf, qx, WX, 3);
      ATL_FRAGS(kf, vf, wl); ATL_COMMIT(sk, sv, wl); DIL_LOAD(WY, 1); DIL_COMP(kf, vf, qx, WX, 4);
      ATL_FRAGS(kf, vf, wl); ATL_COMMIT(sk, sv, wl); DIL_LOAD(WY, 2); DIL_COMP(kf, vf, qy, WY, 0);
      ATL_FRAGS(kf, vf, wl); ATL_COMMIT(sk, sv, wl); DIL_LOAD(WY, 3); DIL_COMP(kf, vf, qy, WY, 1);
      ATL_FRAGS(kf, vf, wl); ATL_COMMIT(sk, sv, wl); DIL_LOAD(WY, 4); DIL_COMP(kf, vf, qy, WY, 2);
      ATL_FRAGS(kf, vf, wl); ATL_COMMIT(sk, sv, wl);
      if (pair < 2) { WX = dil_wt(wave + 8 * (2 * pair + 2), b, hl, P0, r32, big); DIL_LOADQ(qx, WX); DIL_LOAD(WX, 0); }
      DIL_COMP(kf, vf, qy, WY, 3);
      ATL_FRAGS(kf, vf, wl);
      if (pair < 2) { ATL_COMMIT(sk, sv, wl); DIL_LOAD(WX, 1); }
      DIL_COMP(kf, vf, qy, WY, 4);
    }
#undef DIL_LOADQ
#undef DIL_LOAD
#undef DIL_COMP
    __syncthreads();
    {
#pragma unroll 2
      for (int i = 0; i < 8; ++i) {
        const unsigned m = b * SEQ + P0 + 64 * i + (tid >> 3); const unsigned pc = (tid & 7) * 16;
        const float l0 = lse[(m * 8 + hl) * 3 + 0], l1 = lse[(m * 8 + hl) * 3 + 1], l2 = lse[(m * 8 + hl) * 3 + 2];
        float a0[8], a1[8], a2[8];
        unpack8(*(const u32x4*)(big + B_QK + ((size_t)m * 3072 + 0 * 1024 + hl * 64) * 2 + pc), a0);
        unpack8(*(const u32x4*)(big + B_QK + ((size_t)m * 3072 + 1 * 1024 + hl * 64) * 2 + pc), a1);
        unpack8(*(const u32x4*)(big + B_QK + ((size_t)m * 3072 + 2 * 1024 + hl * 64) * 2 + pc), a2);
        const float lm = fmaxf(l0, fmaxf(l1, l2));
        float w0 = __builtin_amdgcn_exp2f(l0 - lm), w1 = __builtin_amdgcn_exp2f(l1 - lm), w2 = __builtin_amdgcn_exp2f(l2 - lm);
        const float iw = 1.f / (w0 + w1 + w2); w0 *= iw; w1 *= iw; w2 *= iw;
        float f[8];
#pragma unroll
        for (int e = 0; e < 8; ++e) f[e] = w0 * a0[e] + w1 * a1[e] + w2 * a2[e];
        u32x4 wv; wv.x = cvt_pk_bf16(f[0], f[1]); wv.y = cvt_pk_bf16(f[2], f[3]); wv.z = cvt_pk_bf16(f[4], f[5]); wv.w = cvt_pk_bf16(f[6], f[7]);
        *(u32x4*)(att + ((size_t)m * 1024 + (8 * ch + hl) * 64) * 2 + pc) = wv;
      }
    }
    __syncthreads();
  }
}

#define XB_TMO      128
#define XB_XCNT(j)  (256  + 64 * (j))
#define XB_XSUB(j)  (1280 + 64 * (j))
#define XB_XGEN(j)  (2304 + 64 * (j))
#define XB_TOP      3328
#define XB_TOPGEN   3392
#define XCD_BAR_WORDS 3456
#define XB_SPIN_CAP (1u << 18)
__device__ __forceinline__ unsigned xb_ld(unsigned* p)              { return __hip_atomic_load(p, __ATOMIC_RELAXED, __HIP_MEMORY_SCOPE_AGENT); }
__device__ __forceinline__ unsigned xb_add(unsigned* p, unsigned v) { return __hip_atomic_fetch_add(p, v, __ATOMIC_RELAXED, __HIP_MEMORY_SCOPE_AGENT); }
__device__ __forceinline__ unsigned xb_xcc_id() { return (unsigned)__builtin_amdgcn_s_getreg((3 << 11) | 20) & 0xFu; }
#define XB_SPIN(cond, bar) do { unsigned _sp = 0; while (cond) { __builtin_amdgcn_s_sleep(1); \
    if ((++_sp & 255u) == 0u) { if (xb_ld(&(bar)[XB_TMO])) break; if (_sp > XB_SPIN_CAP) { atomicAdd(&(bar)[XB_TMO], 1u); break; } } } } while (0)
struct XcdBarrier { unsigned* bar; unsigned x; volatile LAS unsigned* st; };
__device__ __forceinline__ XcdBarrier xcd_barrier_post(unsigned* bar, volatile LAS unsigned* st) {
  XcdBarrier b; b.bar = bar; b.x = xb_xcc_id(); b.st = st;
  if (threadIdx.x == 0) (void)xb_add(&bar[XB_XCNT(b.x)], 1u);
  return b;
}
__device__ __forceinline__ void xcd_barrier_complete(unsigned* bar, unsigned x, unsigned& nloc, unsigned& nx) {
  const unsigned G = gridDim.x * gridDim.y * gridDim.z;
  unsigned sum, cnt, mine, sp = 0u;
  for (;;) {
    sum = 0u; cnt = 0u; mine = 0u;
#pragma unroll
    for (unsigned j = 0; j < 16; ++j) { const unsigned c = xb_ld(&bar[XB_XCNT(j)]); sum += c; cnt += (c > 0u) ? 1u : 0u; mine = (j == x) ? c : mine; }
    if (sum == G) break;
    __builtin_amdgcn_s_sleep(1);
    if ((++sp & 255u) == 0u) { if (xb_ld(&bar[XB_TMO])) break; if (sp > XB_SPIN_CAP) { atomicAdd(&bar[XB_TMO], 1u); break; } }
  }
  nloc = mine > 0u ? mine : 1u; nx = cnt > 0u ? cnt : 1u;
}
__device__ __forceinline__ void xcd_barrier(const XcdBarrier& b) {
  asm volatile("s_waitcnt vmcnt(0)" ::: "memory");
  __syncthreads();
  if (threadIdx.x == 0) {
    unsigned* bar = b.bar;
    __builtin_amdgcn_s_waitcnt(0);
    unsigned nloc = b.st[0], nx = b.st[1];
    if (nloc == 0u) { xcd_barrier_complete(bar, b.x, nloc, nx); b.st[0] = nloc; b.st[1] = nx; }
    const unsigned old = xb_add(&bar[XB_XSUB(b.x)], 1u);
    const unsigned gen = old / nloc;
    if (old + 1u == (gen + 1u) * nloc) {
      __builtin_amdgcn_fence(__ATOMIC_RELEASE, "agent");
      asm volatile("s_waitcnt vmcnt(0)" ::: "memory");
      const unsigned og = xb_add(&bar[XB_TOP], 1u);
      const unsigned tg = og / nx;
      if (og + 1u == (tg + 1u) * nx) xb_add(&bar[XB_TOPGEN], 1u);
      else XB_SPIN(xb_ld(&bar[XB_TOPGEN]) == tg, bar);
      __builtin_amdgcn_fence(__ATOMIC_ACQUIRE, "agent");
      xb_add(&bar[XB_XGEN(b.x)], 1u);
      asm volatile("s_waitcnt vmcnt(0)" ::: "memory");
    } else {
      XB_SPIN(xb_ld(&bar[XB_XGEN(b.x)]) == gen, bar);
      __builtin_amdgcn_fence(__ATOMIC_ACQUIRE, "agent");
      asm volatile("s_waitcnt vmcnt(0)" ::: "memory");
    }
  }
  __syncthreads();
}

__device__ __forceinline__ const void* ldptr(LAS unsigned char* lds, int i) {
  const volatile LAS unsigned* p = (const volatile LAS unsigned*)(lds + 131072) + 2 * i;
  const unsigned lo = __builtin_amdgcn_readfirstlane(p[0]), hi = __builtin_amdgcn_readfirstlane(p[1]);
  return (const void*)(((unsigned long long)hi << 32) | lo);
}
struct Args { const float* in[15]; float* out; unsigned char* ws; int ph_lo, ph_hi; };

__global__ void __launch_bounds__(512, 2) fwd(Args a) {
  extern __shared__ __attribute__((aligned(16))) unsigned char lds_raw[];
  LAS unsigned char* lds = (LAS unsigned char*)lds_raw;
  cg::grid_group grid = cg::this_grid();
  const int G = gridDim.x, bx = blockIdx.x;
  const int gsz = G * 512, NGW = G * 8;
  if (threadIdx.x < 15) ((LAS unsigned long long*)(lds + 131072))[threadIdx.x] = (unsigned long long)a.in[threadIdx.x];
  if (threadIdx.x == 15) ((LAS unsigned long long*)(lds + 131072))[15] = (unsigned long long)a.out;
  if (threadIdx.x == 16) ((LAS unsigned long long*)(lds + 131072))[16] = (unsigned long long)a.ws;
  if (threadIdx.x == 17) { ((LAS unsigned*)(lds + 131072 + 256))[0] = 0u; ((LAS unsigned*)(lds + 131072 + 256))[1] = 0u; }
  if (bx == 0) for (int i = threadIdx.x; i < XCD_BAR_WORDS; i += 512) ((unsigned*)a.ws)[i] = 0u;
  __syncthreads();
  XcdBarrier xbar; xbar.bar = (unsigned*)a.ws; xbar.x = 0; xbar.st = (volatile LAS unsigned*)(lds + 131072 + 256);
#define INP(i) ((const float*)ldptr(lds, (i)))

  if (a.ph_lo == 0) {
    const int gtid0 = bx * 512 + threadIdx.x;
    float* cos64 = (float*)(a.ws + WS_COS64); float* sin64 = (float*)(a.ws + WS_SIN64); float* cos32 = (float*)(a.ws + WS_COS32); float* sin32 = (float*)(a.ws + WS_SIN32);
    for (int i = gtid0; i < SEQ * 32; i += gsz) { const int pos = i >> 5, kk = i & 31; float sn, cs; sincos_acc((float)pos * INV64[kk], sn, cs); cos64[i] = cs; sin64[i] = sn; }
    for (int i = gtid0; i < SEQ * 16; i += gsz) { const int pos = i >> 4, kk = i & 15; float sn, cs; sincos_acc((float)pos * INV64[2 * kk], sn, cs); cos32[i] = cs; sin32[i] = sn; }
  }
#ifdef ONE_LAUNCH
  for (int ph = a.ph_lo; ph < a.ph_hi; ++ph) {
#else
  { const int ph = a.ph_lo;
#endif
    int tid = threadIdx.x; asm volatile("" : "+v"(tid));
    const int lane = tid & 63, wave = __builtin_amdgcn_readfirstlane(tid >> 6), gtid = bx * 512 + tid, gw = bx * 8 + wave;
    unsigned char* ws = a.ws;
    float* X = a.out;
    unsigned char* big = ws + WS_BIG;
    bf16_t* XN = (bf16_t*)(ws + WS_XN); bf16_t* ATT = (bf16_t*)(ws + WS_ATT);
    const float* cos64 = (const float*)(ws + WS_COS64); const float* sin64 = (const float*)(ws + WS_SIN64);
    const float* cos32 = (const float*)(ws + WS_COS32); const float* sin32 = (const float*)(ws + WS_SIN32);
    if (ph == NPH - 1) {
      for (int m = gw; m < M; m += NGW) rms_row_f32(X + (size_t)m * DM, INP(3), X + (size_t)m * DM, lane);
    } else {
      const int pp = ph >= 15 ? ph - 15 : ph, L = (ph >= 15 ? 2 : 0) + (pp >= 7 ? 1 : 0), idx = pp >= 7 ? pp - 7 : pp, e = L >> 1; const bool even = !(L & 1);
      const int k = even ? idx + (idx >= 2 ? 1 : 0) + (idx >= 5 ? 1 : 0) : idx + (idx >= 6 ? 1 : 0);
      const float* xsrc = (L == 0) ? INP(0) : X;
      float* ss_mix = (float*)(ws + WS_SS_MIX); float* ss_mlp = (float*)(ws + WS_SS_MLP);
      if (k == 0) {
        LAS float* scr = (LAS float*)(lds + wave * 16384);
        const float* w1 = INP(13) + (size_t)L * DM * FF; const float* w2 = INP(14) + (size_t)L * FF * DM;
        const float* wo = even ? INP(10) + (size_t)e * DM * DM : INP(12) + (size_t)e * DM * DM;
        const float* gmix = INP(1) + L * DM; const float* gmlp = INP(2) + L * DM;
        const int nin = even ? EV_N : 2 * OD_NC;
        const int I_IN = 16 * (nin / 32), I_O = 16 * 32, I_1 = 16 * 128, I_2 = 64 * 32, I_UQ = even ? 4 * 24 : 0, I_UKV = even ? 2 * 32 : 0;
        const int NIT = I_IN + I_O + I_1 + I_2 + I_UQ + I_UKV;
        for (int it = gw; it < NIT; it += NGW) {
          int r = it;
          if (r < I_IN) { if (even) transpose_item(INP(4) + (size_t)e * DM * 1952, DM, 1952, EV_N, (bf16_t*)(ws + WS_W + W_IN), CM_EVIN, scr, r, lane, gmix);
                          else transpose_item(INP(11) + (size_t)e * DM * 9216, DM, 9216, 2 * OD_NC, (bf16_t*)(ws + WS_W + W_IN), CM_ODIN, scr, r, lane, gmix); continue; } r -= I_IN;
          if (r < I_O) { transpose_item(wo, DM, DM, DM, (bf16_t*)(ws + WS_W + W_O), CM_ID, scr, r, lane, nullptr); continue; } r -= I_O;
          if (r < I_1) { transpose_item(w1, DM, FF, FF, (bf16_t*)(ws + WS_W + W_1), CM_ID, scr, r, lane, gmlp); continue; } r -= I_1;
          if (r < I_2) { transpose_item(w2, FF, DM, DM, (bf16_t*)(ws + WS_W + W_2), CM_ID, scr, r, lane, nullptr); continue; } r -= I_2;
          if (r < I_UQ) { transpose_item(INP(7) + (size_t)e * 256 * 768, 256, 768, 768, (bf16_t*)(ws + WS_W + W_UQ), CM_UQ, scr, r, lane, INP(6) + e * 256); continue; } r -= I_UQ;
          transpose_item(INP(9) + (size_t)e * 128 * 1024, 128, 1024, 1024, (bf16_t*)(ws + WS_W + W_UKV), CM_UKV, scr, r, lane, INP(8) + e * 128);
        }
        if (L == 0) {
          for (int m = gw; m < M; m += NGW) {
            const f32x4* xr = (const f32x4*)(xsrc + (size_t)m * DM) + lane; u32x2* o8 = (u32x2*)(XN + (size_t)m * DM) + lane; float s = 0.f;
#pragma unroll
            for (int j = 0; j < 4; ++j) { const f32x4 v = xr[64 * j]; s += (v.x * v.x + v.y * v.y) + (v.z * v.z + v.w * v.w); u32x2 w; w.x = cvt_pk_bf16(v.x, v.y); w.y = cvt_pk_bf16(v.z, v.w); o8[64 * j] = w; }
            s = wave_sum(s); if (lane < 4) ss_mix[m * 4 + lane] = (lane == 0) ? s : 0.f;
          }
        }
      } else if (even && k == 4) {
        na_attn_phase(big, (unsigned char*)ATT, INP(5) + (size_t)e * 8 * 15 * 31, gw, NGW, lane, lds + wave * ATL_WAVE, lds + LDS_OST_OFF + wave * LDS_OST_WAVE);
        __syncthreads();
        mla_attn_phase(big, (unsigned char*)ATT, lds, bx, G, wave, lane);
      } else if (!even && (k == 2 || k == 4)) {
        dil_attn_phase(big, (unsigned char*)ATT, (k == 2) ? 0 : 1, bx, G, wave, lane, tid, lds + wave * ATL_WAVE, lds + LDS_OST_OFF + wave * LDS_OST_WAVE);
      } else {
        const int nsub = (even && k == 3) ? 2 : 1;
        for (int sub = 0; sub < nsub; ++sub) {
          pg8::Gemm g; pg8::StaticOrder S; EpiB E; E.ws = ws; E.lds = lds;
          g.M = M;
          E.base = (k == 5) ? xsrc : X; E.outf = X;
          E.rsub = (k == 5) ? 0 : 1;
          if (k == 5) { g.A = ATT; g.Bt = (const bf16_t*)(ws + WS_W + W_O); g.N = DM; g.K = DM; E.kind = K_RESID; }
          else if (k == 8) { g.A = (const bf16_t*)big; g.Bt = (const bf16_t*)(ws + WS_W + W_2); g.N = DM; g.K = FF; E.kind = K_RESID; }
          else if (k == 7) { g.A = XN; g.Bt = (const bf16_t*)(ws + WS_W + W_1); g.N = FF; g.K = DM; E.kind = K_RELU2; }
          else if (even && k == 1) { g.A = XN; g.Bt = (const bf16_t*)(ws + WS_W + W_IN); g.N = EV_N; g.K = DM; E.kind = K_EVIN; }
          else if (even) {
            if (sub == 0) { g.A = (const bf16_t*)(big + B_CQN); g.Bt = (const bf16_t*)(ws + WS_W + W_UQ); g.N = 768; g.K = 256; E.kind = K_UQ; }
            else { g.A = (const bf16_t*)(big + B_CKVN); g.Bt = (const bf16_t*)(ws + WS_W + W_UKV); g.N = 1024; g.K = 128; E.kind = K_UKV; }
          } else { const int ch = (k == 1) ? 0 : 1; g.A = XN; g.Bt = (const bf16_t*)(ws + WS_W + W_IN) + (size_t)ch * OD_NC * DM; g.N = OD_NC; g.K = DM; E.kind = K_ODIN; }
          S.init(M, g.N, G, bx);
          pg8::gemm_phase<EpiB>(lds, g, S, E);
        }
      }
    }
#ifdef ONE_LAUNCH
    if (ph + 1 < a.ph_hi) {
      if (ph == a.ph_lo) { grid.sync(); xbar = xcd_barrier_post((unsigned*)a.ws, (volatile LAS unsigned*)(lds + 131072 + 256)); }
      else xcd_barrier(xbar);
    }
#endif
  }
}

extern "C" void kernel_launch(void* const* d_in, const int* in_sizes, int n_in, void* d_out, int out_size, void* d_ws, size_t ws_size, hipStream_t stream) {
  static int grid = 0;
  if (!grid) {
    if (n_in != 15 || out_size != M * DM || ws_size < WS_END) { fprintf(stderr, "kernel_launch: unexpected sizes n_in %d out %d ws %zu (need %zu)\n", n_in, out_size, ws_size, (size_t)WS_END); grid = -1; return; }
    int dev = 0, cus = 0, per_cu = 0;
    (void)hipGetDevice(&dev);
    (void)hipDeviceGetAttribute(&cus, hipDeviceAttributeMultiprocessorCount, dev);
    (void)hipFuncSetAttribute((const void*)fwd, hipFuncAttributeMaxDynamicSharedMemorySize, LDS_BYTES);
    (void)hipOccupancyMaxActiveBlocksPerMultiprocessor(&per_cu, (const void*)fwd, 512, LDS_BYTES);
    if (per_cu < 1) per_cu = 1;
    grid = cus * per_cu;
  }
  if (grid < 0) return;
  Args a{};
  for (int i = 0; i < 15; ++i) a.in[i] = (const float*)d_in[i];
  a.out = (float*)d_out; a.ws = (unsigned char*)d_ws;
#ifndef ONE_LAUNCH
  for (int ph = 0; ph < NPH; ++ph) {
    a.ph_lo = ph; a.ph_hi = ph + 1;
    hipLaunchKernelGGL(fwd, dim3(grid), dim3(512), LDS_BYTES, stream, a);
  }
#else
  a.ph_lo = 0; a.ph_hi = NPH;
  void* args[] = {&a};
  hipError_t er = hipLaunchCooperativeKernel((const void*)fwd, dim3(grid), dim3(512), args, LDS_BYTES, stream);
  if (er != hipSuccess) fprintf(stderr, "cooperative launch failed: %s (grid %d)\n", hipGetErrorString(er), grid);
#endif
}
```

```cpp
#include <hip/hip_runtime.h>
#include <hip/hip_cooperative_groups.h>
#include <cstdio>
#include <cstdint>
namespace cg = cooperative_groups;
#define ONE_LAUNCH 1

#define LAS __attribute__((address_space(3)))
typedef unsigned short bf16_t;
typedef short bf16x8 __attribute__((ext_vector_type(8)));
typedef float f32x4 __attribute__((ext_vector_type(4)));
typedef float f32x2 __attribute__((ext_vector_type(2)));
typedef float f32x16 __attribute__((ext_vector_type(16)));
typedef unsigned u32x4 __attribute__((ext_vector_type(4)));
typedef unsigned u32x2 __attribute__((ext_vector_type(2)));

constexpr int M = 16384, SEQ = 8192, DM = 1024, FF = 4096;
constexpr int EV_N = 2048;
constexpr int OD_NC = 4608;
constexpr float LOG2E = 1.4426950408889634f;
constexpr float C_NA = 0.125f * LOG2E;
constexpr float C_MLA = 0.10206207261596575f * LOG2E;
constexpr float RMS_EPS = 1e-6f;
constexpr float NEG_BIG = -1e30f;

constexpr size_t MiB = 1u << 20;
constexpr size_t WS_COS64 = 1 * MiB, WS_SIN64 = 2 * MiB, WS_COS32 = 3 * MiB, WS_SIN32 = 3 * MiB + 512 * 1024;
constexpr size_t WS_W = 4 * MiB;
constexpr size_t W_IN = 0, W_O = 18 * MiB, W_1 = 20 * MiB, W_2 = 28 * MiB, W_UQ = 36 * MiB, W_UKV = 36 * MiB + 512 * 1024;
constexpr size_t WS_XN = 41 * MiB;
constexpr size_t WS_ATT = 73 * MiB;
constexpr size_t WS_BIG = 105 * MiB;
constexpr size_t B_QKNA = 0, B_VTNA = 32 * MiB, B_CQN = 60 * MiB, B_CKVN = 68 * MiB, B_KPE = 72 * MiB,
                 B_QMLA = 73 * MiB, B_KN = 97 * MiB, B_VTMLA = 113 * MiB;
constexpr size_t B_QK = 0, B_VT = 96 * MiB, B_LSE = 144 * MiB;
constexpr size_t WS_END = 255 * MiB;

constexpr int LDS_BYTES = 151552;
constexpr int LDS_VT_OFF = 131072 + 1024, LDS_VT_WAVE = 2336;
constexpr int NPH = 31;
constexpr size_t WS_SS_MIX = 252 * MiB, WS_SS_MLP = 253 * MiB, WS_SS_Q = 254 * MiB, WS_SS_KV = 254 * MiB + 512 * 1024;

__device__ const float INV64[32] = {
  1.000000000e+00f, 7.498942018e-01f, 5.623413324e-01f, 4.216965139e-01f, 3.162277639e-01f, 2.371373922e-01f, 1.778279394e-01f, 1.333521456e-01f,
  1.000000015e-01f, 7.498941571e-02f, 5.623412877e-02f, 4.216964915e-02f, 3.162277862e-02f, 2.371373586e-02f, 1.778279431e-02f, 1.333521493e-02f,
  9.999999776e-03f, 7.498942316e-03f, 5.623413250e-03f, 4.216964822e-03f, 3.162277862e-03f, 2.371373819e-03f, 1.778279431e-03f, 1.333521446e-03f,
  1.000000047e-03f, 7.498941850e-04f, 5.623413017e-04f, 4.216965463e-04f, 3.162277862e-04f, 2.371373848e-04f, 1.778279402e-04f, 1.333521504e-04f};

typedef __bf16 bf16x2_t __attribute__((ext_vector_type(2)));
__device__ __forceinline__ unsigned cvt_pk_bf16(float lo, float hi) { const f32x2 v = {lo, hi}; const bf16x2_t b = __builtin_convertvector(v, bf16x2_t); return __builtin_bit_cast(unsigned, b); }
__device__ __forceinline__ bf16_t f2bf(float f) { return (bf16_t)(cvt_pk_bf16(f, 0.f) & 0xffffu); }
__device__ __forceinline__ float bf2f(unsigned short h) { return __uint_as_float(((unsigned)h) << 16); }
__device__ __forceinline__ float bflo(unsigned w) { return __uint_as_float(w << 16); }
__device__ __forceinline__ float bfhi(unsigned w) { return __uint_as_float(w & 0xffff0000u); }
__device__ __forceinline__ int vtidx(int p) { return (p & ~12) | ((p & 4) << 1) | ((p & 8) >> 1); }
__device__ __forceinline__ float wave_sum(float v) {
#pragma unroll
  for (int o = 1; o < 64; o <<= 1) v += __shfl_xor(v, o);
  return v;
}
__device__ __forceinline__ void unpack8(const u32x4 w, float* f) {
  f[0] = bflo(w.x); f[1] = bfhi(w.x); f[2] = bflo(w.y); f[3] = bfhi(w.y); f[4] = bflo(w.z); f[5] = bfhi(w.z); f[6] = bflo(w.w); f[7] = bfhi(w.w);
}

namespace pg8 {
constexpr int BM = 256, BK = 64, HALF = 128, HTB = HALF * BK * 2, STAGE_BYTES = 8 * HTB, NXCD = 8, WGM = 4;
__host__ __device__ __forceinline__ int lds_byte(int r, int c) { const int st = (r >> 4) * 2 + (c >> 5), rr = r & 15, cc = c & 31, ob = rr * 64 + cc * 2; return st * 1024 + (ob ^ (((ob >> 9) & 1) << 5)); }
__host__ __device__ __forceinline__ void stage_rc(int b, int& R, int& C) { const int st = b / 1024, sb = b % 1024, swz = sb ^ (((sb >> 9) & 1) << 5); R = (st >> 1) * 16 + swz / 64; C = (st & 1) * 32 + (swz % 64) / 2; }
__host__ __device__ __forceinline__ int perm32(int rho) { const int n = rho >> 4, i = rho & 15; return 8 * (i >> 2) + 4 * n + (i & 3); }

struct Unit { int pm, pn; };
struct Gemm { const bf16_t* A; const bf16_t* Bt; int M, N, K; };
struct StaticOrder {
  int nM, nN, nwg, G, c;
  __device__ void init(int M_, int N_, int G_, int c_) { nM = M_ / BM; nN = N_ / BM; nwg = nM * nN; G = G_; c = c_; }
  __device__ bool next(int i, Unit& u) const {
    const long L = (long)i * G + c; if (L >= nwg) return false;
    int wgid = (int)L; { const int q = nwg / NXCD, r = nwg % NXCD, xcd = wgid % NXCD, off = wgid / NXCD; wgid = (xcd < r ? xcd * (q + 1) : r * (q + 1) + (xcd - r) * q) + off; }
    const int nig = WGM * nN, gid = wgid / nig, fm = gid * WGM, gsz = (nM - fm) < WGM ? (nM - fm) : WGM;
    u.pm = fm + ((wgid % nig) % gsz); u.pn = (wgid % nig) / gsz; return true;
  }
};

template <class Epi>
__device__ __forceinline__ void gemm_phase(LAS unsigned char* lds, const Gemm g, const StaticOrder& S, const Epi& E) {
  int tid = threadIdx.x; asm volatile("" : "+v"(tid));
  const int wid = __builtin_amdgcn_readfirstlane(tid >> 6), lane = tid & 63, wr = wid >> 2, wc = wid & 3, fr = lane & 15, fq = lane >> 4;
  constexpr bool PERM = true; const int K = g.K, nt = K / BK;
  unsigned voffA[2], voffB[2];
#pragma unroll
  for (int i = 0; i < 2; ++i) { int R, C; stage_rc(tid * 16 + i * 8192, R, C); const int Rb = PERM ? ((R & ~31) + perm32(R & 31)) : R;
    voffA[i] = (unsigned)(R * K + C) * 2u; voffB[i] = (unsigned)(Rb * K + C) * 2u; }
  const size_t kstep = (size_t)(BK * 2);
  const size_t hstep = (size_t)HALF * K * 2;
  const size_t tstep = 2 * hstep;
  const unsigned ldsw = (unsigned)wid * 1024u;
  const int aoff = lds_byte(wr * 64 + fr, fq * 8), boff = lds_byte(wc * 32 + fr, fq * 8);
#define PG8_SA(b, h) (((b) * 2 + (h)) * HTB)
#define PG8_SB(b, h) ((4 + (b) * 2 + (h)) * HTB)
#define PG8_STAGE(bufoff, gbase, voff) do { _Pragma("unroll") for (int _i = 0; _i < 2; ++_i) \
    __builtin_amdgcn_global_load_lds((const unsigned*)((const char*)(gbase) + (voff)[_i]), (LAS unsigned*)(lds + (bufoff) + ldsw + _i * 8192), 16, 0, 0); } while (0)
#define PG8_LDA(dst, b, h) do { _Pragma("unroll") for (int m = 0; m < 4; ++m) _Pragma("unroll") for (int k = 0; k < 2; ++k) dst[m][k] = *(const LAS bf16x8*)(lds + PG8_SA(b, h) + aoff + m * 2048 + k * 1024); } while (0)
#define PG8_LDB(dst, b, h) do { _Pragma("unroll") for (int n = 0; n < 2; ++n) _Pragma("unroll") for (int k = 0; k < 2; ++k) dst[n][k] = *(const LAS bf16x8*)(lds + PG8_SB(b, h) + boff + n * 2048 + k * 1024); } while (0)
#define PG8_MMA(ai, bj, At, Bt) do { __builtin_amdgcn_s_setprio(1); _Pragma("unroll") for (int m = 0; m < 4; ++m) _Pragma("unroll") for (int n = 0; n < 2; ++n) _Pragma("unroll") for (int k = 0; k < 2; ++k) \
    acc[ai][bj][m][n] = __builtin_amdgcn_mfma_f32_16x16x32_bf16(Bt[n][k], At[m][k], acc[ai][bj][m][n], 0, 0, 0); __builtin_amdgcn_s_setprio(0); } while (0)
#define PG8_WAIT_V(n) asm volatile("s_waitcnt vmcnt(" #n ")" ::: "memory")
#define PG8_WAIT_L(n) asm volatile("s_waitcnt lgkmcnt(" #n ")" ::: "memory")
#define PG8_BAR __builtin_amdgcn_s_barrier()
#define PG8_SCHED __builtin_amdgcn_sched_barrier(0)
  Unit cur, nxt; int ui = 0;
  if (!S.next(0, cur)) return;
  f32x4 acc[2][2][4][2];
#pragma unroll
  for (int a = 0; a < 2; ++a)
#pragma unroll
    for (int b = 0; b < 2; ++b)
#pragma unroll
      for (int m = 0; m < 4; ++m)
#pragma unroll
        for (int n = 0; n < 2; ++n) acc[a][b][m][n] = (f32x4){0.f, 0.f, 0.f, 0.f};
  bf16x8 At[4][2], B0[2][2], B1[2][2];
  const char* cA = (const char*)g.A + (size_t)cur.pm * tstep; const char* cB = (const char*)g.Bt + (size_t)cur.pn * tstep;
  PG8_STAGE(PG8_SB(0, 0), cB, voffB); PG8_STAGE(PG8_SB(0, 1), cB + hstep, voffB); PG8_STAGE(PG8_SA(0, 0), cA, voffA); PG8_STAGE(PG8_SA(0, 1), cA + hstep, voffA);
  if (wr == 1) PG8_BAR;
  PG8_WAIT_V(2); PG8_BAR;
  PG8_STAGE(PG8_SB(1, 0), cB + kstep, voffB); PG8_STAGE(PG8_SA(1, 0), cA + kstep, voffA); PG8_STAGE(PG8_SB(1, 1), cB + hstep + kstep, voffB);
  PG8_WAIT_V(6); PG8_BAR;
  for (;;) {
    const bool has_next = S.next(ui + 1, nxt);
    const char* nA = has_next ? (const char*)g.A + (size_t)nxt.pm * tstep : cA; const char* nB = has_next ? (const char*)g.Bt + (size_t)nxt.pn * tstep : cB;
    for (int t = 0; t < nt; t += 2) {
      const bool last = (t == nt - 2);
      const char* a1 = cA + (size_t)(t + 1) * kstep;
      const char* a2 = last ? nA : cA + (size_t)(t + 2) * kstep; const char* b2 = last ? nB : cB + (size_t)(t + 2) * kstep;
      const char* a3 = a2 + kstep; const char* b3 = b2 + kstep;
      PG8_LDB(B0, 0, 0); PG8_LDB(B1, 0, 1); PG8_SCHED; PG8_LDA(At, 0, 0); PG8_STAGE(PG8_SA(1, 1), a1 + hstep, voffA);
      PG8_WAIT_V(8); PG8_WAIT_L(0); PG8_BAR; PG8_MMA(0, 0, At, B0); PG8_MMA(0, 1, At, B1); PG8_BAR; PG8_SCHED;
      PG8_LDA(At, 0, 1); PG8_STAGE(PG8_SB(0, 0), b2, voffB); PG8_STAGE(PG8_SB(0, 1), b2 + hstep, voffB); PG8_STAGE(PG8_SA(0, 0), a2, voffA);
      PG8_WAIT_V(8); PG8_WAIT_L(0); PG8_BAR; PG8_MMA(1, 0, At, B0); PG8_MMA(1, 1, At, B1); PG8_BAR; PG8_SCHED;
      PG8_LDB(B0, 1, 0); PG8_LDB(B1, 1, 1); PG8_SCHED; PG8_LDA(At, 1, 0); PG8_STAGE(PG8_SA(0, 1), a2 + hstep, voffA);
      PG8_WAIT_V(8); PG8_WAIT_L(0); PG8_BAR; PG8_MMA(0, 0, At, B0); PG8_MMA(0, 1, At, B1); PG8_BAR; PG8_SCHED;
      PG8_LDA(At, 1, 1); PG8_STAGE(PG8_SB(1, 0), b3, voffB); PG8_STAGE(PG8_SB(1, 1), b3 + hstep, voffB); PG8_STAGE(PG8_SA(1, 0), a3, voffA);
      PG8_WAIT_V(8); PG8_WAIT_L(0); PG8_BAR; PG8_MMA(1, 0, At, B0); PG8_MMA(1, 1, At, B1); PG8_BAR; PG8_SCHED;
    }
    if (wr == 0) PG8_BAR;
    E(acc, cur, wr, wc, fr, fq);
    if (!has_next) break;
#pragma unroll
    for (int a = 0; a < 2; ++a)
#pragma unroll
      for (int b = 0; b < 2; ++b)
#pragma unroll
        for (int m = 0; m < 4; ++m)
#pragma unroll
          for (int n = 0; n < 2; ++n) acc[a][b][m][n] = (f32x4){0.f, 0.f, 0.f, 0.f};
    cur = nxt; cA = nA; cB = nB; ++ui;
    if (wr == 1) PG8_BAR;
  }
  PG8_WAIT_V(0);
  PG8_BAR;
#undef PG8_SA
#undef PG8_SB
#undef PG8_STAGE
#undef PG8_LDA
#undef PG8_LDB
#undef PG8_MMA
#undef PG8_WAIT_V
#undef PG8_WAIT_L
#undef PG8_BAR
#undef PG8_SCHED
}
}

enum EpiKind { K_EVIN = 0, K_UQ = 1, K_UKV = 2, K_ODIN = 3, K_RELU2 = 4, K_RESID = 5 };
struct EpiB {
  int kind;
  unsigned char* ws;
  const float* base; float* outf;
  int rsub;
  LAS unsigned char* lds;
  __device__ __forceinline__ void store8(unsigned char* b, unsigned off, f32x4 v0, f32x4 v1) const {
    u32x4 w; w.x = cvt_pk_bf16(v0[0], v0[1]); w.y = cvt_pk_bf16(v0[2], v0[3]); w.z = cvt_pk_bf16(v1[0], v1[1]); w.w = cvt_pk_bf16(v1[2], v1[3]);
    *(u32x4*)(b + off) = w;
  }
  __device__ __forceinline__ void rope8(f32x4& v0, f32x4& v1, const f32x4 c, const f32x4 s) const {
    f32x4 a0, a1;
    a0[0] = v0[0] * c[0] - v0[1] * s[0]; a0[1] = v0[1] * c[0] + v0[0] * s[0];
    a0[2] = v0[2] * c[1] - v0[3] * s[1]; a0[3] = v0[3] * c[1] + v0[2] * s[1];
    a1[0] = v1[0] * c[2] - v1[1] * s[2]; a1[1] = v1[1] * c[2] + v1[0] * s[2];
    a1[2] = v1[2] * c[3] - v1[3] * s[3]; a1[3] = v1[3] * c[3] + v1[2] * s[3];
    v0 = a0; v1 = a1;
  }
  __device__ __forceinline__ void vt8(unsigned char* vt, unsigned off, f32x4 v0, f32x4 v1) const {
    *(bf16_t*)(vt + off + 0 * SEQ * 2) = f2bf(v0[0]); *(bf16_t*)(vt + off + 1 * SEQ * 2) = f2bf(v0[1]); *(bf16_t*)(vt + off + 2 * SEQ * 2) = f2bf(v0[2]); *(bf16_t*)(vt + off + 3 * SEQ * 2) = f2bf(v0[3]);
    *(bf16_t*)(vt + off + 4 * SEQ * 2) = f2bf(v1[0]); *(bf16_t*)(vt + off + 5 * SEQ * 2) = f2bf(v1[1]); *(bf16_t*)(vt + off + 6 * SEQ * 2) = f2bf(v1[2]); *(bf16_t*)(vt + off + 7 * SEQ * 2) = f2bf(v1[3]);
  }
  __device__ __forceinline__ void operator()(const f32x4 (&acc)[2][2][4][2], const pg8::Unit& u, int wr, int wc, int, int) const {
    const int ln_ = (int)__builtin_amdgcn_mbcnt_hi(~0u, __builtin_amdgcn_mbcnt_lo(~0u, 0u)), fr = ln_ & 15, fq = ln_ >> 4;
    const int pn = u.pn;
    unsigned char* const big = ws + WS_BIG;
    const float* const ss_in = (const float*)(ws + (kind == K_RELU2 ? WS_SS_MLP : WS_SS_MIX)); float* const ss_out = (float*)(ws + (rsub == 0 ? WS_SS_MLP : WS_SS_MIX));
    const float* const cos64 = (const float*)(ws + WS_COS64); const float* const sin64 = (const float*)(ws + WS_SIN64);
    const float* const cos32 = (const float*)(ws + WS_COS32); const float* const sin32 = (const float*)(ws + WS_SIN32);
    float rsv[2][4];
    {
      const unsigned row0 = u.pm * 256 + wr * 64 + fr;
      if (kind == K_EVIN || kind == K_ODIN || kind == K_RELU2) {
        f32x4 pq4[2][4];
#pragma unroll
        for (int ai = 0; ai < 2; ++ai)
#pragma unroll
          for (int m = 0; m < 4; ++m) pq4[ai][m] = *(const f32x4*)((const char*)ss_in + (row0 + ai * 128 + m * 16) * 16u);
#pragma unroll
        for (int ai = 0; ai < 2; ++ai)
#pragma unroll
          for (int m = 0; m < 4; ++m) { const f32x4 p = pq4[ai][m]; rsv[ai][m] = __builtin_amdgcn_rsqf(((p[0] + p[1]) + (p[2] + p[3])) * (1.f / DM) + RMS_EPS); }
      } else if (kind == K_UQ || kind == K_UKV) {
        const unsigned char* sb = ws + (kind == K_UQ ? WS_SS_Q : WS_SS_KV); const float inv = (kind == K_UQ) ? (1.f / 256.f) : (1.f / 128.f);
        f32x4 pq[2][4];
#pragma unroll
        for (int ai = 0; ai < 2; ++ai)
#pragma unroll
          for (int m = 0; m < 4; ++m) pq[ai][m] = *(const f32x4*)(sb + (row0 + ai * 128 + m * 16) * 16u);
#pragma unroll
        for (int ai = 0; ai < 2; ++ai)
#pragma unroll
          for (int m = 0; m < 4; ++m) { const f32x4 p = pq[ai][m]; rsv[ai][m] = __builtin_amdgcn_rsqf(((p[0] + p[1]) + (p[2] + p[3])) * inv + RMS_EPS); }
      } else {
#pragma unroll
        for (int ai = 0; ai < 2; ++ai)
#pragma unroll
          for (int m = 0; m < 4; ++m) rsv[ai][m] = 1.f;
      }
    }
    {
      int vkind = -1; unsigned vrow0 = 0; unsigned char* vbase = big;
      const unsigned bt = (unsigned)u.pm >> 5;
      if (kind == K_EVIN && (pn == 4 || pn == 5)) { vkind = 0; vbase = big + B_VTNA; vrow0 = bt * 512 + (pn - 4) * 256 + wc * 32; }
      else if (kind == K_UKV && pn >= 2) { vkind = 0; vbase = big + B_VTMLA; vrow0 = bt * 512 + (pn - 2) * 256 + wc * 32; }
      else if (kind == K_ODIN && pn >= 12) { const int gq = (pn - 12) >> 1; vkind = gq; vbase = big + B_VT; vrow0 = (bt * 3 + gq) * 512 + (pn & 1) * 256 + wc * 32; }
      if (vkind >= 0) {
        LAS unsigned char* scr = lds + LDS_VT_OFF + (wr * 4 + wc) * LDS_VT_WAVE;
        const int lane = fq * 16 + fr;
#pragma unroll
        for (int ai = 0; ai < 2; ++ai)
#pragma unroll
          for (int bj = 0; bj < 2; ++bj) {
            const unsigned P = ((unsigned)u.pm * 256 + ai * 128 + wr * 64) & (SEQ - 1);
#pragma unroll
            for (int h = 0; h < 2; ++h) {
              if ((fq >> 1) == h) {
#pragma unroll
                for (int m = 0; m < 4; ++m) {
                  const float rs = rsv[ai][m];
                  int fr_ = fr; asm volatile("" : "+v"(fr_));
                  const int rlm = (vkind == 0) ? 16 * m + vtidx(fr_) : (vkind == 1) ? 16 * (fr_ & 3) + vtidx(4 * m + (fr_ >> 2)) : 4 * fr_ + m;
                  LAS unsigned char* wp = scr + (8 * (fq & 1)) * 144 + (fq & 1) * 32 + rlm * 2;
#pragma unroll
                  for (int e = 0; e < 8; ++e) *(LAS bf16_t*)(wp + e * 144) = f2bf(acc[ai][bj][m][e >> 2][e & 3] * rs);
                }
              }
              asm volatile("s_waitcnt lgkmcnt(0)" ::: "memory");
              const unsigned vr = vrow0 + bj * 128 + 16 * h;
              if (vkind == 2) {
                const unsigned swc = ((P >> 6) & 3), sw = ((swc & 1) << 1) | (swc >> 1);
#pragma unroll
                for (int t = 0; t < 4; ++t) { const int q = lane + 64 * t, cl = q >> 4, r = q & 15;
                  const u32x2 w = *(const LAS u32x2*)(scr + cl * 144 + (cl >> 3) * 32 + r * 8);
                  *(u32x2*)(vbase + ((vr + cl) * SEQ + r * 512 + ((P >> 4) & ~15u) + 4 * sw) * 2u) = w; }
              } else {
#pragma unroll
                for (int t = 0; t < 2; ++t) { const int q = lane + 64 * t, cl = q >> 3, pc = q & 7;
                  const u32x4 w = *(const LAS u32x4*)(scr + cl * 144 + (cl >> 3) * 32 + pc * 16);
                  const unsigned lidx = (vkind == 0) ? P + 8 * pc : (pc >> 1) * 2048 + (P >> 2) + 8 * (pc & 1);
                  *(u32x4*)(vbase + ((vr + cl) * SEQ + lidx) * 2u) = w; }
              }
              asm volatile("s_waitcnt lgkmcnt(0)" ::: "memory");
            }
          }
        return;
      }
    }
#pragma unroll
    for (int ai = 0; ai < 2; ++ai) {
      f32x4 bpre[2][2][2];
      const bool rope64 = (kind == K_ODIN) && (pn < 12), rope32 = (kind == K_UQ && pn == 2) || (kind == K_EVIN && pn == 7 && wc == 0);
      if (rope64 || rope32) {
#pragma unroll
        for (int m = 0; m < 4; ++m) { const unsigned pos_ = ((unsigned)u.pm * 256 + ai * 128 + wr * 64 + m * 16 + fr) & (SEQ - 1);
          const unsigned toff = rope64 ? (pos_ * 32 + (wc & 1) * 16 + 4 * fq) * 4u : (pos_ * 16 + 4 * fq) * 4u;
          bpre[m >> 1][m & 1][0] = *(const f32x4*)((const char*)(rope64 ? cos64 : cos32) + toff); bpre[m >> 1][m & 1][1] = *(const f32x4*)((const char*)(rope64 ? sin64 : sin32) + toff); }
      }
#pragma unroll
      for (int m = 0; m < 4; ++m) {
        if ((m & 1) == 0) asm volatile("" ::: "memory");
        if (kind == K_RESID && (m & 1) == 0) {
#pragma unroll
          for (int mm = 0; mm < 2; ++mm)
#pragma unroll
            for (int bj = 0; bj < 2; ++bj) { const unsigned o = ((u.pm * 256 + ai * 128 + wr * 64 + (m + mm) * 16 + fr) * DM + pn * 256 + bj * 128 + wc * 32 + 8 * fq) * 4u;
              bpre[mm][bj][0] = *(const f32x4*)((const char*)base + o); bpre[mm][bj][1] = *(const f32x4*)((const char*)base + o + 16); }
        }
        const unsigned row = u.pm * 256 + ai * 128 + wr * 64 + m * 16 + fr;
        const unsigned b = row >> 13, pos = row & (SEQ - 1);
        const float rs = rsv[ai][m];
        float part = 0.f;
#pragma unroll
        for (int bj = 0; bj < 2; ++bj) {
          const unsigned col = pn * 256 + bj * 128 + wc * 32 + 8 * fq;
          f32x4 v0 = acc[ai][bj][m][0] * rs, v1 = acc[ai][bj][m][1] * rs;
          if (kind == K_RESID) {
            const unsigned o = (row * DM + col) * 4u;
            v0 += bpre[m & 1][bj][0]; v1 += bpre[m & 1][bj][1];
            *(f32x4*)((char*)outf + o) = v0; *(f32x4*)((char*)outf + o + 16) = v1;
            store8(ws + WS_XN, (row * DM + col) * 2u, v0, v1);
            part += (v0[0] * v0[0] + v0[1] * v0[1]) + (v0[2] * v0[2] + v0[3] * v0[3]) + (v1[0] * v1[0] + v1[1] * v1[1]) + (v1[2] * v1[2] + v1[3] * v1[3]);
          } else if (kind == K_RELU2) {
#pragma unroll
            for (int e = 0; e < 4; ++e) { float a = fmaxf(v0[e], 0.f), c = fmaxf(v1[e], 0.f); v0[e] = a * a; v1[e] = c * c; }
            store8(big, (row * FF + col) * 2u, v0, v1);
          } else if (kind == K_EVIN) {
            if (pn < 4) { const float sc = pn < 2 ? C_NA : 1.f; store8(big + B_QKNA, (row * 1024 + col) * 2u, v0 * sc, v1 * sc); }
            else if (pn < 6) { vt8(big + B_VTNA, ((b * 512 + (col - 1024)) * SEQ + vtidx(pos)) * 2u, v0, v1); }
            else if (pn == 6) { store8(big + B_CQN, (row * 256 + (col - 1536)) * 2u, v0, v1);
              part += (v0[0] * v0[0] + v0[1] * v0[1]) + (v0[2] * v0[2] + v0[3] * v0[3]) + (v1[0] * v1[0] + v1[1] * v1[1]) + (v1[2] * v1[2] + v1[3] * v1[3]); }
            else {
              if (bj == 0) { store8(big + B_CKVN, (row * 128 + (col - 1792)) * 2u, v0, v1);
                part += (v0[0] * v0[0] + v0[1] * v0[1]) + (v0[2] * v0[2] + v0[3] * v0[3]) + (v1[0] * v1[0] + v1[1] * v1[1]) + (v1[2] * v1[2] + v1[3] * v1[3]); }
              else if (wc == 0) { rope8(v0, v1, bpre[m >> 1][m & 1][0], bpre[m >> 1][m & 1][1]); store8(big + B_KPE, (row * 32 + 8 * fq) * 2u, v0, v1); }
            }
          } else if (kind == K_UQ) {
            if (pn == 2) rope8(v0, v1, bpre[m >> 1][m & 1][0], bpre[m >> 1][m & 1][1]);
            store8(big + B_QMLA, (row * 768 + col) * 2u, v0 * C_MLA, v1 * C_MLA);
          } else if (kind == K_UKV) {
            if (pn < 2) store8(big + B_KN, (row * 512 + col) * 2u, v0, v1);
            else vt8(big + B_VTMLA, ((b * 512 + (col - 512)) * SEQ + vtidx(pos)) * 2u, v0, v1);
          } else {
            const int s = pn >> 1;
            if (s < 6) {
              rope8(v0, v1, bpre[m >> 1][m & 1][0], bpre[m >> 1][m & 1][1]);
              const float sc = (s & 1) ? 1.f : C_NA;
              store8(big + B_QK, (row * 3072 + col) * 2u, v0 * sc, v1 * sc);
            } else {
              const int gq = s - 6, sh = 2 * gq;
              const unsigned lidx = ((pos & ((1u << sh) - 1)) << (13 - sh)) | (pos >> sh);
              vt8(big + B_VT, (((b * 3 + gq) * 512 + (col - s * 512)) * SEQ + vtidx(lidx)) * 2u, v0, v1);
            }
          }
        }
        if (kind == K_RESID || (kind == K_EVIN && pn >= 6)) {
          part += __shfl_xor(part, 16); part += __shfl_xor(part, 32);
          if (fq == 0) {
            if (kind == K_RESID) *(LAS float*)(lds + LDS_VT_OFF + ((ai * 128 + wr * 64 + m * 16 + fr) * 4 + wc) * 4) = part;
            else ((float*)(ws + (pn == 6 ? WS_SS_Q : WS_SS_KV)))[row * 4 + wc] = part;
          }
        }
      }
    }
    if (kind == K_RESID) {
      asm volatile("s_waitcnt lgkmcnt(0)" ::: "memory"); __builtin_amdgcn_s_barrier(); asm volatile("" ::: "memory");
      const int t_ = (wr * 4 + wc) * 64 + ln_;
      if (t_ < 256) { const f32x4 p = *(const LAS f32x4*)(lds + LDS_VT_OFF + t_ * 16); ss_out[(u.pm * 256 + t_) * 4 + pn] = (p[0] + p[1]) + (p[2] + p[3]); }
      asm volatile("s_waitcnt lgkmcnt(0)" ::: "memory"); __builtin_amdgcn_s_barrier(); asm volatile("" ::: "memory");
    }
  }
};

enum ColMap { CM_ID = 0, CM_EVIN = 1, CM_UQ = 2, CM_UKV = 3, CM_ODIN = 4 };
__device__ __forceinline__ int colmap(int kind, int n) {
  switch (kind) {
    case CM_EVIN: { if (n < 1920) return n; if (n >= 1952) return -1; const int j = n - 1920, k = j >> 1; return 1920 + ((j & 1) ? k + 16 : k); }
    case CM_UQ: { if (n < 512) return (n >> 6) * 96 + (n & 63); const int h = (n - 512) >> 5, j = (n - 512) & 31, k = j >> 1; return h * 96 + 64 + ((j & 1) ? k + 16 : k); }
    case CM_UKV: { if (n < 512) return (n >> 6) * 128 + (n & 63); const int n2 = n - 512; return (n2 >> 6) * 128 + 64 + (n2 & 63); }
    case CM_ODIN: { const int ch = n / OD_NC, n1 = n - ch * OD_NC, s = n1 >> 9, hl = (n1 & 511) >> 6, j = n1 & 63;
      int gq, t, js; if (s < 6) { gq = s >> 1; t = s & 1; const int k = j >> 1; js = (j & 1) ? k + 32 : k; } else { gq = s - 6; t = 2; js = j; }
      return ((gq * 3 + t) * 16 + (8 * ch + hl)) * 64 + js; }
    default: return n;
  }
}
__device__ __forceinline__ void transpose_item(const float* W, int K, int Nsrc, int Nout, bf16_t* WT, int cm, LAS float* scr, int item, int lane, const float* gain) {
  const int nblk = Nout / 32, kb = item / nblk, nb = item % nblk, k0 = 64 * kb, n0 = 32 * nb;
  const int sc = colmap(cm, n0 + (lane & 31));
  float wv[32];
#pragma unroll
  for (int i = 0; i < 32; ++i) { const int kk = 2 * i + (lane >> 5); wv[i] = sc >= 0 ? W[(size_t)(k0 + kk) * Nsrc + sc] : 0.f; }
#pragma unroll
  for (int i = 0; i < 32; ++i) { const int kk = 2 * i + (lane >> 5); const float gk = gain ? gain[k0 + kk] : 1.f; scr[kk * 33 + (lane & 31)] = wv[i] * gk; }
  asm volatile("s_waitcnt lgkmcnt(0)" ::: "memory");
  const int c = lane & 7;
#pragma unroll
  for (int j = 0; j < 4; ++j) { const int n = (lane >> 3) + 8 * j; const LAS float* s = scr + (8 * c) * 33 + n;
    u32x4 o; o.x = cvt_pk_bf16(s[0 * 33], s[1 * 33]); o.y = cvt_pk_bf16(s[2 * 33], s[3 * 33]); o.z = cvt_pk_bf16(s[4 * 33], s[5 * 33]); o.w = cvt_pk_bf16(s[6 * 33], s[7 * 33]);
    *(u32x4*)(WT + (size_t)(n0 + n) * K + k0 + 8 * c) = o; }
  asm volatile("s_waitcnt lgkmcnt(0)" ::: "memory");
}
__device__ __forceinline__ void rms_row_bf16(const float* xrow, const float* g, bf16_t* orow, int lane) {
  const f32x4* xr = (const f32x4*)xrow + lane; const f32x4* gr = (const f32x4*)g + lane;
  f32x4 v[4]; float s = 0.f;
#pragma unroll
  for (int j = 0; j < 4; ++j) { v[j] = xr[64 * j]; s += (v[j].x * v[j].x + v[j].y * v[j].y) + (v[j].z * v[j].z + v[j].w * v[j].w); }
  const float rstd = 1.f / sqrtf(wave_sum(s) * (1.f / DM) + RMS_EPS);
  u32x2* o8 = (u32x2*)orow + lane;
#pragma unroll
  for (int j = 0; j < 4; ++j) { const f32x4 gg = gr[64 * j]; u32x2 w; w.x = cvt_pk_bf16(v[j].x * rstd * gg.x, v[j].y * rstd * gg.y); w.y = cvt_pk_bf16(v[j].z * rstd * gg.z, v[j].w * rstd * gg.w); o8[64 * j] = w; }
}
__device__ __forceinline__ void rms_row_f32(const float* xrow, const float* g, float* orow, int lane) {
  const f32x4* xr = (const f32x4*)xrow + lane; const f32x4* gr = (const f32x4*)g + lane;
  f32x4 v[4]; float s = 0.f;
#pragma unroll
  for (int j = 0; j < 4; ++j) { v[j] = xr[64 * j]; s += (v[j].x * v[j].x + v[j].y * v[j].y) + (v[j].z * v[j].z + v[j].w * v[j].w); }
  const float rstd = 1.f / sqrtf(wave_sum(s) * (1.f / DM) + RMS_EPS);
  f32x4* o = (f32x4*)orow + lane;
#pragma unroll
  for (int j = 0; j < 4; ++j) { const f32x4 gg = gr[64 * j]; o[64 * j] = v[j] * rstd * gg; }
}
__device__ __forceinline__ void sincos_acc(float angf, float& sn, float& cs) {
  const double x = (double)angf;
  const double n = __builtin_rint(x * 0.63661977236758134308);
  double r = __builtin_fma(-n, 1.57079632679489655800e+00, x); r = __builtin_fma(-n, 6.12323399573676603587e-17, r);
  const double r2 = r * r;
  double sp = 1.0 / 6227020800.0; sp = sp * r2 - 1.0 / 39916800.0; sp = sp * r2 + 1.0 / 362880.0; sp = sp * r2 - 1.0 / 5040.0; sp = sp * r2 + 1.0 / 120.0; sp = sp * r2 - 1.0 / 6.0; sp = sp * r2 + 1.0; sp *= r;
  double cp = -1.0 / 87178291200.0; cp = cp * r2 + 1.0 / 479001600.0; cp = cp * r2 - 1.0 / 3628800.0; cp = cp * r2 + 1.0 / 40320.0; cp = cp * r2 - 1.0 / 720.0; cp = cp * r2 + 1.0 / 24.0; cp = cp * r2 - 0.5; cp = cp * r2 + 1.0;
  const int q = ((int)(long long)n) & 3;
  const double s_ = (q & 1) ? cp : sp, c_ = (q & 1) ? sp : cp;
  sn = (float)((q & 2) ? -s_ : s_);
  cs = (float)(((q + 1) & 2) ? -c_ : c_);
}

__device__ __forceinline__ int crow(int r, int hi) { return (r & 3) + 8 * (r >> 2) + 4 * hi; }
__device__ __forceinline__ float half_max(float m) { auto rr = __builtin_amdgcn_permlane32_swap(__float_as_uint(m), __float_as_uint(m), false, false); return fmaxf(__uint_as_float(rr[0]), __uint_as_float(rr[1])); }
__device__ __forceinline__ float half_sum(float m) { auto rr = __builtin_amdgcn_permlane32_swap(__float_as_uint(m), __float_as_uint(m), false, false); return __uint_as_float(rr[0]) + __uint_as_float(rr[1]); }
__device__ __forceinline__ bf16x8 ldg8(const unsigned char* base, unsigned off) { return *(const bf16x8*)(base + off); }
__device__ __forceinline__ void softmax_pv(f32x16& s, const bf16x8 (&vf)[4], f32x16& o0, f32x16& o1, float& mrun, float& lrun) {
  float mx = fmaxf(s[0], s[1]);
#pragma unroll
  for (int r = 2; r < 16; ++r) mx = fmaxf(mx, s[r]);
  mx = half_max(mx);
  const float mnew = fmaxf(mrun, mx), alpha = __builtin_amdgcn_exp2f(mrun - mnew); mrun = mnew;
#pragma unroll
  for (int r = 0; r < 16; ++r) s[r] = __builtin_amdgcn_exp2f(s[r] - mnew);
  const float ls = (((s[0] + s[1]) + (s[2] + s[3])) + ((s[4] + s[5]) + (s[6] + s[7]))) + (((s[8] + s[9]) + (s[10] + s[11])) + ((s[12] + s[13]) + (s[14] + s[15])));
  lrun = lrun * alpha + ls;
  if (__builtin_amdgcn_ballot_w64(alpha != 1.f) != 0ull) {
#pragma unroll
    for (int r = 0; r < 16; ++r) { o0[r] *= alpha; o1[r] *= alpha; }
  }
  u32x4 w0, w1;
  w0.x = cvt_pk_bf16(s[0], s[1]); w0.y = cvt_pk_bf16(s[2], s[3]); w0.z = cvt_pk_bf16(s[4], s[5]); w0.w = cvt_pk_bf16(s[6], s[7]);
  w1.x = cvt_pk_bf16(s[8], s[9]); w1.y = cvt_pk_bf16(s[10], s[11]); w1.z = cvt_pk_bf16(s[12], s[13]); w1.w = cvt_pk_bf16(s[14], s[15]);
  const bf16x8 p0 = __builtin_bit_cast(bf16x8, w0), p1 = __builtin_bit_cast(bf16x8, w1);
  o0 = __builtin_amdgcn_mfma_f32_32x32x16_bf16(vf[0], p0, o0, 0, 0, 0); o0 = __builtin_amdgcn_mfma_f32_32x32x16_bf16(vf[1], p1, o0, 0, 0, 0);
  o1 = __builtin_amdgcn_mfma_f32_32x32x16_bf16(vf[2], p0, o1, 0, 0, 0); o1 = __builtin_amdgcn_mfma_f32_32x32x16_bf16(vf[3], p1, o1, 0, 0, 0);
}
__device__ __forceinline__ void store_ot(unsigned char* base, unsigned rowoff, const f32x16& o0, const f32x16& o1, float il, int hi) {
#pragma unroll
  for (int a = 0; a < 4; ++a) {
    u32x2 w; w.x = cvt_pk_bf16(o0[4 * a] * il, o0[4 * a + 1] * il); w.y = cvt_pk_bf16(o0[4 * a + 2] * il, o0[4 * a + 3] * il);
    *(u32x2*)(base + rowoff + (8 * a + 4 * hi) * 2) = w;
    u32x2 v; v.x = cvt_pk_bf16(o1[4 * a] * il, o1[4 * a + 1] * il); v.y = cvt_pk_bf16(o1[4 * a + 2] * il, o1[4 * a + 3] * il);
    *(u32x2*)(base + rowoff + (32 + 8 * a + 4 * hi) * 2) = v;
  }
}

constexpr int LDS_OST_OFF = 77824, LDS_OST_WAVE = 4608;
__device__ __forceinline__ void store_ot_rows(LAS unsigned char* ol, unsigned char* base, unsigned rowoff0, unsigned rowstride, const f32x16& o0, const f32x16& o1, float il, int r32, int hi, int lane) {
#pragma unroll
  for (int a = 0; a < 4; ++a) {
    u32x2 w; w.x = cvt_pk_bf16(o0[4 * a] * il, o0[4 * a + 1] * il); w.y = cvt_pk_bf16(o0[4 * a + 2] * il, o0[4 * a + 3] * il);
    *(LAS u32x2*)(ol + r32 * 144 + (8 * a + 4 * hi) * 2) = w;
    u32x2 v; v.x = cvt_pk_bf16(o1[4 * a] * il, o1[4 * a + 1] * il); v.y = cvt_pk_bf16(o1[4 * a + 2] * il, o1[4 * a + 3] * il);
    *(LAS u32x2*)(ol + r32 * 144 + (32 + 8 * a + 4 * hi) * 2) = v;
  }
#pragma unroll
  for (int t = 0; t < 4; ++t) { const int p = lane + 64 * t, row = p >> 3, c = p & 7;
    const u32x4 w = *(const LAS u32x4*)(ol + row * 144 + c * 16);
    *(u32x4*)(base + rowoff0 + (unsigned)row * rowstride + c * 16) = w; }
}

constexpr int MLA_STEP_BYTES = 40960, MLA_NSTEP = SEQ / 128;
#define MLA_QBLOCK(S, O0, O1, NEGM, MREF, LRUN, FIRST) do { \
    S = S - MREF; \
    float mx_ = fmaxf(fmaxf(S[0], S[1]), fmaxf(S[2], S[3])); \
    _Pragma("unroll") for (int r = 4; r < 16; r += 4) mx_ = fmaxf(mx_, fmaxf(fmaxf(S[r], S[r + 1]), fmaxf(S[r + 2], S[r + 3]))); \
    mx_ = half_max(mx_); \
    if ((FIRST) || __builtin_amdgcn_ballot_w64(mx_ > 8.f) != 0ull) { \
      const float delta_ = (FIRST) ? mx_ : fmaxf(mx_, 0.f); MREF += delta_; \
      S = S - delta_; \
      if (!(FIRST)) { const float alpha_ = __builtin_amdgcn_exp2f(-delta_); LRUN *= alpha_; O0 = O0 * alpha_; O1 = O1 * alpha_; } } \
    _Pragma("unroll") for (int r = 0; r < 16; ++r) S[r] = __builtin_amdgcn_exp2f(S[r]); \
    LRUN += (((S[0] + S[1]) + (S[2] + S[3])) + ((S[4] + S[5]) + (S[6] + S[7]))) + (((S[8] + S[9]) + (S[10] + S[11])) + ((S[12] + S[13]) + (S[14] + S[15]))); } while (0)
__device__ __forceinline__ void mla_attn_phase(unsigned char* big, unsigned char* att, LAS unsigned char* lds, int bx, int G, int wave, int lane) {
  const int r32 = lane & 31, hi = lane >> 5;
  for (int u = bx; u < 256; u += G) {
    const int ux = u & 7, ui = u >> 3, bh = ((ux << 1) + (ui >> 4)) & 15, qb = ui & 15, b = bh >> 3, h = bh & 7;
    const unsigned m0 = b * SEQ + qb * 512 + wave * 64 + r32;
    bf16x8 qa[6], qb2[6];
#pragma unroll
    for (int c = 0; c < 4; ++c) { qa[c] = ldg8(big + B_QMLA, (m0 * 768 + h * 64 + 16 * c + 8 * hi) * 2u); qb2[c] = ldg8(big + B_QMLA, ((m0 + 32) * 768 + h * 64 + 16 * c + 8 * hi) * 2u); }
#pragma unroll
    for (int c = 0; c < 2; ++c) { qa[4 + c] = ldg8(big + B_QMLA, (m0 * 768 + 512 + h * 32 + 16 * c + 8 * hi) * 2u); qb2[4 + c] = ldg8(big + B_QMLA, ((m0 + 32) * 768 + 512 + h * 32 + 16 * c + 8 * hi) * 2u); }
    const unsigned char* kn = big + B_KN + ((size_t)b * SEQ * 512 + h * 64) * 2;
    const unsigned char* kp = big + B_KPE + ((size_t)b * SEQ * 32) * 2;
    const unsigned char* vt = big + B_VTMLA + ((size_t)(b * 8 + h) * 64 * SEQ) * 2;
    const unsigned char* sbase[5]; unsigned sstride[5], loff[5];
#pragma unroll
    for (int i = 0; i < 5; ++i) {
      const int sl = wave * 5 + i, tt = sl / 10, f = sl % 10;
      if (f < 4) { sbase[i] = kn + (size_t)tt * (32 * 512 * 2); loff[i] = (r32 * 512 + 16 * f + 8 * hi) * 2u; sstride[i] = 128 * 512 * 2; }
      else if (f < 6) { sbase[i] = kp + (size_t)tt * (32 * 32 * 2); loff[i] = (r32 * 32 + 16 * (f - 4) + 8 * hi) * 2u; sstride[i] = 128 * 32 * 2; }
      else { const int d0 = (f - 6) >> 1, j = (f - 6) & 1; sbase[i] = vt + (size_t)tt * 64; loff[i] = ((d0 * 32 + r32) * SEQ + 16 * j + 8 * hi) * 2u; sstride[i] = 256; }
    }
#define MLA_ISSUE(st, rs) do { _Pragma("unroll") for (int i = 0; i < 5; ++i) \
      __builtin_amdgcn_global_load_lds((const unsigned*)(sbase[i] + (size_t)(st) * sstride[i] + loff[i]), (LAS unsigned*)(lds + (rs) * MLA_STEP_BYTES + (wave * 5 + i) * 1024), 16, 0, 0); } while (0)
#define MLA_LD(base, idx) (*(const LAS bf16x8*)(lds + (base) + (idx) * 1024 + lane * 16))
    const f32x16 z16 = {0.f, 0.f, 0.f, 0.f, 0.f, 0.f, 0.f, 0.f, 0.f, 0.f, 0.f, 0.f, 0.f, 0.f, 0.f, 0.f};
    f32x16 oA0 = z16, oA1 = z16, oB0 = z16, oB1 = z16;
    float mrefA = 0.f, mrefB = 0.f, lA = 0.f, lB = 0.f;
    MLA_ISSUE(0, 0); MLA_ISSUE(1, 1);
    int rs = 0;
    for (int st = 0; st < MLA_NSTEP; ++st) {
      if (st + 1 < MLA_NSTEP) asm volatile("s_waitcnt vmcnt(5)" ::: "memory"); else asm volatile("s_waitcnt vmcnt(0)" ::: "memory");
      __builtin_amdgcn_s_barrier();
      asm volatile("" ::: "memory");
      if (st + 2 < MLA_NSTEP) { const int rn = (rs >= 1) ? rs - 1 : 2; MLA_ISSUE(st + 2, rn); }
      const int sb = rs * MLA_STEP_BYTES;
#pragma unroll 1
      for (int tt = 0; tt < 4; ++tt) {
        const int tb = sb + tt * 10240;
        bf16x8 kf[6], vf[4];
#pragma unroll
        for (int c = 0; c < 6; ++c) kf[c] = MLA_LD(tb, c);
        f32x16 sA = __builtin_amdgcn_mfma_f32_32x32x16_bf16(kf[0], qa[0], z16, 0, 0, 0), sB = __builtin_amdgcn_mfma_f32_32x32x16_bf16(kf[0], qb2[0], z16, 0, 0, 0);
#pragma unroll
        for (int c = 1; c < 6; ++c) { sA = __builtin_amdgcn_mfma_f32_32x32x16_bf16(kf[c], qa[c], sA, 0, 0, 0); sB = __builtin_amdgcn_mfma_f32_32x32x16_bf16(kf[c], qb2[c], sB, 0, 0, 0); }
#pragma unroll
        for (int c = 0; c < 4; ++c) vf[c] = MLA_LD(tb, 6 + c);
        const bool first = (st == 0) && (tt == 0);
        MLA_QBLOCK(sA, oA0, oA1, 0, mrefA, lA, first);
        MLA_QBLOCK(sB, oB0, oB1, 0, mrefB, lB, first);
        u32x4 w0, w1, w2, w3;
        w0.x = cvt_pk_bf16(sA[0], sA[1]); w0.y = cvt_pk_bf16(sA[2], sA[3]); w0.z = cvt_pk_bf16(sA[4], sA[5]); w0.w = cvt_pk_bf16(sA[6], sA[7]);
        w1.x = cvt_pk_bf16(sA[8], sA[9]); w1.y = cvt_pk_bf16(sA[10], sA[11]); w1.z = cvt_pk_bf16(sA[12], sA[13]); w1.w = cvt_pk_bf16(sA[14], sA[15]);
        w2.x = cvt_pk_bf16(sB[0], sB[1]); w2.y = cvt_pk_bf16(sB[2], sB[3]); w2.z = cvt_pk_bf16(sB[4], sB[5]); w2.w = cvt_pk_bf16(sB[6], sB[7]);
        w3.x = cvt_pk_bf16(sB[8], sB[9]); w3.y = cvt_pk_bf16(sB[10], sB[11]); w3.z = cvt_pk_bf16(sB[12], sB[13]); w3.w = cvt_pk_bf16(sB[14], sB[15]);
        const bf16x8 pA0 = __builtin_bit_cast(bf16x8, w0), pA1 = __builtin_bit_cast(bf16x8, w1), pB0 = __builtin_bit_cast(bf16x8, w2), pB1 = __builtin_bit_cast(bf16x8, w3);
        oA0 = __builtin_amdgcn_mfma_f32_32x32x16_bf16(vf[0], pA0, oA0, 0, 0, 0); oB0 = __builtin_amdgcn_mfma_f32_32x32x16_bf16(vf[0], pB0, oB0, 0, 0, 0);
        oA1 = __builtin_amdgcn_mfma_f32_32x32x16_bf16(vf[2], pA0, oA1, 0, 0, 0); oB1 = __builtin_amdgcn_mfma_f32_32x32x16_bf16(vf[2], pB0, oB1, 0, 0, 0);
        oA0 = __builtin_amdgcn_mfma_f32_32x32x16_bf16(vf[1], pA1, oA0, 0, 0, 0); oB0 = __builtin_amdgcn_mfma_f32_32x32x16_bf16(vf[1], pB1, oB0, 0, 0, 0);
        oA1 = __builtin_amdgcn_mfma_f32_32x32x16_bf16(vf[3], pA1, oA1, 0, 0, 0); oB1 = __builtin_amdgcn_mfma_f32_32x32x16_bf16(vf[3], pB1, oB1, 0, 0, 0);
      }
      asm volatile("s_waitcnt lgkmcnt(0)" ::: "memory");
      rs = (rs == 2) ? 0 : rs + 1;
    }
#undef MLA_LD
#undef MLA_ISSUE
    const float ilA = 1.f / half_sum(lA), ilB = 1.f / half_sum(lB);
    store_ot(att, (m0 * 1024 + 512 + h * 64) * 2u, oA0, oA1, ilA, hi);
    store_ot(att, ((m0 + 32) * 1024 + 512 + h * 64) * 2u, oB0, oB1, ilB, hi);
    __builtin_amdgcn_s_barrier();
  }
}
#undef MLA_QBLOCK

constexpr int ATL_K = 0, ATL_V = 4608, ATL_WAVE = 9728;
#define ATL_LOAD(SK, SV, kbase, kpitch, vbase) do { \
    _Pragma("unroll") for (int i_ = 0; i_ < 4; ++i_) SK[i_] = *(const u32x4*)((kbase) + (size_t)(8 * i_ + (lane >> 3)) * (kpitch) + (lane & 7) * 16); \
    _Pragma("unroll") for (int i_ = 0; i_ < 4; ++i_) SV[i_] = *(const u32x4*)((vbase) + (size_t)(16 * i_ + (lane >> 2)) * (SEQ * 2) + (lane & 3) * 16); } while (0)
#define ATL_COMMIT(SK, SV, wl) do { \
    _Pragma("unroll") for (int i_ = 0; i_ < 4; ++i_) *(LAS u32x4*)((wl) + ATL_K + (8 * i_ + (lane >> 3)) * 144 + (lane & 7) * 16) = SK[i_]; \
    _Pragma("unroll") for (int i_ = 0; i_ < 4; ++i_) *(LAS u32x4*)((wl) + ATL_V + (16 * i_ + (lane >> 2)) * 80 + (lane & 3) * 16) = SV[i_]; } while (0)
#define ATL_FRAGS(KF, VF, wl) do { \
    _Pragma("unroll") for (int c_ = 0; c_ < 4; ++c_) KF[c_] = *(const LAS bf16x8*)((wl) + ATL_K + r32 * 144 + (2 * c_ + hi) * 16); \
    _Pragma("unroll") for (int d_ = 0; d_ < 2; ++d_) _Pragma("unroll") for (int j_ = 0; j_ < 2; ++j_) VF[2 * d_ + j_] = *(const LAS bf16x8*)((wl) + ATL_V + (32 * d_ + r32) * 80 + (2 * j_ + hi) * 16); } while (0)

__device__ __forceinline__ void na_attn_phase(unsigned char* big, unsigned char* att, const float* rpb, int gw, int NGW, int lane, LAS unsigned char* wl, LAS unsigned char* ol) {
  const int r32 = lane & 31, hi = lane >> 5;
  for (int wt = gw; wt < 4096; wt += NGW) {
    const int w = wt & 1, h = (wt >> 1) & 7, r = (wt >> 4) & 127, b = wt >> 11;
    const int rs = min(max(r - 4, 0), 120), c = 32 * w + r32, cs = min(max(c - 8, 0), 48);
    const unsigned m0 = b * SEQ + r * 64 + c;
    bf16x8 qf[4];
#pragma unroll
    for (int cc = 0; cc < 4; ++cc) qf[cc] = ldg8(big + B_QKNA, (m0 * 1024 + h * 64 + 16 * cc + 8 * hi) * 2u);
    const unsigned char* kb = big + B_QKNA + ((size_t)(b * SEQ + rs * 64) * 1024 + 512 + h * 64) * 2;
    const unsigned char* vt = big + B_VTNA + ((size_t)(b * 8 + h) * 64 * SEQ + rs * 64) * 2;
    const unsigned ko = (r32 * 1024 + 8 * hi) * 2u, vto = (r32 * SEQ + 8 * hi) * 2u;
    const float* bias_h = rpb + h * 15 * 31;
    f32x16 o0 = {0.f, 0.f, 0.f, 0.f, 0.f, 0.f, 0.f, 0.f, 0.f, 0.f, 0.f, 0.f, 0.f, 0.f, 0.f, 0.f}, o1 = o0;
    float mrun = NEG_BIG, lrun = 0.f;
    u32x4 sk[4], sv[4]; bf16x8 kf[4], vf[4];
#define NA_LOAD(t) ATL_LOAD(sk, sv, kb + (size_t)(t) * (32 * 1024 * 2), 2048, vt + (size_t)(t) * 64)
#define NA_COMP(KF, VF, i, half) do { \
      f32x16 s = {0.f, 0.f, 0.f, 0.f, 0.f, 0.f, 0.f, 0.f, 0.f, 0.f, 0.f, 0.f, 0.f, 0.f, 0.f, 0.f}; \
      _Pragma("unroll") for (int cc = 0; cc < 4; ++cc) s = __builtin_amdgcn_mfma_f32_32x32x16_bf16(KF[cc], qf[cc], s, 0, 0, 0); \
      const float* brow = bias_h + (rs + (i) - r + 7) * 31; \
      int c_ = c, cs_ = cs; asm volatile("" : "+v"(c_), "+v"(cs_));     \
      float bvv[16]; \
      _Pragma("unroll") for (int rr = 0; rr < 16; ++rr) { const int rel = 32 * (half) + crow(rr, hi) - c_ + 15; bvv[rr] = brow[min(max(rel, 0), 30)]; } \
      _Pragma("unroll") for (int rr = 0; rr < 16; ++rr) asm volatile("" : "+v"(bvv[rr]));     \
      _Pragma("unroll") for (int rr = 0; rr < 16; ++rr) { \
        const int kc = 32 * (half) + crow(rr, hi); \
        const bool ok = (kc >= cs_) && (kc < cs_ + 16); \
        s[rr] = ok ? s[rr] + bvv[rr] * LOG2E : NEG_BIG; } \
      softmax_pv(s, VF, o0, o1, mrun, lrun); } while (0)
    NA_LOAD(0); ATL_COMMIT(sk, sv, wl); NA_LOAD(1);
    for (int i = 0; i < 8; ++i) {
      ATL_FRAGS(kf, vf, wl); ATL_COMMIT(sk, sv, wl); if (i < 7) NA_LOAD(2 * i + 2);
      NA_COMP(kf, vf, i, 0);
      ATL_FRAGS(kf, vf, wl); if (i < 7) { ATL_COMMIT(sk, sv, wl); NA_LOAD(2 * i + 3); }
      NA_COMP(kf, vf, i, 1);
    }
#undef NA_LOAD
#undef NA_COMP
    const float il = 1.f / half_sum(lrun);
    store_ot(att, (m0 * 1024 + h * 64) * 2u, o0, o1, il, hi);
  }
}

struct DilWT { unsigned mq; int gq, sh, rho, i0, nseq; const unsigned char* vt; };
__device__ __forceinline__ DilWT dil_wt(int wt, int b, int hl, int P0, int r32, const unsigned char* big) {
  DilWT w; w.gq = wt >> 4; const int j = wt & 15; w.sh = 2 * w.gq;
  w.rho = (w.gq == 0) ? 0 : (w.gq == 1) ? (j >> 2) : j; const int it = (w.gq == 0) ? j : (w.gq == 1) ? (j & 3) : 0;
  w.i0 = (P0 >> w.sh) + 32 * it; w.nseq = SEQ >> w.sh;
  w.mq = b * SEQ + ((w.i0 + r32) << w.sh) + w.rho;
  w.vt = big + B_VT + ((size_t)((b * 3 + w.gq) * 8 + hl) * 64 * SEQ + w.rho * w.nseq) * 2;
  return w;
}
__device__ __forceinline__ void dil_attn_phase(unsigned char* big, unsigned char* att, int ch, int bx, int G, int wave, int lane, int tid, LAS unsigned char* wl, LAS unsigned char* ol) {
  const int r32 = lane & 31, hi = lane >> 5;
  float* lse = (float*)(big + B_LSE);
  for (int u = bx; u < 256; u += G) {
    const int ux = u & 7, ui = u >> 3, bhl = ((ux << 1) + (ui >> 4)) & 15, b = bhl >> 3, hl = bhl & 7, P0 = (ui & 15) * 512;
    f32x16 o0, o1; float mrun, lrun;
    bf16x8 qx[4], qy[4], kf[4], vf[4]; u32x4 sk[4], sv[4];
#define DIL_LOADQ(Q, W) do { _Pragma("unroll") for (int cc = 0; cc < 4; ++cc) Q[cc] = ldg8(big + B_QK, (W.mq * 3072 + W.gq * 1024 + hl * 64 + 16 * cc + 8 * hi) * 2u); } while (0)
#define DIL_LOAD(W, T) do { const int k0_ = W.i0 - 64 + 32 * (T), k0c_ = min(max(k0_, 0), W.nseq - 32); \
      ATL_LOAD(sk, sv, big + B_QK + ((size_t)(b * SEQ + (k0c_ << W.sh) + W.rho) * 3072 + W.gq * 1024 + 512 + hl * 64) * 2, ((size_t)6144 << W.sh), W.vt + (size_t)k0c_ * 2); } while (0)
#define DIL_COMP(KF, VF, Q, W, T) do { \
      if ((T) == 0) { _Pragma("unroll") for (int rr = 0; rr < 16; ++rr) { o0[rr] = 0.f; o1[rr] = 0.f; } mrun = NEG_BIG; lrun = 0.f; } \
      const int k0_ = W.i0 - 64 + 32 * (T); const bool tv_ = (k0_ >= 0) && (k0_ < W.nseq); \
      if (tv_) { \
      f32x16 s = {0.f, 0.f, 0.f, 0.f, 0.f, 0.f, 0.f, 0.f, 0.f, 0.f, 0.f, 0.f, 0.f, 0.f, 0.f, 0.f}; \
      _Pragma("unroll") for (int cc = 0; cc < 4; ++cc) s = __builtin_amdgcn_mfma_f32_32x32x16_bf16(KF[cc], Q[cc], s, 0, 0, 0); \
      _Pragma("unroll") for (int rr = 0; rr < 16; ++rr) { \
        const bool ok_ = ((T) == 0 ? (crow(rr, hi) >= r32) : (T) == 4 ? (crow(rr, hi) <= r32) : true); \
        s[rr] = ok_ ? s[rr] : NEG_BIG; } \
      softmax_pv(s, VF, o0, o1, mrun, lrun); } \
      if ((T) == 4) { const float lt_ = half_sum(lrun), il_ = 1.f / lt_; \
        store_ot_rows(ol, big + B_QK, ((unsigned)(b * SEQ + (W.i0 << W.sh) + W.rho) * 3072 + W.gq * 1024 + hl * 64) * 2u, 6144u << W.sh, o0, o1, il_, r32, hi, lane); \
        if (hi == 0) lse[(W.mq * 8 + hl) * 3 + W.gq] = mrun + __builtin_amdgcn_logf(lt_); } } while (0)
    DilWT WX = dil_wt(wave, b, hl, P0, r32, big), WY = WX;
    DIL_LOADQ(qx, WX); DIL_LOAD(WX, 0); ATL_COMMIT(sk, sv, wl); DIL_LOAD(WX, 1);
    for (int pair = 0; pair < 3; ++pair) {
      WY = dil_wt(wave + 8 * (2 * pair + 1), b, hl, P0, r32, big);
      ATL_FRAGS(kf, vf, wl); ATL_COMMIT(sk, sv, wl); DIL_LOAD(WX, 2); DIL_COMP(kf, vf, qx, WX, 0);
      ATL_FRAGS(kf, vf, wl); ATL_COMMIT(sk, sv, wl); DIL_LOAD(WX, 3); DIL_COMP(kf, vf, qx, WX, 1);
      ATL_FRAGS(kf, vf, wl); ATL_COMMIT(sk, sv, wl); DIL_LOAD(WX, 4); DIL_COMP(kf, vf, qx, WX, 2);
      ATL_FRAGS(kf, vf, wl); ATL_COMMIT(sk, sv, wl); DIL_LOADQ(qy, WY); DIL_LOAD(WY, 0); DIL_COMP(kf, vf, qx, WX, 3);
      ATL_FRAGS(kf, vf, wl); ATL_COMMIT(sk, sv, wl); DIL_LOAD(WY, 1); DIL_COMP(kf, vf, qx, WX, 4);
      ATL_FRAGS(kf, vf, wl); ATL_COMMIT(sk, sv, wl); DIL_LOAD(WY, 2); DIL_COMP(kf, vf, qy, WY, 0);
      ATL_FRAGS(kf, vf, wl); ATL_COMMIT(sk, sv, wl); DIL_LOAD(WY, 3); DIL_COMP(kf, vf, qy, WY, 1);
      ATL_FRAGS(kf, vf, wl); ATL_COMMIT(sk, sv, wl); DIL_LOAD(WY, 4); DIL_COMP(kf, vf, qy, WY, 2);
      ATL_FRAGS(kf, vf, wl); ATL_COMMIT(sk, sv, wl);
      if (pair < 2) { WX = dil_wt(wave + 8 * (2 * pair + 2), b, hl, P0, r32, big); DIL_LOADQ(qx, WX); DIL_LOAD(WX, 0); }
      DIL_COMP(kf, vf, qy, WY, 3);
      ATL_FRAGS(kf, vf, wl);
      if (pair < 2) { ATL_COMMIT(sk, sv, wl); DIL_LOAD(WX, 1); }
      DIL_COMP(kf, vf, qy, WY, 4);
    }
#undef DIL_LOADQ
#undef DIL_LOAD
#undef DIL_COMP
    __syncthreads();
    {
#pragma unroll 2
      for (int i = 0; i < 8; ++i) {
        const unsigned m = b * SEQ + P0 + 64 * i + (tid >> 3); const unsigned pc = (tid & 7) * 16;
        const float l0 = lse[(m * 8 + hl) * 3 + 0], l1 = lse[(m * 8 + hl) * 3 + 1], l2 = lse[(m * 8 + hl) * 3 + 2];
        float a0[8], a1[8], a2[8];
        unpack8(*(const u32x4*)(big + B_QK + ((size_t)m * 3072 + 0 * 1024 + hl * 64) * 2 + pc), a0);
        unpack8(*(const u32x4*)(big + B_QK + ((size_t)m * 3072 + 1 * 1024 + hl * 64) * 2 + pc), a1);
        unpack8(*(const u32x4*)(big + B_QK + ((size_t)m * 3072 + 2 * 1024 + hl * 64) * 2 + pc), a2);
        const float lm = fmaxf(l0, fmaxf(l1, l2));
        float w0 = __builtin_amdgcn_exp2f(l0 - lm), w1 = __builtin_amdgcn_exp2f(l1 - lm), w2 = __builtin_amdgcn_exp2f(l2 - lm);
        const float iw = 1.f / (w0 + w1 + w2); w0 *= iw; w1 *= iw; w2 *= iw;
        float f[8];
#pragma unroll
        for (int e = 0; e < 8; ++e) f[e] = w0 * a0[e] + w1 * a1[e] + w2 * a2[e];
        u32x4 wv; wv.x = cvt_pk_bf16(f[0], f[1]); wv.y = cvt_pk_bf16(f[2], f[3]); wv.z = cvt_pk_bf16(f[4], f[5]); wv.w = cvt_pk_bf16(f[6], f[7]);
        *(u32x4*)(att + ((size_t)m * 1024 + (8 * ch + hl) * 64) * 2 + pc) = wv;
      }
    }
    __syncthreads();
  }
}

#define XB_TMO      128
#define XB_XCNT(j)  (256  + 64 * (j))
#define XB_XSUB(j)  (1280 + 64 * (j))
#define XB_XGEN(j)  (2304 + 64 * (j))
#define XB_TOP      3328
#define XB_TOPGEN   3392
#define XCD_BAR_WORDS 3456
#define XB_SPIN_CAP (1u << 18)
__device__ __forceinline__ unsigned xb_ld(unsigned* p)              { return __hip_atomic_load(p, __ATOMIC_RELAXED, __HIP_MEMORY_SCOPE_AGENT); }
__device__ __forceinline__ unsigned xb_add(unsigned* p, unsigned v) { return __hip_atomic_fetch_add(p, v, __ATOMIC_RELAXED, __HIP_MEMORY_SCOPE_AGENT); }
__device__ __forceinline__ unsigned xb_xcc_id() { return (unsigned)__builtin_amdgcn_s_getreg((3 << 11) | 20) & 0xFu; }
#define XB_SPIN(cond, bar) do { unsigned _sp = 0; while (cond) { __builtin_amdgcn_s_sleep(1); \
    if ((++_sp & 255u) == 0u) { if (xb_ld(&(bar)[XB_TMO])) break; if (_sp > XB_SPIN_CAP) { atomicAdd(&(bar)[XB_TMO], 1u); break; } } } } while (0)
struct XcdBarrier { unsigned* bar; unsigned x; volatile LAS unsigned* st; };
__device__ __forceinline__ XcdBarrier xcd_barrier_post(unsigned* bar, volatile LAS unsigned* st) {
  XcdBarrier b; b.bar = bar; b.x = xb_xcc_id(); b.st = st;
  if (threadIdx.x == 0) (void)xb_add(&bar[XB_XCNT(b.x)], 1u);
  return b;
}
__device__ __forceinline__ void xcd_barrier_complete(unsigned* bar, unsigned x, unsigned& nloc, unsigned& nx) {
  const unsigned G = gridDim.x * gridDim.y * gridDim.z;
  unsigned sum, cnt, mine, sp = 0u;
  for (;;) {
    sum = 0u; cnt = 0u; mine = 0u;
#pragma unroll
    for (unsigned j = 0; j < 16; ++j) { const unsigned c = xb_ld(&bar[XB_XCNT(j)]); sum += c; cnt += (c > 0u) ? 1u : 0u; mine = (j == x) ? c : mine; }
    if (sum == G) break;
    __builtin_amdgcn_s_sleep(1);
    if ((++sp & 255u) == 0u) { if (xb_ld(&bar[XB_TMO])) break; if (sp > XB_SPIN_CAP) { atomicAdd(&bar[XB_TMO], 1u); break; } }
  }
  nloc = mine > 0u ? mine : 1u; nx = cnt > 0u ? cnt : 1u;
}
__device__ __forceinline__ void xcd_barrier(const XcdBarrier& b) {
  asm volatile("s_waitcnt vmcnt(0)" ::: "memory");
  __syncthreads();
  if (threadIdx.x == 0) {
    unsigned* bar = b.bar;
    __builtin_amdgcn_s_waitcnt(0);
    unsigned nloc = b.st[0], nx = b.st[1];
    if (nloc == 0u) { xcd_barrier_complete(bar, b.x, nloc, nx); b.st[0] = nloc; b.st[1] = nx; }
    const unsigned old = xb_add(&bar[XB_XSUB(b.x)], 1u);
    const unsigned gen = old / nloc;
    if (old + 1u == (gen + 1u) * nloc) {
      __builtin_amdgcn_fence(__ATOMIC_RELEASE, "agent");
      asm volatile("s_waitcnt vmcnt(0)" ::: "memory");
      const unsigned og = xb_add(&bar[XB_TOP], 1u);
      const unsigned tg = og / nx;
      if (og + 1u == (tg + 1u) * nx) xb_add(&bar[XB_TOPGEN], 1u);
      else XB_SPIN(xb_ld(&bar[XB_TOPGEN]) == tg, bar);
      __builtin_amdgcn_fence(__ATOMIC_ACQUIRE, "agent");
      xb_add(&bar[XB_XGEN(b.x)], 1u);
      asm volatile("s_waitcnt vmcnt(0)" ::: "memory");
    } else {
      XB_SPIN(xb_ld(&bar[XB_XGEN(b.x)]) == gen, bar);
      __builtin_amdgcn_fence(__ATOMIC_ACQUIRE, "agent");
      asm volatile("s_waitcnt vmcnt(0)" ::: "memory");
    }
  }
  __syncthreads();
}

__device__ __forceinline__ const void* ldptr(LAS unsigned char* lds, int i) {
  const volatile LAS unsigned* p = (const volatile LAS unsigned*)(lds + 131072) + 2 * i;
  const unsigned lo = __builtin_amdgcn_readfirstlane(p[0]), hi = __builtin_amdgcn_readfirstlane(p[1]);
  return (const void*)(((unsigned long long)hi << 32) | lo);
}
struct Args { const float* in[15]; float* out; unsigned char* ws; int ph_lo, ph_hi; };

__global__ void __launch_bounds__(512, 2) fwd(Args a) {
  extern __shared__ __attribute__((aligned(16))) unsigned char lds_raw[];
  LAS unsigned char* lds = (LAS unsigned char*)lds_raw;
  cg::grid_group grid = cg::this_grid();
  const int G = gridDim.x, bx = blockIdx.x;
  const int gsz = G * 512, NGW = G * 8;
  if (threadIdx.x < 15) ((LAS unsigned long long*)(lds + 131072))[threadIdx.x] = (unsigned long long)a.in[threadIdx.x];
  if (threadIdx.x == 15) ((LAS unsigned long long*)(lds + 131072))[15] = (unsigned long long)a.out;
  if (threadIdx.x == 16) ((LAS unsigned long long*)(lds + 131072))[16] = (unsigned long long)a.ws;
  if (threadIdx.x == 17) { ((LAS unsigned*)(lds + 131072 + 256))[0] = 0u; ((LAS unsigned*)(lds + 131072 + 256))[1] = 0u; }
  if (bx == 0) for (int i = threadIdx.x; i < XCD_BAR_WORDS; i += 512) ((unsigned*)a.ws)[i] = 0u;
  __syncthreads();
  XcdBarrier xbar; xbar.bar = (unsigned*)a.ws; xbar.x = 0; xbar.st = (volatile LAS unsigned*)(lds + 131072 + 256);
#define INP(i) ((const float*)ldptr(lds, (i)))

  if (a.ph_lo == 0) {
    const int gtid0 = bx * 512 + threadIdx.x;
    float* cos64 = (float*)(a.ws + WS_COS64); float* sin64 = (float*)(a.ws + WS_SIN64); float* cos32 = (float*)(a.ws + WS_COS32); float* sin32 = (float*)(a.ws + WS_SIN32);
    for (int i = gtid0; i < SEQ * 32; i += gsz) { const int pos = i >> 5, kk = i & 31; float sn, cs; sincos_acc((float)pos * INV64[kk], sn, cs); cos64[i] = cs; sin64[i] = sn; }
    for (int i = gtid0; i < SEQ * 16; i += gsz) { const int pos = i >> 4, kk = i & 15; float sn, cs; sincos_acc((float)pos * INV64[2 * kk], sn, cs); cos32[i] = cs; sin32[i] = sn; }
  }
#ifdef ONE_LAUNCH
  for (int ph = a.ph_lo; ph < a.ph_hi; ++ph) {
#else
  { const int ph = a.ph_lo;
#endif
    int tid = threadIdx.x; asm volatile("" : "+v"(tid));
    const int lane = tid & 63, wave = __builtin_amdgcn_readfirstlane(tid >> 6), gtid = bx * 512 + tid, gw = bx * 8 + wave;
    unsigned char* ws = a.ws;
    float* X = a.out;
    unsigned char* big = ws + WS_BIG;
    bf16_t* XN = (bf16_t*)(ws + WS_XN); bf16_t* ATT = (bf16_t*)(ws + WS_ATT);
    const float* cos64 = (const float*)(ws + WS_COS64); const float* sin64 = (const float*)(ws + WS_SIN64);
    const float* cos32 = (const float*)(ws + WS_COS32); const float* sin32 = (const float*)(ws + WS_SIN32);
    if (ph == NPH - 1) {
      for (int m = gw; m < M; m += NGW) rms_row_f32(X + (size_t)m * DM, INP(3), X + (size_t)m * DM, lane);
    } else {
      const int pp = ph >= 15 ? ph - 15 : ph, L = (ph >= 15 ? 2 : 0) + (pp >= 7 ? 1 : 0), idx = pp >= 7 ? pp - 7 : pp, e = L >> 1; const bool even = !(L & 1);
      const int k = even ? idx + (idx >= 2 ? 1 : 0) + (idx >= 5 ? 1 : 0) : idx + (idx >= 6 ? 1 : 0);
      const float* xsrc = (L == 0) ? INP(0) : X;
      float* ss_mix = (float*)(ws + WS_SS_MIX); float* ss_mlp = (float*)(ws + WS_SS_MLP);
      if (k == 0) {
        LAS float* scr = (LAS float*)(lds + wave * 16384);
        const float* w1 = INP(13) + (size_t)L * DM * FF; const float* w2 = INP(14) + (size_t)L * FF * DM;
        const float* wo = even ? INP(10) + (size_t)e * DM * DM : INP(12) + (size_t)e * DM * DM;
        const float* gmix = INP(1) + L * DM; const float* gmlp = INP(2) + L * DM;
        const int nin = even ? EV_N : 2 * OD_NC;
        const int I_IN = 16 * (nin / 32), I_O = 16 * 32, I_1 = 16 * 128, I_2 = 64 * 32, I_UQ = even ? 4 * 24 : 0, I_UKV = even ? 2 * 32 : 0;
        const int NIT = I_IN + I_O + I_1 + I_2 + I_UQ + I_UKV;
        for (int it = gw; it < NIT; it += NGW) {
          int r = it;
          if (r < I_IN) { if (even) transpose_item(INP(4) + (size_t)e * DM * 1952, DM, 1952, EV_N, (bf16_t*)(ws + WS_W + W_IN), CM_EVIN, scr, r, lane, gmix);
                          else transpose_item(INP(11) + (size_t)e * DM * 9216, DM, 9216, 2 * OD_NC, (bf16_t*)(ws + WS_W + W_IN), CM_ODIN, scr, r, lane, gmix); continue; } r -= I_IN;
          if (r < I_O) { transpose_item(wo, DM, DM, DM, (bf16_t*)(ws + WS_W + W_O), CM_ID, scr, r, lane, nullptr); continue; } r -= I_O;
          if (r < I_1) { transpose_item(w1, DM, FF, FF, (bf16_t*)(ws + WS_W + W_1), CM_ID, scr, r, lane, gmlp); continue; } r -= I_1;
          if (r < I_2) { transpose_item(w2, FF, DM, DM, (bf16_t*)(ws + WS_W + W_2), CM_ID, scr, r, lane, nullptr); continue; } r -= I_2;
          if (r < I_UQ) { transpose_item(INP(7) + (size_t)e * 256 * 768, 256, 768, 768, (bf16_t*)(ws + WS_W + W_UQ), CM_UQ, scr, r, lane, INP(6) + e * 256); continue; } r -= I_UQ;
          transpose_item(INP(9) + (size_t)e * 128 * 1024, 128, 1024, 1024, (bf16_t*)(ws + WS_W + W_UKV), CM_UKV, scr, r, lane, INP(8) + e * 128);
        }
        if (L == 0) {
          for (int m = gw; m < M; m += NGW) {
            const f32x4* xr = (const f32x4*)(xsrc + (size_t)m * DM) + lane; u32x2* o8 = (u32x2*)(XN + (size_t)m * DM) + lane; float s = 0.f;
#pragma unroll
            for (int j = 0; j < 4; ++j) { const f32x4 v = xr[64 * j]; s += (v.x * v.x + v.y * v.y) + (v.z * v.z + v.w * v.w); u32x2 w; w.x = cvt_pk_bf16(v.x, v.y); w.y = cvt_pk_bf16(v.z, v.w); o8[64 * j] = w; }
            s = wave_sum(s); if (lane < 4) ss_mix[m * 4 + lane] = (lane == 0) ? s : 0.f;
          }
        }
      } else if (even && k == 4) {
        na_attn_phase(big, (unsigned char*)ATT, INP(5) + (size_t)e * 8 * 15 * 31, gw, NGW, lane, lds + wave * ATL_WAVE, lds + LDS_OST_OFF + wave * LDS_OST_WAVE);
        __syncthreads();
        mla_attn_phase(big, (unsigned char*)ATT, lds, bx, G, wave, lane);
      } else if (!even && (k == 2 || k == 4)) {
        dil_attn_phase(big, (unsigned char*)ATT, (k == 2) ? 0 : 1, bx, G, wave, lane, tid, lds + wave * ATL_WAVE, lds + LDS_OST_OFF + wave * LDS_OST_WAVE);
      } else {
        const int nsub = (even && k == 3) ? 2 : 1;
        for (int sub = 0; sub < nsub; ++sub) {
          pg8::Gemm g; pg8::StaticOrder S; EpiB E; E.ws = ws; E.lds = lds;
          g.M = M;
          E.base = (k == 5) ? xsrc : X; E.outf = X;
          E.rsub = (k == 5) ? 0 : 1;
          if (k == 5) { g.A = ATT; g.Bt = (const bf16_t*)(ws + WS_W + W_O); g.N = DM; g.K = DM; E.kind = K_RESID; }
          else if (k == 8) { g.A = (const bf16_t*)big; g.Bt = (const bf16_t*)(ws + WS_W + W_2); g.N = DM; g.K = FF; E.kind = K_RESID; }
          else if (k == 7) { g.A = XN; g.Bt = (const bf16_t*)(ws + WS_W + W_1); g.N = FF; g.K = DM; E.kind = K_RELU2; }
          else if (even && k == 1) { g.A = XN; g.Bt = (const bf16_t*)(ws + WS_W + W_IN); g.N = EV_N; g.K = DM; E.kind = K_EVIN; }
          else if (even) {
            if (sub == 0) { g.A = (const bf16_t*)(big + B_CQN); g.Bt = (const bf16_t*)(ws + WS_W + W_UQ); g.N = 768; g.K = 256; E.kind = K_UQ; }
            else { g.A = (const bf16_t*)(big + B_CKVN); g.Bt = (const bf16_t*)(ws + WS_W + W_UKV); g.N = 1024; g.K = 128; E.kind = K_UKV; }
          } else { const int ch = (k == 1) ? 0 : 1; g.A = XN; g.Bt = (const bf16_t*)(ws + WS_W + W_IN) + (size_t)ch * OD_NC * DM; g.N = OD_NC; g.K = DM; E.kind = K_ODIN; }
          S.init(M, g.N, G, bx);
          pg8::gemm_phase<EpiB>(lds, g, S, E);
        }
      }
    }
#ifdef ONE_LAUNCH
    if (ph + 1 < a.ph_hi) {
      if (ph == a.ph_lo) { grid.sync(); xbar = xcd_barrier_post((unsigned*)a.ws, (volatile LAS unsigned*)(lds + 131072 + 256)); }
      else xcd_barrier(xbar);
    }
#endif
  }
}

extern "C" void kernel_launch(void* const* d_in, const int* in_sizes, int n_in, void* d_out, int out_size, void* d_ws, size_t ws_size, hipStream_t stream) {
  static int grid = 0;
  if (!grid) {
    if (n_in != 15 || out_size != M * DM || ws_size < WS_END) { fprintf(stderr, "kernel_launch: unexpected sizes n_in %d out %d ws %zu (need %zu)\n", n_in, out_size, ws_size, (size_t)WS_END); grid = -1; return; }
    int dev = 0, cus = 0, per_cu = 0;
    (void)hipGetDevice(&dev);
    (void)hipDeviceGetAttribute(&cus, hipDeviceAttributeMultiprocessorCount, dev);
    (void)hipFuncSetAttribute((const void*)fwd, hipFuncAttributeMaxDynamicSharedMemorySize, LDS_BYTES);
    (void)hipOccupancyMaxActiveBlocksPerMultiprocessor(&per_cu, (const void*)fwd, 512, LDS_BYTES);
    if (per_cu < 1) per_cu = 1;
    grid = cus * per_cu;
  }
  if (grid < 0) return;
  Args a{};
  for (int i = 0; i < 15; ++i) a.in[i] = (const float*)d_in[i];
  a.out = (float*)d_out; a.ws = (unsigned char*)d_ws;
#ifndef ONE_LAUNCH
  for (int ph = 0; ph < NPH; ++ph) {
    a.ph_lo = ph; a.ph_hi = ph + 1;
    hipLaunchKernelGGL(fwd, dim3(grid), dim3(512), LDS_BYTES, stream, a);
  }
#else
  a.ph_lo = 0; a.ph_hi = NPH;
  void* args[] = {&a};
  hipError_t er = hipLaunchCooperativeKernel((const void*)fwd, dim3(grid), dim3(512), args, LDS_BYTES, stream);
  if (er != hipSuccess) fprintf(stderr, "cooperative launch failed: %s (grid %d)\n", hipGetErrorString(er), grid);
#endif
}
```
